# Optimizing an MI355X kernel written in HIP

```python
import jax, jax.numpy as jnp
from jax import lax
import numpy as np

D_MODEL = 1024
BATCH = 4
SEQ = 4096
DEPTH = 2

CHUNK = 64
D_MIX = D_MODEL
LRU_WIDTH = D_MIX // 4
LRU_HEADS = 4
LRU_HEAD_DIM = LRU_WIDTH // LRU_HEADS
CONV_WIDTH = 4
LRU_C = 8.0
FOX_WIDTH = D_MIX // 2
FOX_HEAD_DIM = 64
FOX_HEADS = FOX_WIDTH // FOX_HEAD_DIM
Q_BLOCK = 128
RWKV_WIDTH = D_MIX - LRU_WIDTH - FOX_WIDTH
RWKV_HEAD_DIM = 64
RWKV_HEADS = RWKV_WIDTH // RWKV_HEAD_DIM
DECAY_RANK = 32
AAA_RANK = 32
GATE_RANK = 64
N_GROUPS = 4
EXPERTS_PER_GROUP = 4
N_EXPERTS = N_GROUPS * EXPERTS_PER_GROUP
TOP_K = 2
D_EXPERT = 256
NORM_EPS = 1e-6
GN_EPS = 64e-5
LRU_COLS = 2 * LRU_WIDTH
FOX_COLS = 3 * FOX_WIDTH + FOX_HEADS
RWKV_COLS = 3 * RWKV_WIDTH + DECAY_RANK + AAA_RANK + GATE_RANK
D_IN = LRU_COLS + FOX_COLS + RWKV_COLS

kernel_name = 'hybrid_rglru_fox_rwkv7_hiermoe'


def rms_norm(x, g, eps=NORM_EPS):
    xf = x.astype(jnp.float32)
    y = xf * lax.rsqrt(jnp.mean(xf * xf, axis=-1, keepdims=True) + eps)
    return (y * g.astype(jnp.float32)).astype(x.dtype)


def rglru_group(x_in, gate_in, conv_w, conv_b, wa, ba, wx, bx, lam, norm_g):
    f32 = jnp.float32
    B, S, W = x_in.shape
    xp = jnp.pad(x_in, ((0, 0), (CONV_WIDTH - 1, 0), (0, 0)))
    xc = conv_b + sum(xp[:, j:j + S] * conv_w[j] for j in range(CONV_WIDTH))
    xh = xc.reshape(B, S, LRU_HEADS, LRU_HEAD_DIM)
    r = jax.nn.sigmoid((jnp.einsum('bshi,hij->bshj', xh, wa).reshape(B, S, W) + ba).astype(f32))
    i = jax.nn.sigmoid((jnp.einsum('bshi,hij->bshj', xh, wx).reshape(B, S, W) + bx).astype(f32))
    log_a = -LRU_C * r * jax.nn.softplus(-lam.astype(f32))
    a = jnp.exp(log_a)
    b = jnp.sqrt(-jnp.expm1(2.0 * log_a)) * (i * xc.astype(f32))

    def combine(left, right):
        a1, b1 = left
        a2, b2 = right
        return a1 * a2, a2 * b1 + b2

    _, h = lax.associative_scan(combine, (a, b), axis=1)
    y = jax.nn.gelu(gate_in.astype(f32)) * h
    return rms_norm(y.astype(x_in.dtype), norm_g)


def fox_group(q, k, v, f_logit, fb, qn_g, kn_g, norm_g):
    f32 = jnp.float32
    B, S, _ = q.shape
    H, Dh = FOX_HEADS, FOX_HEAD_DIM
    qh = rms_norm(q.reshape(B, S, H, Dh), qn_g).transpose(0, 2, 1, 3)
    kh = rms_norm(k.reshape(B, S, H, Dh), kn_g).transpose(0, 2, 1, 3)
    vh = v.reshape(B, S, H, Dh).transpose(0, 2, 1, 3)
    log_f = jax.nn.log_sigmoid((f_logit + fb).astype(f32))
    c = jnp.cumsum(log_f, axis=1).transpose(0, 2, 1)
    nb = S // Q_BLOCK
    q_blocks = qh.reshape(B, H, nb, Q_BLOCK, Dh).transpose(2, 0, 1, 3, 4)
    c_blocks = c.reshape(B, H, nb, Q_BLOCK).transpose(2, 0, 1, 3)
    starts = jnp.arange(nb, dtype=jnp.int32) * Q_BLOCK
    k_pos = jnp.arange(S, dtype=jnp.int32)
    scale = FOX_HEAD_DIM ** -0.5

    def block(args):
        qb, cb, s0 = args
        s = jnp.einsum('bhqd,bhkd->bhqk', qb, kh).astype(f32) * scale
        s = s + cb[..., None] - c[:, :, None, :]
        q_pos = s0 + jnp.arange(Q_BLOCK, dtype=jnp.int32)
        mask = k_pos[None, :] <= q_pos[:, None]
        p = jax.nn.softmax(jnp.where(mask, s, -jnp.inf), axis=-1)
        return jnp.einsum('bhqk,bhkd->bhqd', p.astype(vh.dtype), vh)

    o = lax.map(block, (q_blocks, c_blocks, starts))
    o = o.transpose(1, 0, 3, 2, 4).reshape(B, S, FOX_WIDTH)
    return rms_norm(o.astype(q.dtype), norm_g)


def rwkv7_group(p, mu, w0, w2, a0, a2, g2, k_k, k_a, r_k, ln_g, ln_b):
    f32 = jnp.float32
    B, S, _ = p.shape
    H, N = RWKV_HEADS, RWKV_HEAD_DIM
    prev = jnp.pad(p, ((0, 0), (1, 0), (0, 0)))[:, :-1]
    p = p + (prev - p) * mu
    o1 = RWKV_WIDTH
    o2 = 2 * RWKV_WIDTH
    o3 = 3 * RWKV_WIDTH
    o4 = o3 + DECAY_RANK
    o5 = o4 + AAA_RANK
    r, k, v, wd, ad, gd = jnp.split(p, [o1, o2, o3, o4, o5], axis=-1)
    r = r.astype(f32)
    k = k.astype(f32)
    v = v.astype(f32)
    w = -jax.nn.softplus(-(w0 + jnp.tanh(wd) @ w2).astype(f32)) - 0.5
    decay = jnp.exp(-jnp.exp(w))
    a = jax.nn.sigmoid((a0 + ad @ a2).astype(f32))
    g = (jax.nn.sigmoid(gd) @ g2).astype(f32)

    def heads(t):
        return t.reshape(B, S, H, N)

    kk = heads(k * k_k)
    kk = kk / jnp.maximum(jnp.sqrt(jnp.sum(kk * kk, axis=-1, keepdims=True)), 1e-12)
    k = k * (1.0 + (a - 1.0) * k_a)
    rh, wh, kh, vh, ah = heads(r), heads(decay), heads(k), heads(v), heads(a)
    n_chunks = S // CHUNK

    def to_chunks(t):
        return t.transpose(1, 0, 2, 3).reshape(n_chunks, CHUNK, B, H, N)

    xs = (to_chunks(rh), to_chunks(wh), to_chunks(kh), to_chunks(vh), to_chunks(kk), to_chunks(kk * ah))

    def frame_step(state, inp):
        r_t, w_t, k_t, v_t, kk_t, b_t = inp
        sa = jnp.einsum('bhvk,bhk->bhv', state, -kk_t)
        state = (state * w_t[:, :, None, :] + sa[..., None] * b_t[:, :, None, :]
                 + v_t[..., None] * k_t[:, :, None, :])
        return state, jnp.einsum('bhvk,bhk->bhv', state, r_t)

    def chunk_step(state, chunk):
        return lax.scan(frame_step, state, chunk)

    state0 = jnp.zeros((B, H, N, N), f32)
    _, o = lax.scan(chunk_step, state0, xs)
    o = o.reshape(S, B, H, N).transpose(1, 0, 2, 3)
    mean = jnp.mean(o, axis=-1, keepdims=True)
    var = jnp.mean(jnp.square(o - mean), axis=-1, keepdims=True)
    o = ((o - mean) * lax.rsqrt(var + GN_EPS)).reshape(B, S, RWKV_WIDTH) * ln_g + ln_b
    bonus = jnp.sum(rh * kh * r_k, axis=-1, keepdims=True) * vh
    return (o + bonus.reshape(B, S, RWKV_WIDTH)) * g


def hier_moe(x, wg, bg, we, be, w_gate, w_up, w_down):
    f32 = jnp.float32
    B, S, D = x.shape
    t = x.reshape(B * S, D)
    g_probs = jax.nn.softmax((t @ wg).astype(f32) + bg, axis=-1)
    g_p, g_idx = lax.top_k(g_probs, 1)
    e_logits = ((t @ we).astype(f32) + be).reshape(-1, N_GROUPS, EXPERTS_PER_GROUP)
    sel = jax.nn.one_hot(g_idx[:, 0], N_GROUPS, dtype=f32)
    e_logits = jnp.einsum('tg,tge->te', sel, e_logits)
    e_p, e_idx = lax.top_k(jax.nn.softmax(e_logits, axis=-1), TOP_K)
    e_p = e_p / jnp.sum(e_p, axis=-1, keepdims=True)
    weights = g_p * e_p
    ids = g_idx * EXPERTS_PER_GROUP + e_idx
    combine = jnp.sum(jax.nn.one_hot(ids, N_EXPERTS, dtype=f32) * weights[..., None], axis=1)
    hid = jax.nn.silu(jnp.einsum('td,edf->tef', t, w_gate)) * jnp.einsum('td,edf->tef', t, w_up)
    hid = hid * combine[..., None].astype(hid.dtype)
    y = jnp.einsum('tef,efd->td', hid, w_down)
    return y.reshape(B, S, D).astype(x.dtype)


def setup_inputs(seed: int = 0) -> dict:
    key = jax.random.key(seed)
    ks = iter(jax.random.split(key, 40))
    L = DEPTH

    def nrm(shape, scale):
        return jax.random.normal(next(ks), shape, jnp.float32) * scale

    def uni(shape, lo, hi):
        return jax.random.uniform(next(ks), shape, jnp.float32, lo, hi)

    x = nrm((BATCH, SEQ, D_MODEL), 1.0)
    norm1_g = 1.0 + nrm((L, D_MODEL), 0.02)
    w_in = nrm((L, D_MODEL, D_IN), D_MODEL ** -0.5)
    conv_w = nrm((L, CONV_WIDTH, LRU_WIDTH), CONV_WIDTH ** -0.5)
    conv_b = nrm((L, LRU_WIDTH), 0.01)
    lru_wa = nrm((L, LRU_HEADS, LRU_HEAD_DIM, LRU_HEAD_DIM), LRU_HEAD_DIM ** -0.5)
    lru_ba = nrm((L, LRU_WIDTH), 0.01)
    lru_wx = nrm((L, LRU_HEADS, LRU_HEAD_DIM, LRU_HEAD_DIM), LRU_HEAD_DIM ** -0.5)
    lru_bx = nrm((L, LRU_WIDTH), 0.01)
    a_pow = uni((L, LRU_WIDTH), 0.9, 0.999)
    s = a_pow ** (1.0 / LRU_C)
    lru_lambda = jnp.log(s) - jnp.log1p(-s)
    lru_norm_g = 1.0 + nrm((L, LRU_WIDTH), 0.02)
    fox_fb = uni((L, FOX_HEADS), 1.0, 5.0)
    fox_qnorm_g = 1.0 + nrm((L, FOX_HEAD_DIM), 0.02)
    fox_knorm_g = 1.0 + nrm((L, FOX_HEAD_DIM), 0.02)
    fox_norm_g = 1.0 + nrm((L, FOX_WIDTH), 0.02)
    rwkv_mu = uni((L, RWKV_COLS), 0.0, 1.0)
    rwkv_w0 = uni((L, RWKV_WIDTH), -4.0, 0.0)
    rwkv_w2 = nrm((L, DECAY_RANK, RWKV_WIDTH), 0.1 * DECAY_RANK ** -0.5)
    rwkv_a0 = nrm((L, RWKV_WIDTH), 0.1)
    rwkv_a2 = nrm((L, AAA_RANK, RWKV_WIDTH), 0.5 * AAA_RANK ** -0.5)
    rwkv_g2 = nrm((L, GATE_RANK, RWKV_WIDTH), GATE_RANK ** -0.5)
    rwkv_kk = 0.85 + nrm((L, RWKV_WIDTH), 0.05)
    rwkv_ka = 1.0 + nrm((L, RWKV_WIDTH), 0.05)
    rwkv_rk = nrm((L, RWKV_HEADS, RWKV_HEAD_DIM), 0.1)
    rwkv_ln_g = 1.0 + nrm((L, RWKV_WIDTH), 0.02)
    rwkv_ln_b = nrm((L, RWKV_WIDTH), 0.01)
    w_out = nrm((L, D_MIX, D_MODEL), D_MIX ** -0.5)
    norm2_g = 1.0 + nrm((L, D_MODEL), 0.02)
    router_gw = nrm((L, D_MODEL, N_GROUPS), D_MODEL ** -0.5)
    router_gb = nrm((L, N_GROUPS), 0.01)
    router_ew = nrm((L, D_MODEL, N_EXPERTS), D_MODEL ** -0.5)
    router_eb = nrm((L, N_EXPERTS), 0.01)
    exp_w_gate = nrm((L, N_EXPERTS, D_MODEL, D_EXPERT), D_MODEL ** -0.5)
    exp_w_up = nrm((L, N_EXPERTS, D_MODEL, D_EXPERT), D_MODEL ** -0.5)
    exp_w_down = nrm((L, N_EXPERTS, D_EXPERT, D_MODEL), D_EXPERT ** -0.5)
    return {'x': x, 'norm1_g': norm1_g, 'w_in': w_in, 'conv_w': conv_w, 'conv_b': conv_b,
            'lru_wa': lru_wa, 'lru_ba': lru_ba, 'lru_wx': lru_wx, 'lru_bx': lru_bx,
            'lru_lambda': lru_lambda, 'lru_norm_g': lru_norm_g, 'fox_fb': fox_fb,
            'fox_qnorm_g': fox_qnorm_g, 'fox_knorm_g': fox_knorm_g, 'fox_norm_g': fox_norm_g,
            'rwkv_mu': rwkv_mu, 'rwkv_w0': rwkv_w0, 'rwkv_w2': rwkv_w2, 'rwkv_a0': rwkv_a0,
            'rwkv_a2': rwkv_a2, 'rwkv_g2': rwkv_g2, 'rwkv_kk': rwkv_kk, 'rwkv_ka': rwkv_ka,
            'rwkv_rk': rwkv_rk, 'rwkv_ln_g': rwkv_ln_g, 'rwkv_ln_b': rwkv_ln_b, 'w_out': w_out,
            'norm2_g': norm2_g, 'router_gw': router_gw, 'router_gb': router_gb,
            'router_ew': router_ew, 'router_eb': router_eb, 'exp_w_gate': exp_w_gate,
            'exp_w_up': exp_w_up, 'exp_w_down': exp_w_down}


def reference(x, norm1_g, w_in, conv_w, conv_b, lru_wa, lru_ba, lru_wx, lru_bx, lru_lambda,
              lru_norm_g, fox_fb, fox_qnorm_g, fox_knorm_g, fox_norm_g, rwkv_mu, rwkv_w0,
              rwkv_w2, rwkv_a0, rwkv_a2, rwkv_g2, rwkv_kk, rwkv_ka, rwkv_rk, rwkv_ln_g,
              rwkv_ln_b, w_out, norm2_g, router_gw, router_gb, router_ew, router_eb,
              exp_w_gate, exp_w_up, exp_w_down):
    splits = [LRU_WIDTH, LRU_COLS, LRU_COLS + FOX_WIDTH, LRU_COLS + 2 * FOX_WIDTH,
              LRU_COLS + 3 * FOX_WIDTH, LRU_COLS + FOX_COLS]
    for l in range(DEPTH):
        h = rms_norm(x, norm1_g[l])
        proj = h @ w_in[l]
        xa, ga, q, k, v, fl, pc = jnp.split(proj, splits, axis=-1)
        ya = rglru_group(xa, ga, conv_w[l], conv_b[l], lru_wa[l], lru_ba[l], lru_wx[l],
                         lru_bx[l], lru_lambda[l], lru_norm_g[l])
        yb = fox_group(q, k, v, fl, fox_fb[l], fox_qnorm_g[l], fox_knorm_g[l], fox_norm_g[l])
        yc = rwkv7_group(pc, rwkv_mu[l], rwkv_w0[l], rwkv_w2[l], rwkv_a0[l], rwkv_a2[l],
                         rwkv_g2[l], rwkv_kk[l], rwkv_ka[l], rwkv_rk[l], rwkv_ln_g[l], rwkv_ln_b[l])
        y = jnp.concatenate([ya, yb.astype(x.dtype), yc.astype(x.dtype)], axis=-1)
        x = x + (y @ w_out[l]).astype(x.dtype)
        x = x + hier_moe(rms_norm(x, norm2_g[l]), router_gw[l], router_gb[l], router_ew[l],
                         router_eb[l], exp_w_gate[l], exp_w_up[l], exp_w_down[l])
    return x
```

```cpp
#include <hip/hip_runtime.h>
#include <hip/hip_bf16.h>
#include <cstdio>
#include <cstdint>
#include <cmath>
namespace pg8 {
#define PG8_LAS __attribute__((address_space(3)))
typedef unsigned short bf16_t;
typedef short bf16x8 __attribute__((ext_vector_type(8)));
typedef float f32x4 __attribute__((ext_vector_type(4)));
typedef unsigned u32x4 __attribute__((ext_vector_type(4)));
__device__ __forceinline__ int tid_now() { int t = threadIdx.x; asm volatile("" : "+v"(t)); return t; }
constexpr int BM = 256, BK = 64, HALF = 128, HTB = HALF * BK * 2  , STAGE_BYTES = 8 * HTB, NXCD = 8, WGM = 8;

__host__ __device__ __forceinline__ int lds_byte(int r, int c) { const int st = (r >> 4) * 2 + (c >> 5), rr = r & 15, cc = c & 31, ob = rr * 64 + cc * 2; return st * 1024 + (ob ^ (((ob >> 9) & 1) << 5)); }
__host__ __device__ __forceinline__ void stage_rc(int b, int& R, int& C) { const int st = b / 1024, sb = b % 1024, swz = sb ^ (((sb >> 9) & 1) << 5); R = (st >> 1) * 16 + swz / 64; C = (st & 1) * 32 + (swz % 64) / 2; }
__host__ __device__ __forceinline__ int perm32(int rho) { const int n = rho >> 4, i = rho & 15; return 8 * (i >> 2) + 4 * n + (i & 3); }

struct Unit { int pm, pn; };
struct Gemm { const bf16_t* A; const bf16_t* Bt; int M, N, K; };

struct StaticOrder {
    int nM, nN, nwg, G, c;
    __host__ __device__ void init(int M, int N, int G_, int c_) { nM = M / BM; nN = N / BM; nwg = nM * nN; G = G_; c = c_; }
    __host__ __device__ bool next(int i, Unit& u) const {
        const long L = (long)i * G + c; if (L >= nwg) return false;
        int wgid = (int)L; { const int q = nwg / NXCD, r = nwg % NXCD, xcd = wgid % NXCD, off = wgid / NXCD; wgid = (xcd < r ? xcd * (q + 1) : r * (q + 1) + (xcd - r) * q) + off; }
        const int nig = WGM * nN, gid = wgid / nig, fm = gid * WGM, gsz = (nM - fm) < WGM ? (nM - fm) : WGM;
        u.pm = fm + ((wgid % nig) % gsz); u.pn = (wgid % nig) / gsz; return true;
    }
    __device__ __forceinline__ void a_ready(const Unit&) const {}
    __device__ __forceinline__ void done(const Unit&) const {}
};

__device__ __forceinline__ unsigned cvt_pk_bf16(float lo, float hi) { unsigned r; asm volatile("v_cvt_pk_bf16_f32 %0, %1, %2" : "=v"(r) : "v"(lo), "v"(hi)); return r; }
typedef float f32x2 __attribute__((ext_vector_type(2)));
__device__ __forceinline__ f32x2 gelu_pk(f32x2 v) {
    const f32x2 av = __builtin_elementwise_abs(v), d = av * 0.2316418882f + 1.0f;
    f32x2 t; t.x = __builtin_amdgcn_rcpf(d.x); t.y = __builtin_amdgcn_rcpf(d.y);
    f32x2 q = t * 0.5307027145f + (-0.7265760135f); q = q * t + 0.7107068705f; q = q * t + (-0.142248368f); q = q * t + 0.127414796f; q = q * t;
    const f32x2 s = (v * v) * (-0.72134752044f);
    f32x2 e; e.x = __builtin_amdgcn_exp2f(s.x); e.y = __builtin_amdgcn_exp2f(s.y);
    const f32x2 m = v * (q * e), r = v - m;
    f32x2 o; o.x = v.x < 0.f ? m.x : r.x; o.y = v.y < 0.f ? m.y : r.y; return o;
}

template <int ACT  > struct EpiBf16 {
    static constexpr bool PERM = true, AFTER_DRAIN = false; static_assert(ACT == 0 || ACT == 1, "EpiBf16: ACT is 0 (none) or 1 (gelu_pk)");
    bf16_t* O; int ldc; const float* bias; int split_cols; size_t split_stride; float scale0;
    __device__ __forceinline__ void operator()(const f32x4 (&acc)[2][2][4][2], const Unit& u, int wr, int wc, int fr, int fq) const {
        const int row0 = u.pm * BM + wr * 64 + fr; int colt = u.pn * BM; bf16_t* base = O;
        float sc = 1.f; if (split_cols) { const int t = colt / split_cols; base += (size_t)t * split_stride; colt -= t * split_cols; if (t == 0) sc = scale0; }
        const int col0 = colt + wc * 32 + 8 * fq, bcol0 = u.pn * BM + wc * 32 + 8 * fq;
        f32x4 bv[2][2];
#pragma unroll
        for (int bj = 0; bj < 2; ++bj)
#pragma unroll
            for (int n = 0; n < 2; ++n) bv[bj][n] = bias ? *(const f32x4*)(bias + bcol0 + bj * HALF + 4 * n) : (f32x4){0.f, 0.f, 0.f, 0.f};
#pragma unroll
        for (int ai = 0; ai < 2; ++ai)
#pragma unroll
            for (int m = 0; m < 4; ++m) { bf16_t* rowp = base + (size_t)(row0 + ai * HALF + m * 16) * ldc + col0;
#pragma unroll
                for (int bj = 0; bj < 2; ++bj) { f32x4 v0 = acc[ai][bj][m][0] + bv[bj][0], v1 = acc[ai][bj][m][1] + bv[bj][1];
                    if (ACT == 1) { f32x2 a = gelu_pk((f32x2){v0[0], v0[1]}), b = gelu_pk((f32x2){v0[2], v0[3]}), c = gelu_pk((f32x2){v1[0], v1[1]}), d = gelu_pk((f32x2){v1[2], v1[3]});
                        v0 = (f32x4){a.x, a.y, b.x, b.y}; v1 = (f32x4){c.x, c.y, d.x, d.y}; }
                    v0 = v0 * sc; v1 = v1 * sc; u32x4 w; w.x = cvt_pk_bf16(v0[0], v0[1]); w.y = cvt_pk_bf16(v0[2], v0[3]); w.z = cvt_pk_bf16(v1[0], v1[1]); w.w = cvt_pk_bf16(v1[2], v1[3]);
                    *(u32x4*)(rowp + bj * HALF) = w; } }
    }
};
template <class Epi, class Sched, bool ALIGN_EPI = false, bool SP2 = false>
__device__ __forceinline__ void gemm_phase(PG8_LAS unsigned char* lds, const Gemm g, const Sched& S, const Epi& E) {
    const int tid = tid_now(), wid = __builtin_amdgcn_readfirstlane(tid >> 6), lane = tid & 63, wr = wid >> 2, wc = wid & 3, fr = lane & 15, fq = lane >> 4;
    const int K = g.K, nt = K / BK;
    unsigned voffA[2], voffB[2];
#pragma unroll
    for (int i = 0; i < 2; ++i) { int R, C; stage_rc(tid * 16 + i * 8192, R, C); const int Rb = Epi::PERM ? ((R & ~31) + perm32(R & 31)) : R;
        voffA[i] = (unsigned)(R * K + C) * 2u; voffB[i] = (unsigned)(Rb * K + C) * 2u; }
    const size_t kstep = (size_t)(BK * 2);
    const size_t hstep = (size_t)HALF * K * 2;
    const size_t tstep = 2 * hstep;
    const unsigned ldsw = (unsigned)wid * 1024u;
    const int aoff = lds_byte(wr * 64 + fr, fq * 8), boff = lds_byte(wc * 32 + fr, fq * 8);
#define PG8_SA(b, h) (((b) * 2 + (h)) * HTB)
#define PG8_SB(b, h) ((4 + (b) * 2 + (h)) * HTB)
#define PG8_STAGE(bufoff, gbase, voff) do { _Pragma("unroll") for (int _i = 0; _i < 2; ++_i) \
        __builtin_amdgcn_global_load_lds((const unsigned*)((const char*)(gbase) + (voff)[_i]), (PG8_LAS unsigned*)(lds + (bufoff) + ldsw + _i * 8192), 16, 0, 0); } while (0)
#define PG8_LDA(dst, b, h) do { _Pragma("unroll") for (int m = 0; m < 4; ++m) _Pragma("unroll") for (int k = 0; k < 2; ++k) dst[m][k] = *(const PG8_LAS bf16x8*)(lds + PG8_SA(b, h) + aoff + m * 2048 + k * 1024); } while (0)
#define PG8_LDB(dst, b, h) do { _Pragma("unroll") for (int n = 0; n < 2; ++n) _Pragma("unroll") for (int k = 0; k < 2; ++k) dst[n][k] = *(const PG8_LAS bf16x8*)(lds + PG8_SB(b, h) + boff + n * 2048 + k * 1024); } while (0)
#define PG8_MMA(ai, bj, At, Bt) do { __builtin_amdgcn_s_setprio(1); _Pragma("unroll") for (int m = 0; m < 4; ++m) _Pragma("unroll") for (int n = 0; n < 2; ++n) _Pragma("unroll") for (int k = 0; k < 2; ++k) \
        acc[ai][bj][m][n] = __builtin_amdgcn_mfma_f32_16x16x32_bf16(Bt[n][k], At[m][k], acc[ai][bj][m][n], 0, 0, 0); __builtin_amdgcn_s_setprio(0); } while (0)
#define PG8_WAIT_V(n) asm volatile("s_waitcnt vmcnt(" #n ")" ::: "memory")
#define PG8_WAIT_L(n) asm volatile("s_waitcnt lgkmcnt(" #n ")" ::: "memory")
#define PG8_BAR __builtin_amdgcn_s_barrier()
#define PG8_SCHED __builtin_amdgcn_sched_barrier(0)
    Unit cur, nxt; int ui = 0;
    if (!S.next(0, cur)) return;
    f32x4 acc[2][2][4][2];
#pragma unroll
    for (int a = 0; a < 2; ++a)
#pragma unroll
        for (int b = 0; b < 2; ++b)
#pragma unroll
            for (int m = 0; m < 4; ++m)
#pragma unroll
                for (int n = 0; n < 2; ++n) acc[a][b][m][n] = (f32x4){0.f, 0.f, 0.f, 0.f};
    bf16x8 At[4][2], B0[2][2], B1[2][2];
    const char* cA = (const char*)g.A + (size_t)cur.pm * tstep; const char* cB = (const char*)g.Bt + (size_t)cur.pn * tstep;
    S.a_ready(cur);
    if constexpr (SP2) {
        PG8_STAGE(PG8_SB(0, 0), cB, voffB); PG8_STAGE(PG8_SB(0, 1), cB + hstep, voffB); PG8_STAGE(PG8_SA(0, 0), cA, voffA); PG8_STAGE(PG8_SA(0, 1), cA + hstep, voffA);
        if (wr == 1) PG8_BAR;
        PG8_WAIT_V(2); PG8_BAR;
        PG8_STAGE(PG8_SB(1, 0), cB + kstep, voffB); PG8_STAGE(PG8_SA(1, 0), cA + kstep, voffA); PG8_STAGE(PG8_SB(1, 1), cB + hstep + kstep, voffB);
        PG8_WAIT_V(6); PG8_BAR;
    } else {
        PG8_STAGE(PG8_SB(0, 0), cB, voffB); PG8_STAGE(PG8_SA(0, 0), cA, voffA); PG8_STAGE(PG8_SB(0, 1), cB + hstep, voffB); PG8_STAGE(PG8_SA(0, 1), cA + hstep, voffA);
        if (wr == 1) PG8_BAR;
        PG8_WAIT_V(4); PG8_BAR;
        PG8_STAGE(PG8_SB(1, 0), cB + kstep, voffB); PG8_STAGE(PG8_SA(1, 0), cA + kstep, voffA); PG8_STAGE(PG8_SB(1, 1), cB + hstep + kstep, voffB);
        PG8_WAIT_V(6); PG8_BAR;
    }
    for (;;) {
        const bool has_next = S.next(ui + 1, nxt);
        const char* nA = has_next ? (const char*)g.A + (size_t)nxt.pm * tstep : cA; const char* nB = has_next ? (const char*)g.Bt + (size_t)nxt.pn * tstep : cB;
        for (int t = 0; t < nt; t += 2) {
            const bool last = (t == nt - 2);
            const char* a1 = cA + (size_t)(t + 1) * kstep;
            const char* a2 = last ? nA : cA + (size_t)(t + 2) * kstep; const char* b2 = last ? nB : cB + (size_t)(t + 2) * kstep;
            const char* a3 = a2 + kstep; const char* b3 = b2 + kstep;
            if (last && has_next) S.a_ready(nxt);
            if constexpr (SP2) {
            PG8_LDB(B0, 0, 0); PG8_LDB(B1, 0, 1); PG8_SCHED; PG8_LDA(At, 0, 0); PG8_STAGE(PG8_SA(1, 1), a1 + hstep, voffA);
            PG8_WAIT_V(8); PG8_WAIT_L(0); PG8_BAR; PG8_MMA(0, 0, At, B0); PG8_MMA(0, 1, At, B1); PG8_BAR; PG8_SCHED;
            PG8_LDA(At, 0, 1); PG8_STAGE(PG8_SB(0, 0), b2, voffB); PG8_STAGE(PG8_SB(0, 1), b2 + hstep, voffB); PG8_STAGE(PG8_SA(0, 0), a2, voffA);
            PG8_WAIT_V(8); PG8_WAIT_L(0); PG8_BAR; PG8_MMA(1, 0, At, B0); PG8_MMA(1, 1, At, B1); PG8_BAR; PG8_SCHED;
            PG8_LDB(B0, 1, 0); PG8_LDB(B1, 1, 1); PG8_SCHED; PG8_LDA(At, 1, 0); PG8_STAGE(PG8_SA(0, 1), a2 + hstep, voffA);
            PG8_WAIT_V(8); PG8_WAIT_L(0); PG8_BAR; PG8_MMA(0, 0, At, B0); PG8_MMA(0, 1, At, B1); PG8_BAR; PG8_SCHED;
            PG8_LDA(At, 1, 1); PG8_STAGE(PG8_SB(1, 0), b3, voffB); PG8_STAGE(PG8_SB(1, 1), b3 + hstep, voffB); PG8_STAGE(PG8_SA(1, 0), a3, voffA);
            PG8_WAIT_V(8); PG8_WAIT_L(0); PG8_BAR; PG8_MMA(1, 0, At, B0); PG8_MMA(1, 1, At, B1); PG8_BAR; PG8_SCHED;
            } else {
            PG8_LDB(B0, 0, 0); PG8_SCHED; PG8_LDA(At, 0, 0); PG8_STAGE(PG8_SA(1, 1), a1 + hstep, voffA);
            PG8_WAIT_L(8); PG8_BAR; PG8_WAIT_L(0); PG8_MMA(0, 0, At, B0); PG8_BAR; PG8_SCHED;
            PG8_LDB(B1, 0, 1); PG8_STAGE(PG8_SB(0, 0), b2, voffB);
            PG8_BAR; PG8_WAIT_L(0); PG8_MMA(0, 1, At, B1); PG8_BAR;
            PG8_LDA(At, 0, 1); PG8_STAGE(PG8_SA(0, 0), a2, voffA);
            PG8_BAR; PG8_WAIT_L(0); PG8_MMA(1, 0, At, B0); PG8_BAR; PG8_SCHED;
            PG8_STAGE(PG8_SB(0, 1), b2 + hstep, voffB);
            PG8_WAIT_V(6); PG8_BAR; PG8_MMA(1, 1, At, B1); PG8_BAR;
            PG8_LDB(B0, 1, 0); PG8_SCHED; PG8_LDA(At, 1, 0); PG8_STAGE(PG8_SA(0, 1), a2 + hstep, voffA);
            PG8_WAIT_L(8); PG8_BAR; PG8_WAIT_L(0); PG8_MMA(0, 0, At, B0); PG8_BAR; PG8_SCHED;
            PG8_LDB(B1, 1, 1); PG8_STAGE(PG8_SB(1, 0), b3, voffB);
            PG8_BAR; PG8_WAIT_L(0); PG8_MMA(0, 1, At, B1); PG8_BAR;
            PG8_LDA(At, 1, 1); PG8_STAGE(PG8_SA(1, 0), a3, voffA);
            PG8_BAR; PG8_WAIT_L(0); PG8_MMA(1, 0, At, B0); PG8_BAR; PG8_SCHED;
            PG8_STAGE(PG8_SB(1, 1), b3 + hstep, voffB);
            PG8_WAIT_V(6); PG8_BAR; PG8_MMA(1, 1, At, B1); PG8_BAR;
            }
        }
        if constexpr (ALIGN_EPI) { if (wr == 0) PG8_BAR; }
        if constexpr (!Epi::AFTER_DRAIN) { E(acc, cur, wr, wc, fr, fq); S.done(cur); }
        if (!has_next) break;
#pragma unroll
        for (int a = 0; a < 2; ++a)
#pragma unroll
            for (int b = 0; b < 2; ++b)
#pragma unroll
                for (int m = 0; m < 4; ++m)
#pragma unroll
                    for (int n = 0; n < 2; ++n) acc[a][b][m][n] = (f32x4){0.f, 0.f, 0.f, 0.f};
        cur = nxt; cA = nA; cB = nB; ++ui;
        if constexpr (ALIGN_EPI) { if (wr == 1) PG8_BAR; }
    }
    PG8_WAIT_V(0);
    if constexpr (!ALIGN_EPI) { if (wr == 0) PG8_BAR; }
    PG8_BAR;
    if constexpr (Epi::AFTER_DRAIN) { E.fused(acc, cur, wr, wc, fr, fq, lds, wid, lane); S.done(cur); }
#undef PG8_SA
#undef PG8_SB
#undef PG8_STAGE
#undef PG8_LDA
#undef PG8_LDB
#undef PG8_MMA
#undef PG8_WAIT_V
#undef PG8_WAIT_L
#undef PG8_BAR
#undef PG8_SCHED
}
}
namespace attn_body {
using bf16=__hip_bfloat16;
using bf16x8=__attribute__((ext_vector_type(8)))short;
using s16x4=__attribute__((ext_vector_type(4)))short;
using f32x16=__attribute__((ext_vector_type(16)))float;
using u32x4=__attribute__((ext_vector_type(4)))unsigned;
constexpr int BATCH=4,NHEAD=8,SEQ=4096,D=64,PQ=3072,PO=1024;
typedef float f32x4_t __attribute__((ext_vector_type(4)));
__device__ __forceinline__ int lane_now(){int l;asm volatile("v_mbcnt_lo_u32_b32 %0, -1, 0\n\tv_mbcnt_hi_u32_b32 %0, -1, %0":"=v"(l));return l;}
constexpr int NW=8,QBLK=32,QB=QBLK*NW,KVBLK=64,NQB=SEQ/QB;
constexpr int ATTN_UNIT_ROWS=QB;
__device__ __forceinline__ int crow(int r,int hi){return (r&3)+8*(r>>2)+4*hi;}
#define SBAR() __builtin_amdgcn_sched_barrier(0)
__device__ __forceinline__ void cmask(f32x16&p0,f32x16&p1,int jb,int qrel,int hi){
  const float NEG=-INFINITY; int kb=64*jb+4*hi;
  #pragma unroll
  for(int r=0;r<16;++r){int kv=kb+(r&3)+8*(r>>2); if(kv>qrel)p0[r]=NEG; if(kv+32>qrel)p1[r]=NEG;}
}

constexpr int NSLOT=3, SLOTB=8192;
constexpr int LDS_K=0, LDS_V=NSLOT*SLOTB, LDS_WS=2*NSLOT*SLOTB, LDS_OST=LDS_WS+NW*64*4, LDS_BYTES=LDS_OST+NW*4096;
constexpr float C2=0.125f*1.4426950408889634f;
__device__ __forceinline__ void glds16(const void*gsrc,unsigned lds_dst){unsigned keep;
  asm volatile("s_mov_b32 %0, m0\n\ts_mov_b32 m0, %2\n\ts_nop 0\n\tglobal_load_lds_dwordx4 %1, off\n\ts_mov_b32 m0, %0":"=&s"(keep):"v"(gsrc),"s"(lds_dst):"memory");}
__device__ __forceinline__ float max3f(float a,float b,float c){float r;asm("v_max3_f32 %0, %1, %2, %3":"=v"(r):"v"(a),"v"(b),"v"(c));return r;}
__device__ __forceinline__ float max2f(float a,float b){float r;asm("v_max_f32_e32 %0, %1, %2":"=v"(r):"v"(a),"v"(b));return r;}
__device__ __forceinline__ float fadd_s(float a,float b){float r;asm("v_add_f32_e32 %0, %1, %2":"=v"(r):"v"(a),"v"(b));return r;}
__device__ __forceinline__ float fsub_s(float a,float b){float r;asm("v_sub_f32_e32 %0, %1, %2":"=v"(r):"v"(a),"v"(b));return r;}
typedef float f32x2_t __attribute__((ext_vector_type(2))); typedef __bf16 bf16x2_t __attribute__((ext_vector_type(2)));
__device__ __forceinline__ unsigned cvtpk_s(float lo,float hi){f32x2_t v={lo,hi};bf16x2_t b=__builtin_convertvector(v,bf16x2_t);return __builtin_bit_cast(unsigned,b);}
#define WAIT_BAR(N) asm volatile("s_waitcnt vmcnt(" #N ") lgkmcnt(0)\n\ts_barrier":::"memory")

__device__ __forceinline__ void qkt(f32x16&p0,f32x16&p1,const char*Kslot,const bf16x8*qr,int r32,int hi){ const f32x16 negm=f32x16{};
  const char*kb=Kslot+hi*1024+r32*16;
  #pragma unroll
  for(int d0=0;d0<4;++d0){
    const bf16x8 b0=*reinterpret_cast<const bf16x8*>(kb+d0*2048);
    const bf16x8 b1=*reinterpret_cast<const bf16x8*>(kb+d0*2048+512);
    if(d0==0){p0=__builtin_amdgcn_mfma_f32_32x32x16_bf16(b0,qr[0],negm,0,0,0);p1=__builtin_amdgcn_mfma_f32_32x32x16_bf16(b1,qr[0],negm,0,0,0);}
    else{p0=__builtin_amdgcn_mfma_f32_32x32x16_bf16(b0,qr[d0],p0,0,0,0);p1=__builtin_amdgcn_mfma_f32_32x32x16_bf16(b1,qr[d0],p1,0,0,0);}}
}
typedef __attribute__((address_space(3))) const char* lds_cptr;
typedef short v4i16_t __attribute__((ext_vector_type(4)));
__device__ __forceinline__ void kload8(bf16x8*kf,lds_cptr kp){
  kf[0]=*(const __attribute__((address_space(3))) bf16x8*)(kp);      kf[1]=*(const __attribute__((address_space(3))) bf16x8*)(kp+512);
  kf[2]=*(const __attribute__((address_space(3))) bf16x8*)(kp+2048); kf[3]=*(const __attribute__((address_space(3))) bf16x8*)(kp+2560);
  kf[4]=*(const __attribute__((address_space(3))) bf16x8*)(kp+4096); kf[5]=*(const __attribute__((address_space(3))) bf16x8*)(kp+4608);
  kf[6]=*(const __attribute__((address_space(3))) bf16x8*)(kp+6144); kf[7]=*(const __attribute__((address_space(3))) bf16x8*)(kp+6656);
}
__device__ __forceinline__ void kload2(bf16x8*kf,lds_cptr kp,int j){ kf[2*j]=*(const __attribute__((address_space(3))) bf16x8*)(kp+j*2048); kf[2*j+1]=*(const __attribute__((address_space(3))) bf16x8*)(kp+j*2048+512); }
__device__ __forceinline__ s16x4 vtr(lds_cptr p){ return __builtin_bit_cast(s16x4,__builtin_amdgcn_ds_read_tr16_b64_v4i16((__attribute__((address_space(3))) v4i16_t*)p)); }
__device__ __forceinline__ float rowmax(const f32x16&p0,const f32x16&p1){
  float a=max3f(p0[0],p0[1],p1[0]),b=max3f(p0[2],p0[3],p1[1]);a=max3f(a,p1[2],p1[3]);
  #pragma unroll
  for(int r=4;r<16;r+=4){a=max3f(a,p0[r],p0[r+1]);b=max3f(b,p0[r+2],p0[r+3]);a=max3f(a,p1[r],p1[r+1]);b=max3f(b,p1[r+2],p1[r+3]);}
  const float m=max2f(a,b);
  auto rr=__builtin_amdgcn_permlane32_swap(__float_as_uint(m),__float_as_uint(m),false,false);
  return max2f(__uint_as_float(rr[0]),__uint_as_float(rr[1]));
}
__device__ __forceinline__ void pv(f32x16*o,int vb,bf16x8 pa0,bf16x8 pa1,bf16x8 pa2,bf16x8 pa3){
  #pragma unroll
  for(int d0=0;d0<2;++d0){s16x4 lo[4],hi[4];
    #pragma unroll
    for(int ks=0;ks<4;++ks){
      asm volatile("ds_read_b64_tr_b16 %0,%1 offset:%c2":"=&v"(lo[ks]):"v"(vb),"i"(d0*4096+ks*1024):"memory");
      asm volatile("ds_read_b64_tr_b16 %0,%1 offset:%c2":"=&v"(hi[ks]):"v"(vb),"i"(d0*4096+ks*1024+512):"memory");}
    asm volatile("s_waitcnt lgkmcnt(0)":::"memory");SBAR();
    #define PK(k) (bf16x8){lo[k][0],lo[k][1],lo[k][2],lo[k][3],hi[k][0],hi[k][1],hi[k][2],hi[k][3]}
    o[d0]=__builtin_amdgcn_mfma_f32_32x32x16_bf16(pa0,PK(0),o[d0],0,0,0);
    o[d0]=__builtin_amdgcn_mfma_f32_32x32x16_bf16(pa1,PK(1),o[d0],0,0,0);
    o[d0]=__builtin_amdgcn_mfma_f32_32x32x16_bf16(pa2,PK(2),o[d0],0,0,0);
    o[d0]=__builtin_amdgcn_mfma_f32_32x32x16_bf16(pa3,PK(3),o[d0],0,0,0);
    #undef PK
  }
}

#ifndef ATTN_STORE16
#define ATTN_STORE16(p,v) (*(u32x4*)(p)=(v))
#endif
template<int THRL> __device__ __forceinline__ void attn_unit(int b,int h,int qb,const bf16*Q,const bf16*__restrict__ K,const bf16*__restrict__ V,bf16*O,char*shm,const char*cs){
  const int tid=pg8::tid_now(),lane=tid&63,r32=lane&31,hi=lane>>5; const int wid=__builtin_amdgcn_readfirstlane(tid>>6);
  const long rowbase=(long)b*SEQ; const int q0=qb*QB;
  const bf16*Qw=Q+(rowbase+q0+wid*QBLK)*PQ+h*D;
  const bf16*Kh=K+rowbase*PQ+h*D,*Vh=V+rowbase*PQ+h*D;
  const unsigned lds0=(unsigned)(uintptr_t)shm;
  float*wsf=(float*)(shm+LDS_WS)+wid*64;
  const bf16*ksrc=Kh+(long)lane*PQ+wid*8;
  const bf16*vsrc=Vh+(long)(16*(wid&3)+(lane>>2))*PQ+(wid>>2)*32+(lane&3)*8;
  const unsigned kdst=lds0+LDS_K+wid*1024, vdst=lds0+LDS_V+wid*1024;
  #define DMA_K(t,slot) glds16(ksrc+(long)(t)*KVBLK*PQ,(unsigned)__builtin_amdgcn_readfirstlane(kdst+(slot)))
  #define DMA_V(t,slot) glds16(vsrc+(long)(t)*KVBLK*PQ,(unsigned)__builtin_amdgcn_readfirstlane(vdst+(slot)))
  const int vb0=(int)(lds0+LDS_V)+((lane>>4)&1)*32+(lane&3)*8+(4*hi+((lane&15)>>2))*64;
  const char*Kbase=shm+LDS_K; bf16x8 kf[8];
  const lds_cptr shm3=(lds_cptr)shm; const lds_cptr kp0=shm3+LDS_K+hi*1024+r32*16; const lds_cptr vp0=shm3+LDS_V+((lane>>4)&1)*32+(lane&3)*8+(4*hi+((lane&15)>>2))*64;
  const int NT=(q0+QB)/KVBLK;
  DMA_K(0,0);DMA_V(0,0);DMA_K(1,SLOTB);
  bf16x8 qr[4];
  #pragma unroll
  for(int d0=0;d0<4;++d0)qr[d0]=*reinterpret_cast<const bf16x8*>(&Qw[(long)r32*PQ+d0*16+hi*8]);
  float mhat=0.f,l_reg=0.f;f32x16 o[2];o[0]=f32x16{};o[1]=f32x16{};const f32x16 zero16=f32x16{};
  const int qrel=wid*QBLK+r32;
  #define CMASK(P0,P1,t) do{int jb_=(t)-(NT-4); if(jb_>=0)cmask(P0,P1,jb_,qrel,hi);}while(0)
  const lds_cptr csb=(lds_cptr)cs+hi*16;
  #define BIAS(P0,P1,t) do{ const __attribute__((address_space(3))) f32x4_t* cb_=(const __attribute__((address_space(3))) f32x4_t*)(csb+(t)*256); const float nm_=-mhat; \
    _Pragma("unroll") for(int g_=0;g_<4;++g_){ const f32x4_t v0_=cb_[2*g_]+nm_; \
      P0[4*g_]+=v0_[0];P0[4*g_+1]+=v0_[1];P0[4*g_+2]+=v0_[2];P0[4*g_+3]+=v0_[3]; if(g_&1)SBAR(); } \
    _Pragma("unroll") for(int g_=0;g_<4;++g_){ const f32x4_t v1_=cb_[8+2*g_]+nm_; \
      P1[4*g_]+=v1_[0];P1[4*g_+1]+=v1_[1];P1[4*g_+2]+=v1_[2];P1[4*g_+3]+=v1_[3]; if(g_&1)SBAR(); } }while(0)
  bool resc=false;
  #define START(P0,P1) do{ const float rm=rowmax(P0,P1); resc=false; \
    { const float dl=rm; mhat=fadd_s(mhat,dl); \
      _Pragma("unroll") for(int r=0;r<16;++r){P0[r]=fsub_s(P0[r],dl);P1[r]=fsub_s(P1[r],dl);} \
    } \
    _Pragma("unroll") for(int r=0;r<16;++r)P0[r]=__builtin_amdgcn_exp2f(P0[r]); }while(0)
  #define RESC() do{ if(resc){ asm volatile("s_waitcnt lgkmcnt(0)":::"memory"); \
      _Pragma("unroll") for(int d_=0;d_<2;++d_) _Pragma("unroll") for(int r=0;r<16;++r)o[d_][r]*=wsf[crow(r,hi)]; } }while(0)
  f32x16 pA0,pA1,pB0,pB1;
  int sl_prev=0,sl_cur=0,sl_next=SLOTB;
  #define ROT() do{sl_prev=sl_cur;sl_cur=sl_next;sl_next=(sl_next==(NSLOT-1)*SLOTB)?0:sl_next+SLOTB;}while(0)
  DMA_K(2,2*SLOTB);
  WAIT_BAR(3);
  qkt(pA0,pA1,Kbase,qr,r32,hi);asm volatile("s_nop 15\n\ts_nop 7":"+v"(pA0),"+v"(pA1));BIAS(pA0,pA1,0);CMASK(pA0,pA1,0);
  START(pA0,pA1);
  _Pragma("unroll") for(int r=0;r<16;++r)pA1[r]=__builtin_amdgcn_exp2f(pA1[r]);
  WAIT_BAR(0);
  DMA_K(3,0);DMA_V(1,SLOTB);
  ROT();
  kload8(kf,kp0+sl_cur);
  WAIT_BAR(2);
  s16x4 vlo[8],vhi[8]; u32x4 pw0,pw1,pw2,pw3;
  #define PKW(P,B) cvtpk_s(P[B],P[B+1])
  #define PAF(k) __builtin_bit_cast(bf16x8,pw##k)
  #define VFR(i) (bf16x8){vlo[i][0],vlo[i][1],vlo[i][2],vlo[i][3],vhi[i][0],vhi[i][1],vhi[i][2],vhi[i][3]}
  #define PIN(x) asm volatile("":"+v"(x))
  #define MX3(a,b,c) __builtin_fmaxf(__builtin_fmaxf((a),(b)),(c))
  #define GAPA(MF,A0,A1,A2,A3,W0,W1,PW) do{ MF; sacc+=A0; sacc+=A1; sacc+=A2; sacc+=A3; PIN(sacc); W0; W1; PIN(PW); SBAR(); }while(0)
  #define EX(v) __builtin_amdgcn_exp2f(v)
  #define GAPB(MF,X,B) do{ MF; X[B]=EX(X[B]); X[B+1]=EX(X[B+1]); X[B+2]=EX(X[B+2]); X[B+3]=EX(X[B+3]); PIN(X); SBAR(); }while(0)
  #define VRD(i) do{ vlo[i]=vtr(vp_+(((i)>>2)*4096+((i)&3)*1024)); vhi[i]=vtr(vp_+(((i)>>2)*4096+((i)&3)*1024+512)); }while(0)
  #define KRD(G,j) do{ if(G){ kload2(kf,kp0+sl_next,j); SBAR(); } }while(0)
  #define STEP(C0,C1,P0,P1,t,GK,GV,GL) do{ SBAR(); \
    const lds_cptr vp_=vp0+sl_prev; \
    VRD(0); SBAR(); float sacc=(P0[0]+P0[1]); \
    GAPA(C0=__builtin_amdgcn_mfma_f32_32x32x16_bf16(kf[0],qr[0],zero16,0,0,0), P0[2],P0[3],P0[4],P0[5],     pw0[0]=PKW(P0,0), pw0[1]=PKW(P0,2), pw0); \
    VRD(4); SBAR(); GAPA(C1=__builtin_amdgcn_mfma_f32_32x32x16_bf16(kf[1],qr[0],zero16,0,0,0), P0[6],P0[7],P0[8],P0[9],     pw0[2]=PKW(P0,4), pw0[3]=PKW(P0,6), pw0); \
    VRD(1); SBAR(); GAPA(C0=__builtin_amdgcn_mfma_f32_32x32x16_bf16(kf[2],qr[1],C0,0,0,0),   P0[10],P0[11],P0[12],P0[13], pw1[0]=PKW(P0,8), pw1[1]=PKW(P0,10), pw1); \
    VRD(5); SBAR(); GAPA(C1=__builtin_amdgcn_mfma_f32_32x32x16_bf16(kf[3],qr[1],C1,0,0,0),   P0[14],P0[15],P1[0],P1[1],   pw1[2]=PKW(P0,12),pw1[3]=PKW(P0,14), pw1); \
    VRD(2); SBAR(); GAPA(C0=__builtin_amdgcn_mfma_f32_32x32x16_bf16(kf[4],qr[2],C0,0,0,0),   P1[2],P1[3],P1[4],P1[5],     pw2[0]=PKW(P1,0), pw2[1]=PKW(P1,2), pw2); \
    VRD(6); SBAR(); GAPA(C1=__builtin_amdgcn_mfma_f32_32x32x16_bf16(kf[5],qr[2],C1,0,0,0),   P1[6],P1[7],P1[8],P1[9],     pw2[2]=PKW(P1,4), pw2[3]=PKW(P1,6), pw2); \
    VRD(3); SBAR(); GAPA(C0=__builtin_amdgcn_mfma_f32_32x32x16_bf16(kf[6],qr[3],C0,0,0,0),   P1[10],P1[11],P1[12],P1[13], pw3[0]=PKW(P1,8), pw3[1]=PKW(P1,10), pw3); \
    VRD(7); SBAR(); GAPA(C1=__builtin_amdgcn_mfma_f32_32x32x16_bf16(kf[7],qr[3],C1,0,0,0),   P1[14],P1[15],0.f,0.f,       pw3[2]=PKW(P1,12),pw3[3]=PKW(P1,14), pw3); \
    l_reg+=sacc; \
    if(GK){DMA_K((t)+3,sl_cur);} if(GV){DMA_V((t)+1,sl_next);} \
    BIAS(C0,C1,t); CMASK(C0,C1,t); \
    { float a=MX3(C0[0],C0[1],C1[0]),b=MX3(C0[2],C0[3],C1[1]); a=MX3(a,C1[2],C1[3]); \
      _Pragma("unroll") for(int r=4;r<16;r+=4){a=MX3(a,C0[r],C0[r+1]);b=MX3(b,C0[r+2],C0[r+3]);a=MX3(a,C1[r],C1[r+1]);b=MX3(b,C1[r+2],C1[r+3]);} \
      float rm=__builtin_fmaxf(a,b); { auto rr=__builtin_amdgcn_permlane32_swap(__float_as_uint(rm),__float_as_uint(rm),false,false); rm=__builtin_fmaxf(__uint_as_float(rr[0]),__uint_as_float(rr[1])); } \
      resc=false; \
      if(__builtin_expect(__any(rm>(float)THRL),0)){ const float dl=__builtin_fmaxf(rm,0.f); mhat+=dl; \
        _Pragma("unroll") for(int r=0;r<16;++r){C0[r]-=dl;C1[r]-=dl;} \
        const float f=__builtin_amdgcn_exp2f(-dl); l_reg*=f; if(hi==0)wsf[r32]=f; resc=true; } } \
    SBAR(); \
    GAPB(o[0]=__builtin_amdgcn_mfma_f32_32x32x16_bf16(PAF(0),VFR(0),o[0],0,0,0), C0,0); \
    GAPB(o[1]=__builtin_amdgcn_mfma_f32_32x32x16_bf16(PAF(0),VFR(4),o[1],0,0,0), C0,4); \
    KRD(GL,0); GAPB(o[0]=__builtin_amdgcn_mfma_f32_32x32x16_bf16(PAF(1),VFR(1),o[0],0,0,0), C0,8); \
    KRD(GL,1); GAPB(o[1]=__builtin_amdgcn_mfma_f32_32x32x16_bf16(PAF(1),VFR(5),o[1],0,0,0), C0,12); \
    KRD(GL,2); GAPB(o[0]=__builtin_amdgcn_mfma_f32_32x32x16_bf16(PAF(2),VFR(2),o[0],0,0,0), C1,0); \
    KRD(GL,3); GAPB(o[1]=__builtin_amdgcn_mfma_f32_32x32x16_bf16(PAF(2),VFR(6),o[1],0,0,0), C1,4); \
    GAPB(o[0]=__builtin_amdgcn_mfma_f32_32x32x16_bf16(PAF(3),VFR(3),o[0],0,0,0), C1,8); \
    GAPB(o[1]=__builtin_amdgcn_mfma_f32_32x32x16_bf16(PAF(3),VFR(7),o[1],0,0,0), C1,12); \
    }while(0)
  int t=1;
  #undef CMASK
  #define CMASK(P0,P1,t) do{}while(0)
  for(;t+5<NT;t+=2){
    STEP(pB0,pB1,pA0,pA1,t,true,true,true);     WAIT_BAR(2); RESC(); ROT();
    STEP(pA0,pA1,pB0,pB1,t+1,true,true,true);   WAIT_BAR(2); RESC(); ROT();
  }
  #undef CMASK
  #define CMASK(P0,P1,t) do{int jb_=(t)-(NT-4); if(jb_>=0)cmask(P0,P1,jb_,qrel,hi);}while(0)
  #define ENDW(tt) do{ if((tt)+3<NT){WAIT_BAR(2);} else if((tt)+2<NT){WAIT_BAR(1);} else {WAIT_BAR(0);} }while(0)
  for(;t+1<NT;t+=2){
    STEP(pB0,pB1,pA0,pA1,t,(t+3<NT),(t+1<NT),(t+1<NT));       ENDW(t);   RESC(); ROT();
    STEP(pA0,pA1,pB0,pB1,t+1,(t+4<NT),(t+2<NT),(t+2<NT));     ENDW(t+1); RESC(); ROT();
  }
  STEP(pB0,pB1,pA0,pA1,NT-1,false,false,false); RESC();
  { float sacc=pB0[0]+pB0[1]; _Pragma("unroll") for(int r=2;r<16;++r)sacc+=pB0[r]; _Pragma("unroll") for(int r=0;r<16;++r)sacc+=pB1[r]; l_reg+=sacc;
    pw0=(u32x4){PKW(pB0,0),PKW(pB0,2),PKW(pB0,4),PKW(pB0,6)};pw1=(u32x4){PKW(pB0,8),PKW(pB0,10),PKW(pB0,12),PKW(pB0,14)};pw2=(u32x4){PKW(pB1,0),PKW(pB1,2),PKW(pB1,4),PKW(pB1,6)};pw3=(u32x4){PKW(pB1,8),PKW(pB1,10),PKW(pB1,12),PKW(pB1,14)};
    SBAR(); pv(o,vb0+sl_cur,PAF(0),PAF(1),PAF(2),PAF(3)); }
  #undef PKW
  #undef PAF
  #undef VFR
  #undef PIN
  #undef MX3
  #undef GAPA
  #undef GAPB
  #undef EX
  #undef VRD
  #undef KRD
  #undef STEP
  #undef ENDW
  {auto rr=__builtin_amdgcn_permlane32_swap(__float_as_uint(l_reg),__float_as_uint(l_reg),false,false);l_reg=__uint_as_float(rr[0])+__uint_as_float(rr[1]);}
  if(hi==0)wsf[32+r32]=l_reg;asm volatile("s_waitcnt lgkmcnt(0)":::"memory");
  float rli[16];
  #pragma unroll
  for(int r=0;r<16;++r)rli[r]=__builtin_amdgcn_rcpf(wsf[32+crow(r,hi)]);
  bf16*Ow=O+(rowbase+q0+wid*QBLK)*PO+h*D;
  { bf16*stg=(bf16*)(shm+LDS_OST)+wid*2048;
    #pragma unroll
    for(int r=0;r<16;++r){const int orow=crow(r,hi);
      #pragma unroll
      for(int d0=0;d0<2;++d0)stg[orow*64+d0*32+r32]=__float2bfloat16(o[d0][r]*rli[r]);}
    asm volatile("s_waitcnt lgkmcnt(0)":::"memory");
    const int le_=lane_now();
    #pragma unroll
    for(int i=0;i<4;++i){const int row=i*8+(le_>>3),ch=le_&7; const u32x4 v=*(const u32x4*)(stg+row*64+ch*8); ATTN_STORE16(Ow+(long)row*PO+ch*8,v);} }
  asm volatile("s_waitcnt lgkmcnt(0)\n\ts_barrier":::"memory");
  #undef BIAS
  #undef DMA_K
  #undef DMA_V
  #undef CMASK
  #undef START
  #undef RESC
  #undef ROT
}
constexpr int ATTN_LDS_BYTES=LDS_BYTES;
#undef SBAR
#undef WAIT_BAR
}

#ifndef MK_ONE_LAUNCH
#define MK_ONE_LAUNCH 1
#endif
constexpr int NWAVES = 8, NTHR = NWAVES * 64;
constexpr int Bsz = 4, S = 4096, T = Bsz * S, DM = 1024, NL = 2;
constexpr int NCH = S / 64;
constexpr int C_XA = 0, C_GA = 256, C_Q = 512, C_K = 1024, C_V = 1536, C_FL = 2048, C_P = 2056;
constexpr int C_R = C_P, C_RK = C_P + 256, C_RV = C_P + 512, C_WD = C_P + 768, C_AD = C_P + 800, C_GD = C_P + 832, DIN = C_P + 896, NP = 3072, RCOLS = 896;
constexpr int NE = 16, DE = 256, MAXTILES = 144;
constexpr float L2E = 1.4426950408889634f;
constexpr int NPH = 11;
enum { PH_PRE = 0, PH_GIN, PH_PREP, PH_ATTN, PH_RWKV, PH_POST, PH_GOUT, PH_ROUTE, PH_PLACE, PH_MOE1, PH_MOE2 };
constexpr int PH_FIN = NL * NPH, N_PHASES = PH_FIN + 1;
enum { I_X = 0, I_N1G, I_WIN, I_CONVW, I_CONVB, I_WA, I_BA, I_WX, I_BX, I_LAM, I_LNG, I_FB, I_QNG, I_KNG, I_FNG, I_MU, I_W0, I_W2, I_A0, I_A2, I_G2, I_KK, I_KA, I_RK, I_RLG, I_RLB,
       I_WOUT, I_N2G, I_RGW, I_RGB, I_REW, I_REB, I_EG, I_EU, I_ED, N_IN };

constexpr size_t MiB = 1u << 20;
constexpr size_t WS_CTL = 0, CTL_ZERO_BYTES = 1 * MiB;
constexpr size_t WS_WIN = 2 * MiB, WS_WOUT = 8 * MiB, WS_WGU = 10 * MiB, WS_WD = 26 * MiB;
constexpr size_t WS_H = 34 * MiB;
constexpr size_t WS_PROJ = 66 * MiB;
constexpr size_t WS_Y = 162 * MiB;
constexpr size_t WS_HLOC = 194 * MiB, WS_CUMA = 202 * MiB;
constexpr size_t WS_ORAW = 210 * MiB;
constexpr size_t WS_G = 226 * MiB, WS_VS = 234 * MiB;
constexpr size_t WS_CLOC = 242 * MiB, WS_BON = WS_CLOC + 512 * 1024, WS_AAGG = WS_BON + 256 * 1024, WS_HAGG = WS_AAGG + 256 * 1024, WS_CTOT = WS_HAGG + 256 * 1024;
constexpr size_t WS_TOKE = 244 * MiB, WS_TOKW = WS_TOKE + 128 * 1024, WS_TSLOT = WS_TOKW + 128 * 1024;
constexpr size_t WS_ASORT = 66 * MiB, WS_HID = 138 * MiB, WS_STOK = 156 * MiB, WS_SW = 157 * MiB;
constexpr size_t WS_YE = WS_ASORT;
constexpr size_t WS_END = 256 * MiB;
static_assert(WS_ASORT + (size_t)MAXTILES * 256 * 1024 * 2 <= WS_HID && WS_HID + (size_t)MAXTILES * 256 * 256 * 2 <= WS_STOK && WS_SW + MAXTILES * 256 * 4 <= WS_Y, "MoE overlay");
static_assert(WS_PROJ + (size_t)T * NP * 2 <= WS_Y && WS_CTOT + 4 * 64 * 8 * 4 <= WS_TOKE && WS_TSLOT + 128 * 1024 <= WS_END, "d_ws map");

constexpr int CW_TMO = 0;
constexpr int CW_BAR = 4096;
constexpr int CW_CNT0 = 8192, CW_CUR0 = 8192 + 64, CW_LSTRIDE = 256;

constexpr int LDS_BYTES = 156 * 1024;
constexpr int MISC_OFF = LDS_BYTES - 256;
constexpr int LDS_TAB = 131072;

#define GAS __attribute__((address_space(1)))
#define LAS __attribute__((address_space(3)))
typedef unsigned short bf16;
typedef unsigned v4u __attribute__((ext_vector_type(4)));
typedef unsigned v2u __attribute__((ext_vector_type(2)));
typedef float f32x4 __attribute__((ext_vector_type(4)));
typedef GAS unsigned gu32;
#define RLX_AGENT __ATOMIC_RELAXED, __HIP_MEMORY_SCOPE_AGENT
typedef float f32x2_ __attribute__((ext_vector_type(2))); typedef __bf16 bf16x2_ __attribute__((ext_vector_type(2)));
__device__ __forceinline__ unsigned pk2(float lo, float hi) { f32x2_ v = {lo, hi}; bf16x2_ b = __builtin_convertvector(v, bf16x2_); return __builtin_bit_cast(unsigned, b); }
__device__ __forceinline__ unsigned f2bf(float f) { return pk2(f, 0.f) & 0xffffu; }
__device__ __forceinline__ float bf2f(bf16 v) { return __builtin_bit_cast(float, (unsigned)v << 16); }
__device__ __forceinline__ float bflo(unsigned w) { return __builtin_bit_cast(float, w << 16); }
__device__ __forceinline__ float bfhi(unsigned w) { return __builtin_bit_cast(float, w & 0xffff0000u); }
__device__ __forceinline__ float sigmoidf_(float x) { return 1.f / (1.f + __expf(-x)); }
__device__ __forceinline__ float softplusf_(float x) { return fmaxf(x, 0.f) + log1pf(__expf(-fabsf(x))); }
__device__ __forceinline__ float wave_sum(float v) {
#pragma unroll
    for (int o = 1; o < 64; o <<= 1) v += __shfl_xor(v, o);
    return v;
}
#define XB_TMO      128
#define XB_XCNT(j)  (256  + 64 * (j))
#define XB_XSUB(j)  (1280 + 64 * (j))
#define XB_XGEN(j)  (2304 + 64 * (j))
#define XB_TOP      3328
#define XB_TOPGEN   3392
#define XCD_BAR_WORDS 3456
#define XB_SPIN_CAP (1u << 21)

__device__ __forceinline__ unsigned xb_ld(unsigned* p)              { return __hip_atomic_load(p, __ATOMIC_RELAXED, __HIP_MEMORY_SCOPE_AGENT); }
__device__ __forceinline__ unsigned xb_add(unsigned* p, unsigned v) { return __hip_atomic_fetch_add(p, v, __ATOMIC_RELAXED, __HIP_MEMORY_SCOPE_AGENT); }
__device__ __forceinline__ unsigned xb_xcc_id() { return (unsigned)__builtin_amdgcn_s_getreg((3 << 11) | 20) & 0xFu; }
#define XB_SPIN(cond, bar) do { unsigned _sp = 0; while (cond) { __builtin_amdgcn_s_sleep(1); \
    if ((++_sp & 255u) == 0u) { if (xb_ld(&(bar)[XB_TMO])) break; if (_sp > XB_SPIN_CAP) { atomicAdd(&(bar)[XB_TMO], 1u); break; } } } } while (0)

struct XcdBarrier {
    unsigned* bar; unsigned x;
    volatile LAS unsigned* st;
};

__device__ __forceinline__ XcdBarrier xcd_barrier_post(unsigned* bar, volatile LAS unsigned* st) {
    XcdBarrier b; b.bar = bar; b.x = xb_xcc_id(); b.st = st;
    if (threadIdx.x == 0) (void)xb_add(&bar[XB_XCNT(b.x)], 1u);
    return b;
}
__device__ __forceinline__ void xcd_barrier_complete(unsigned* bar, unsigned x, unsigned& nloc, unsigned& nx) {
    const unsigned G = gridDim.x * gridDim.y * gridDim.z;
    unsigned sum, cnt, mine, sp = 0u;
    for (;;) {
        sum = 0u; cnt = 0u; mine = 0u;
#pragma unroll
        for (unsigned j = 0; j < 16; ++j) { const unsigned c = xb_ld(&bar[XB_XCNT(j)]); sum += c; cnt += (c > 0u) ? 1u : 0u; mine = (j == x) ? c : mine; }
        if (sum == G) break;
        __builtin_amdgcn_s_sleep(1);
        if ((++sp & 255u) == 0u) { if (xb_ld(&bar[XB_TMO])) break; if (sp > XB_SPIN_CAP) { atomicAdd(&bar[XB_TMO], 1u); break; } }
    }
    nloc = mine > 0u ? mine : 1u; nx = cnt > 0u ? cnt : 1u;
}

__device__ __forceinline__ void xcd_barrier(const XcdBarrier& b) {
    asm volatile("s_waitcnt vmcnt(0)" ::: "memory");
    __syncthreads();
    if (threadIdx.x == 0) {
        unsigned* bar = b.bar;
        __builtin_amdgcn_s_waitcnt(0);
        unsigned nloc = b.st[0], nx = b.st[1];
        if (nloc == 0u) { xcd_barrier_complete(bar, b.x, nloc, nx); b.st[0] = nloc; b.st[1] = nx; }
        const unsigned old = xb_add(&bar[XB_XSUB(b.x)], 1u);
        const unsigned gen = old / nloc;
        if (old + 1u == (gen + 1u) * nloc) {
            __builtin_amdgcn_fence(__ATOMIC_RELEASE, "agent");
            asm volatile("s_waitcnt vmcnt(0)" ::: "memory");
            const unsigned og = xb_add(&bar[XB_TOP], 1u);
            const unsigned tg = og / nx;
            if (og + 1u == (tg + 1u) * nx) xb_add(&bar[XB_TOPGEN], 1u);
            else XB_SPIN(xb_ld(&bar[XB_TOPGEN]) == tg, bar);
            __builtin_amdgcn_fence(__ATOMIC_ACQUIRE, "agent");
            xb_add(&bar[XB_XGEN(b.x)], 1u);
            asm volatile("s_waitcnt vmcnt(0)" ::: "memory");
        } else {
            XB_SPIN(xb_ld(&bar[XB_XGEN(b.x)]) == gen, bar);
            __builtin_amdgcn_fence(__ATOMIC_ACQUIRE, "agent");
            asm volatile("s_waitcnt vmcnt(0)" ::: "memory");
        }
    }
    __syncthreads();
}

struct Args { const float* in[N_IN]; float* out; unsigned char* ws; int ph_lo, ph_hi; };
typedef const __attribute__((address_space(4))) Args* CA;
__device__ __forceinline__ CA args_now() { CA p = (CA)__builtin_amdgcn_kernarg_segment_ptr(); asm volatile("" : "+s"(p)); return p; }

__device__ __forceinline__ void tr_item(const float* W, int K, int N, const float* gk, bf16* WT, int row_off, int row_stride, float* scr, int item, int nblk, int lane) {
    const int kb = item / nblk, nb = item % nblk, k0 = 64 * kb, n0 = 32 * nb;
    const int nn = n0 + (lane & 31);
#pragma unroll 8
    for (int i = 0; i < 32; ++i) { const int kk = 2 * i + (lane >> 5); float v = (nn < N) ? W[(size_t)(k0 + kk) * N + nn] : 0.f; if (gk) v *= gk[k0 + kk]; scr[kk * 33 + (lane & 31)] = v; }
    asm volatile("s_waitcnt lgkmcnt(0)" ::: "memory");
    const int c = lane & 7;
#pragma unroll
    for (int j = 0; j < 4; ++j) { const int n = (lane >> 3) + 8 * j; const float* s = scr + (8 * c) * 33 + n;
        v4u o; o.x = pk2(s[0 * 33], s[1 * 33]); o.y = pk2(s[2 * 33], s[3 * 33]); o.z = pk2(s[4 * 33], s[5 * 33]); o.w = pk2(s[6 * 33], s[7 * 33]);
        *(v4u*)(WT + (size_t)(row_off + row_stride * (n0 + n)) * K + k0 + 8 * c) = o; }
    asm volatile("s_waitcnt lgkmcnt(0)" ::: "memory");
}
__device__ __forceinline__ void rms_row_to_bf16(const float* xrow, bf16* orow, int lane) {
    const f32x4* xr = (const f32x4*)xrow + lane;
    f32x4 v[4]; float s = 0.f;
#pragma unroll
    for (int j = 0; j < 4; ++j) { v[j] = xr[64 * j]; s += (v[j].x * v[j].x + v[j].y * v[j].y) + (v[j].z * v[j].z + v[j].w * v[j].w); }
    const float rstd = rsqrtf(wave_sum(s) * (1.f / DM) + 1e-6f);
    v2u* o8 = (v2u*)orow + lane;
#pragma unroll
    for (int j = 0; j < 4; ++j) { v2u o; o.x = pk2(v[j].x * rstd, v[j].y * rstd); o.y = pk2(v[j].z * rstd, v[j].w * rstd); o8[64 * j] = o; }
}
__device__ __forceinline__ void combine_row(float* xrow, const bf16* y0, const bf16* y1, bf16* orow, int lane) {
    f32x4* xr = (f32x4*)xrow + lane; const v2u* p0 = (const v2u*)y0 + lane; const v2u* p1 = (const v2u*)y1 + lane;
    f32x4 v[4]; float s = 0.f;
#pragma unroll
    for (int j = 0; j < 4; ++j) { v[j] = xr[64 * j]; const v2u q0 = p0[64 * j], q1 = p1[64 * j];
        v[j].x += bflo(q0.x) + bflo(q1.x); v[j].y += bfhi(q0.x) + bfhi(q1.x); v[j].z += bflo(q0.y) + bflo(q1.y); v[j].w += bfhi(q0.y) + bfhi(q1.y);
        xr[64 * j] = v[j]; s += (v[j].x * v[j].x + v[j].y * v[j].y) + (v[j].z * v[j].z + v[j].w * v[j].w); }
    if (orow) { const float rstd = rsqrtf(wave_sum(s) * (1.f / DM) + 1e-6f); v2u* o8 = (v2u*)orow + lane;
#pragma unroll
        for (int j = 0; j < 4; ++j) { v2u o; o.x = pk2(v[j].x * rstd, v[j].y * rstd); o.y = pk2(v[j].z * rstd, v[j].w * rstd); o8[64 * j] = o; } }
}
__device__ __forceinline__ void phase_pre(CA a, int l, unsigned char* lds, int tid) {
    const int lane = tid & 63, wave = tid >> 6;
    float* scr = (float*)lds + wave * (64 * 33);
    const int gw = blockIdx.x * NWAVES + wave, NGW = gridDim.x * NWAVES;
    bf16* WinT = (bf16*)(a->ws + WS_WIN); bf16* WoutT = (bf16*)(a->ws + WS_WOUT); bf16* WguT = (bf16*)(a->ws + WS_WGU); bf16* WdT = (bf16*)(a->ws + WS_WD);
    constexpr int I_IN = 16 * 96, I_OUT = 16 * 32, I_E = 16 * 128;
    constexpr int NITEMS = I_IN + I_OUT + 3 * I_E;
    for (int it = gw; it < NITEMS; it += NGW) {
        int r = it;
        if (r < I_IN) { tr_item(a->in[I_WIN] + (size_t)l * DM * DIN, DM, DIN, a->in[I_N1G] + l * DM, WinT, 0, 1, scr, r, 96, lane); continue; } r -= I_IN;
        if (r < I_OUT) { tr_item(a->in[I_WOUT] + (size_t)l * DM * DM, DM, DM, nullptr, WoutT, 0, 1, scr, r, 32, lane); continue; } r -= I_OUT;
        if (r < I_E) { const int e = r >> 7, rr = r & 127; tr_item(a->in[I_EG] + (size_t)(l * NE + e) * DM * DE, DM, DE, a->in[I_N2G] + l * DM, WguT + (size_t)e * 512 * DM, 0, 2, scr, rr, 8, lane); continue; } r -= I_E;
        if (r < I_E) { const int e = r >> 7, rr = r & 127; tr_item(a->in[I_EU] + (size_t)(l * NE + e) * DM * DE, DM, DE, a->in[I_N2G] + l * DM, WguT + (size_t)e * 512 * DM, 1, 2, scr, rr, 8, lane); continue; } r -= I_E;
        { const int e = r >> 7, rr = r & 127; tr_item(a->in[I_ED] + (size_t)(l * NE + e) * DE * DM, DE, DM, nullptr, WdT + (size_t)e * DM * DE, 0, 1, scr, rr, 32, lane); }
    }
    bf16* H = (bf16*)(a->ws + WS_H);
    if (l == 0) { for (int m = gw; m < T; m += NGW) rms_row_to_bf16(a->in[I_X] + (size_t)m * DM, H + (size_t)m * DM, lane); }
    else { const int* TS = (const int*)(a->ws + WS_TSLOT); const bf16* YE = (const bf16*)(a->ws + WS_YE);
        for (int m = gw; m < T; m += NGW) combine_row(a->out + (size_t)m * DM, YE + (size_t)TS[2 * m] * DM, YE + (size_t)TS[2 * m + 1] * DM, H + (size_t)m * DM, lane); }
}
__device__ __forceinline__ void phase_fin(CA a, int tid) {
    const int lane = tid & 63, wave = tid >> 6; const int gw = blockIdx.x * NWAVES + wave, NGW = gridDim.x * NWAVES;
    const int* TS = (const int*)(a->ws + WS_TSLOT); const bf16* YE = (const bf16*)(a->ws + WS_YE);
    for (int m = gw; m < T; m += NGW) combine_row(a->out + (size_t)m * DM, YE + (size_t)TS[2 * m] * DM, YE + (size_t)TS[2 * m + 1] * DM, nullptr, lane);
}

__device__ __forceinline__ void prep_unit(CA a, int l, int u, unsigned char* lds, int tid) {
    const int b = u / NCH, c = u % NCH, t0 = c * 64; const size_t row0 = (size_t)b * S + t0;
    bf16* P = (bf16*)(a->ws + WS_PROJ);
    float* xcT = (float*)lds; float* ex = (float*)(lds + 69632); float* lfb = (float*)(lds + 71680);
    const int j = tid & 255, half = tid >> 8, hh = j >> 6, jj = j & 63;
    float xcv[32];
    {
        const float* cw = a->in[I_CONVW] + l * 4 * 256; const float cb = a->in[I_CONVB][l * 256 + j];
        const float w0 = cw[j], w1 = cw[256 + j], w2 = cw[512 + j], w3 = cw[768 + j];
        const int tb = t0 + half * 32;
        const bf16* px = P + ((size_t)b * S) * NP + C_XA + j;
        float x3 = (tb >= 3) ? bf2f(px[(size_t)(tb - 3) * NP]) : 0.f, x2 = (tb >= 2) ? bf2f(px[(size_t)(tb - 2) * NP]) : 0.f, x1 = (tb >= 1) ? bf2f(px[(size_t)(tb - 1) * NP]) : 0.f;
#pragma unroll
        for (int tt = 0; tt < 32; ++tt) { const float x0 = bf2f(px[(size_t)(tb + tt) * NP]); const float v = cb + w0 * x3 + w1 * x2 + w2 * x1 + w3 * x0;
            xcv[tt] = v; xcT[j * 68 + half * 32 + tt] = v; x3 = x2; x2 = x1; x1 = x0; }
    }
    __syncthreads();
    float aR[32], aI[32];
#pragma unroll
    for (int tt = 0; tt < 32; ++tt) { aR[tt] = 0.f; aI[tt] = 0.f; }
    {
        const float* wa = a->in[I_WA] + ((size_t)(l * 4 + hh) * 64) * 64 + jj; const float* wx = a->in[I_WX] + ((size_t)(l * 4 + hh) * 64) * 64 + jj;
#pragma unroll 2
        for (int i = 0; i < 64; ++i) { const float wai = wa[i * 64], wxi = wx[i * 64]; const f32x4* xr = (const f32x4*)(xcT + (hh * 64 + i) * 68 + half * 32);
#pragma unroll
            for (int q = 0; q < 8; ++q) { const f32x4 xv = xr[q];
                aR[4 * q] += xv.x * wai; aR[4 * q + 1] += xv.y * wai; aR[4 * q + 2] += xv.z * wai; aR[4 * q + 3] += xv.w * wai;
                aI[4 * q] += xv.x * wxi; aI[4 * q + 1] += xv.y * wxi; aI[4 * q + 2] += xv.z * wxi; aI[4 * q + 3] += xv.w * wxi; } }
    }
    {
        const float ba = a->in[I_BA][l * 256 + j], bx = a->in[I_BX][l * 256 + j], lam = a->in[I_LAM][l * 256 + j];
        const float sp = softplusf_(-lam);
        float hrun = 0.f, arun = 1.f;
#pragma unroll
        for (int tt = 0; tt < 32; ++tt) { const float r = sigmoidf_(aR[tt] + ba), ig = sigmoidf_(aI[tt] + bx); const float la = -8.f * r * sp; const float av = __expf(la);
            const float bb = sqrtf(fmaxf(-expm1f(2.f * la), 0.f)) * (ig * xcv[tt]); hrun = av * hrun + bb; arun *= av; aR[tt] = hrun; aI[tt] = arun; }
        if (half == 0) { ex[j] = hrun; ex[256 + j] = arun; }
    }
    __syncthreads();
    if (half == 1) { const float h0 = ex[j], a0 = ex[256 + j];
#pragma unroll
        for (int tt = 0; tt < 32; ++tt) { aR[tt] += aI[tt] * h0; aI[tt] *= a0; }
        ((float*)(a->ws + WS_AAGG))[(size_t)(b * NCH + c) * 256 + j] = aI[31]; ((float*)(a->ws + WS_HAGG))[(size_t)(b * NCH + c) * 256 + j] = aR[31]; }
    { bf16* HL = (bf16*)(a->ws + WS_HLOC); bf16* CA = (bf16*)(a->ws + WS_CUMA);
#pragma unroll
        for (int tt = 0; tt < 32; ++tt) { const size_t o = (row0 + half * 32 + tt) * 256 + j; HL[o] = (bf16)f2bf(aR[tt]); CA[o] = (bf16)f2bf(aI[tt]); } }
    {
        const float* qg = a->in[I_QNG] + l * 64; const float* kg = a->in[I_KNG] + l * 64;
        for (int pass = 0; pass < 16; ++pass) { const int item = pass * 64 + (tid >> 3), sub = tid & 7; const int which = item >> 9, rem = item & 511, t = rem >> 3, h = rem & 7;
            bf16* p = P + (row0 + t) * NP + (which ? C_K : C_Q) + h * 64 + sub * 8;
            const v4u raw = *(const v4u*)p; float v[8] = {bflo(raw.x), bfhi(raw.x), bflo(raw.y), bfhi(raw.y), bflo(raw.z), bfhi(raw.z), bflo(raw.w), bfhi(raw.w)};
            float ss = 0.f;
#pragma unroll
            for (int e = 0; e < 8; ++e) ss += v[e] * v[e];
            ss += __shfl_xor(ss, 1); ss += __shfl_xor(ss, 2); ss += __shfl_xor(ss, 4);
            const float rstd = rsqrtf(ss * (1.f / 64.f) + 1e-6f) * (which ? 1.f : 0.125f * L2E);
            const float* g = (which ? kg : qg) + sub * 8;
            v4u o; o.x = pk2(v[0] * rstd * g[0], v[1] * rstd * g[1]); o.y = pk2(v[2] * rstd * g[2], v[3] * rstd * g[3]); o.z = pk2(v[4] * rstd * g[4], v[5] * rstd * g[5]); o.w = pk2(v[6] * rstd * g[6], v[7] * rstd * g[7]);
            *(v4u*)p = o; }
    }
    { const int t = tid >> 3, h = tid & 7; const float fl = bf2f(P[(row0 + t) * NP + C_FL + h]) + a->in[I_FB][l * 8 + h]; lfb[t * 8 + h] = fminf(fl, 0.f) - log1pf(__expf(-fabsf(fl))); }
    __syncthreads();
    if (tid < 8) { float run = 0.f; float* CL = (float*)(a->ws + WS_CLOC);
        for (int t = 0; t < 64; ++t) { run += lfb[t * 8 + tid]; CL[(row0 + t) * 8 + tid] = run; }
        ((float*)(a->ws + WS_CTOT))[(size_t)(b * NCH + c) * 8 + tid] = run; }
    __syncthreads();
}

constexpr int ATT_CS_OFF = 86016, ATT_CB_OFF = ATT_CS_OFF + 16384;
static_assert(attn_body::ATTN_LDS_BYTES <= ATT_CS_OFF && ATT_CB_OFF + 256 <= LDS_TAB, "attention LDS map");
__device__ __forceinline__ void attn_run(CA a, int b, int h, int qb, unsigned char* lds) {
    const int lane = attn_body::lane_now(); const int tid = __builtin_amdgcn_readfirstlane(threadIdx.x >> 6) * 64 + lane;
    float* cs = (float*)(lds + ATT_CS_OFF); float* cbase = (float*)(lds + ATT_CB_OFF);
    const float* CT = (const float*)(a->ws + WS_CTOT); const float* CL = (const float*)(a->ws + WS_CLOC);
    if (tid < 64) { const float v = CT[(size_t)(b * NCH + tid) * 8 + h]; float s = v;
#pragma unroll
        for (int o = 1; o < 64; o <<= 1) { const float n = __shfl_up(s, o); if (tid >= o) s += n; }
        cbase[tid] = s - v; }
    __syncthreads();
    const int q0 = qb * 256; const float cref = cbase[q0 >> 6] + CL[((size_t)b * S + q0) * 8 + h];
    for (int jx = tid; jx < q0 + 256; jx += NTHR) cs[jx] = (cref - (cbase[jx >> 6] + CL[((size_t)b * S + jx) * 8 + h])) * L2E;
    __syncthreads();
    const attn_body::bf16* P = (const attn_body::bf16*)(a->ws + WS_PROJ);
    attn_body::attn_unit<8>(b, h, qb, P + C_Q, P + C_K, P + C_V, (attn_body::bf16*)(a->ws + WS_Y) + 256, (char*)lds, (const char*)cs);
}

constexpr int RW_PBUF = 0, RW_VBUF = 81920, RW_LR = 86016, RW_W2 = 118784, RW_A2 = RW_W2 + 8192, RW_G2 = RW_A2 + 8192;
static_assert(RW_G2 + 16384 <= MISC_OFF, "rwkv LDS map");
__device__ __forceinline__ void rwkv_block(CA a, int l, int blk, unsigned char* lds, int tid) {
    const int b = blk >> 4, h = (blk >> 2) & 3, rb = blk & 3, lane = tid & 63, wave = tid >> 6;
    float* pbuf = (float*)(lds + RW_PBUF); float* vbuf = (float*)(lds + RW_VBUF); float* lr = (float*)(lds + RW_LR);
    float* w2h = (float*)(lds + RW_W2); float* a2h = (float*)(lds + RW_A2); float* g2h = (float*)(lds + RW_G2);
    const bf16* P = (const bf16*)(a->ws + WS_PROJ);
    for (int idx = tid; idx < 32 * 64; idx += NTHR) { const int jx = idx >> 6, n = idx & 63; w2h[idx] = a->in[I_W2][(size_t)(l * 32 + jx) * 256 + h * 64 + n]; a2h[idx] = a->in[I_A2][(size_t)(l * 32 + jx) * 256 + h * 64 + n]; }
    for (int idx = tid; idx < 64 * 64; idx += NTHR) { const int jx = idx >> 6, n = idx & 63; g2h[idx] = a->in[I_G2][(size_t)(l * 64 + jx) * 256 + h * 64 + n]; }
    const float* mu = a->in[I_MU] + l * RCOLS;
    float s0 = 0.f, s1 = 0.f, s2 = 0.f, s3 = 0.f;
    const int rl = 4 * (wave & 3) + (lane >> 4), kq = (lane & 15) * 4;
    bf16* G = (bf16*)(a->ws + WS_G); bf16* VS = (bf16*)(a->ws + WS_VS); float* BON = (float*)(a->ws + WS_BON); float* ORAW = (float*)(a->ws + WS_ORAW);
    for (int c = 0; c < NCH; ++c) {
        const size_t row0 = (size_t)b * S + c * 64;
        for (int idx = tid; idx < 64 * 128; idx += NTHR) { const int t = idx >> 7, jx = idx & 127; const size_t o = (row0 + t) * NP + C_WD + jx;
            const float cur = bf2f(P[o]); const float prev = (c * 64 + t > 0) ? bf2f(P[o - NP]) : 0.f; float val = cur + (prev - cur) * mu[768 + jx];
            if (jx < 32) val = tanhf(val); else if (jx >= 64) val = sigmoidf_(val);
            lr[idx] = val; }
        __syncthreads();
        {
            const int t = tid >> 3, n0 = (tid & 7) * 8; const size_t row = row0 + t; const bool hasprev = (c * 64 + t) > 0;
            const bf16* pr = P + row * NP + C_R + h * 64 + n0;
            const v4u rc = *(const v4u*)pr, kc = *(const v4u*)(pr + 256), vc = *(const v4u*)(pr + 512);
            v4u rp = {0u, 0u, 0u, 0u}, kp_ = rp, vp = rp;
            if (hasprev) { rp = *(const v4u*)(pr - NP); kp_ = *(const v4u*)(pr - NP + 256); vp = *(const v4u*)(pr - NP + 512); }
            float accw[8], acca[8], accg[8];
#pragma unroll
            for (int e = 0; e < 8; ++e) { accw[e] = a->in[I_W0][l * 256 + h * 64 + n0 + e]; acca[e] = a->in[I_A0][l * 256 + h * 64 + n0 + e]; accg[e] = 0.f; }
            const float* lrt = lr + t * 128;
#pragma unroll 2
            for (int jx = 0; jx < 32; ++jx) { const float lw = lrt[jx], la = lrt[32 + jx]; const f32x4 wA = *(const f32x4*)(w2h + jx * 64 + n0), wB = *(const f32x4*)(w2h + jx * 64 + n0 + 4), aA = *(const f32x4*)(a2h + jx * 64 + n0), aB = *(const f32x4*)(a2h + jx * 64 + n0 + 4);
                accw[0] += lw * wA.x; accw[1] += lw * wA.y; accw[2] += lw * wA.z; accw[3] += lw * wA.w; accw[4] += lw * wB.x; accw[5] += lw * wB.y; accw[6] += lw * wB.z; accw[7] += lw * wB.w;
                acca[0] += la * aA.x; acca[1] += la * aA.y; acca[2] += la * aA.z; acca[3] += la * aA.w; acca[4] += la * aB.x; acca[5] += la * aB.y; acca[6] += la * aB.z; acca[7] += la * aB.w; }
#pragma unroll 2
            for (int jx = 0; jx < 64; ++jx) { const float lg = lrt[64 + jx]; const f32x4 gA = *(const f32x4*)(g2h + jx * 64 + n0), gB = *(const f32x4*)(g2h + jx * 64 + n0 + 4);
                accg[0] += lg * gA.x; accg[1] += lg * gA.y; accg[2] += lg * gA.z; accg[3] += lg * gA.w; accg[4] += lg * gB.x; accg[5] += lg * gB.y; accg[6] += lg * gB.z; accg[7] += lg * gB.w; }
            const unsigned rcw[4] = {rc.x, rc.y, rc.z, rc.w}, kcw[4] = {kc.x, kc.y, kc.z, kc.w}, vcw[4] = {vc.x, vc.y, vc.z, vc.w};
            const unsigned rpw[4] = {rp.x, rp.y, rp.z, rp.w}, kpw[4] = {kp_.x, kp_.y, kp_.z, kp_.w}, vpw[4] = {vp.x, vp.y, vp.z, vp.w};
            float kkv[8], av[8], gv[8], vv[8]; float ss = 0.f, bon = 0.f;
#pragma unroll
            for (int e = 0; e < 8; ++e) { const int n = n0 + e, hn = h * 64 + n, w_ = e >> 1; const bool hi_ = e & 1;
                const float rcur = hi_ ? bfhi(rcw[w_]) : bflo(rcw[w_]), kcur = hi_ ? bfhi(kcw[w_]) : bflo(kcw[w_]), vcur = hi_ ? bfhi(vcw[w_]) : bflo(vcw[w_]);
                const float rprev = hi_ ? bfhi(rpw[w_]) : bflo(rpw[w_]), kprev = hi_ ? bfhi(kpw[w_]) : bflo(kpw[w_]), vprev = hi_ ? bfhi(vpw[w_]) : bflo(vpw[w_]);
                const float r = rcur + (rprev - rcur) * mu[hn], k = kcur + (kprev - kcur) * mu[256 + hn], v = vcur + (vprev - vcur) * mu[512 + hn];
                const float wl = -softplusf_(-accw[e]) - 0.5f; const float decay = __expf(-__expf(wl)); const float aa = sigmoidf_(acca[e]);
                kkv[e] = k * a->in[I_KK][l * 256 + hn]; ss += kkv[e] * kkv[e];
                const float kp = k * (1.f + (aa - 1.f) * a->in[I_KA][l * 256 + hn]); bon += r * kp * a->in[I_RK][l * 256 + hn];
                pbuf[t * 320 + n] = decay; pbuf[t * 320 + 192 + n] = kp; pbuf[t * 320 + 256 + n] = r; av[e] = aa; gv[e] = accg[e]; vv[e] = v;
                if ((n >> 4) == rb) vbuf[t * 16 + (n & 15)] = v; }
            ss += __shfl_xor(ss, 1); ss += __shfl_xor(ss, 2); ss += __shfl_xor(ss, 4);
            bon += __shfl_xor(bon, 1); bon += __shfl_xor(bon, 2); bon += __shfl_xor(bon, 4);
            const float inv = 1.f / fmaxf(sqrtf(ss), 1e-12f);
#pragma unroll
            for (int e = 0; e < 8; ++e) { const float kkn = kkv[e] * inv; pbuf[t * 320 + 64 + n0 + e] = -kkn; pbuf[t * 320 + 128 + n0 + e] = kkn * av[e]; }
            if (rb == 0) { v4u go, vo; go.x = pk2(gv[0], gv[1]); go.y = pk2(gv[2], gv[3]); go.z = pk2(gv[4], gv[5]); go.w = pk2(gv[6], gv[7]);
                vo.x = pk2(vv[0], vv[1]); vo.y = pk2(vv[2], vv[3]); vo.z = pk2(vv[4], vv[5]); vo.w = pk2(vv[6], vv[7]);
                *(v4u*)(G + row * 256 + h * 64 + n0) = go; *(v4u*)(VS + row * 256 + h * 64 + n0) = vo;
                if ((tid & 7) == 0) BON[row * 4 + h] = bon; }
        }
        __syncthreads();
        if (wave < 4) {
#pragma unroll 2
            for (int t = 0; t < 64; ++t) { const float* pt = pbuf + t * 320 + kq;
                const f32x4 wv = *(const f32x4*)pt, nk = *(const f32x4*)(pt + 64), bv = *(const f32x4*)(pt + 128), kp = *(const f32x4*)(pt + 192), rv = *(const f32x4*)(pt + 256);
                const float vv = vbuf[t * 16 + rl];
                float d = (s0 * nk.x + s1 * nk.y) + (s2 * nk.z + s3 * nk.w);
                d += __shfl_xor(d, 1); d += __shfl_xor(d, 2); d += __shfl_xor(d, 4); d += __shfl_xor(d, 8);
                s0 = s0 * wv.x + d * bv.x + vv * kp.x; s1 = s1 * wv.y + d * bv.y + vv * kp.y; s2 = s2 * wv.z + d * bv.z + vv * kp.z; s3 = s3 * wv.w + d * bv.w + vv * kp.w;
                float o = (s0 * rv.x + s1 * rv.y) + (s2 * rv.z + s3 * rv.w);
                o += __shfl_xor(o, 1); o += __shfl_xor(o, 2); o += __shfl_xor(o, 4); o += __shfl_xor(o, 8);
                if ((lane & 15) == 0) ORAW[(row0 + t) * 256 + h * 64 + rb * 16 + rl] = o; }
        }
        __syncthreads();
    }
}

__device__ __forceinline__ float gelu_tanh(float x) { const float u = 0.7978845608028654f * (x + 0.044715f * x * x * x); return 0.5f * x * (1.f + tanhf(u)); }
__device__ __forceinline__ void post_unit(CA a, int l, int u, unsigned char* lds, int tid) {
    const int b = u / NCH, c = u % NCH, lane = tid & 63, wave = tid >> 6; const size_t row0 = (size_t)b * S + c * 64;
    float* carry = (float*)lds;
    if (tid < 256) { const float* AA = (const float*)(a->ws + WS_AAGG) + (size_t)b * NCH * 256 + tid; const float* HA = (const float*)(a->ws + WS_HAGG) + (size_t)b * NCH * 256 + tid;
        float cr = 0.f; for (int cc = 0; cc < c; ++cc) cr = AA[cc * 256] * cr + HA[cc * 256]; carry[tid] = cr; }
    __syncthreads();
    const bf16* P = (const bf16*)(a->ws + WS_PROJ); bf16* Y = (bf16*)(a->ws + WS_Y);
    const f32x4 cr4 = *(const f32x4*)(carry + 4 * lane);
    const f32x4 lg4 = *(const f32x4*)(a->in[I_LNG] + l * 256 + 4 * lane);
    const f32x4 fgA = *(const f32x4*)(a->in[I_FNG] + l * 512 + 8 * lane), fgB = *(const f32x4*)(a->in[I_FNG] + l * 512 + 8 * lane + 4);
    const f32x4 rg4 = *(const f32x4*)(a->in[I_RLG] + l * 256 + 4 * lane), rb4 = *(const f32x4*)(a->in[I_RLB] + l * 256 + 4 * lane);
    for (int tt = wave; tt < 64; tt += NWAVES) { const size_t row = row0 + tt;
        {
            const v2u hl = *(const v2u*)((const bf16*)(a->ws + WS_HLOC) + row * 256 + 4 * lane), ca = *(const v2u*)((const bf16*)(a->ws + WS_CUMA) + row * 256 + 4 * lane), ga = *(const v2u*)(P + row * NP + C_GA + 4 * lane);
            const float y0 = gelu_tanh(bflo(ga.x)) * (bflo(hl.x) + bflo(ca.x) * cr4.x), y1 = gelu_tanh(bfhi(ga.x)) * (bfhi(hl.x) + bfhi(ca.x) * cr4.y),
                        y2 = gelu_tanh(bflo(ga.y)) * (bflo(hl.y) + bflo(ca.y) * cr4.z), y3 = gelu_tanh(bfhi(ga.y)) * (bfhi(hl.y) + bfhi(ca.y) * cr4.w);
            const float rstd = rsqrtf(wave_sum((y0 * y0 + y1 * y1) + (y2 * y2 + y3 * y3)) * (1.f / 256.f) + 1e-6f);
            v2u o; o.x = pk2(y0 * rstd * lg4.x, y1 * rstd * lg4.y); o.y = pk2(y2 * rstd * lg4.z, y3 * rstd * lg4.w); *(v2u*)(Y + row * DM + 4 * lane) = o; }
        {
            bf16* p = Y + row * DM + 256 + 8 * lane; const v4u raw = *(const v4u*)p;
            const float v0 = bflo(raw.x), v1 = bfhi(raw.x), v2 = bflo(raw.y), v3 = bfhi(raw.y), v4 = bflo(raw.z), v5 = bfhi(raw.z), v6 = bflo(raw.w), v7 = bfhi(raw.w);
            const float rstd = rsqrtf(wave_sum(((v0 * v0 + v1 * v1) + (v2 * v2 + v3 * v3)) + ((v4 * v4 + v5 * v5) + (v6 * v6 + v7 * v7))) * (1.f / 512.f) + 1e-6f);
            v4u o; o.x = pk2(v0 * rstd * fgA.x, v1 * rstd * fgA.y); o.y = pk2(v2 * rstd * fgA.z, v3 * rstd * fgA.w); o.z = pk2(v4 * rstd * fgB.x, v5 * rstd * fgB.y); o.w = pk2(v6 * rstd * fgB.z, v7 * rstd * fgB.w);
            *(v4u*)p = o; }
        {
            const f32x4 o4 = *(const f32x4*)((const float*)(a->ws + WS_ORAW) + row * 256 + 4 * lane);
            float s = (o4.x + o4.y) + (o4.z + o4.w); s += __shfl_xor(s, 1); s += __shfl_xor(s, 2); s += __shfl_xor(s, 4); s += __shfl_xor(s, 8);
            const float mean = s * (1.f / 64.f); const float d0 = o4.x - mean, d1 = o4.y - mean, d2 = o4.z - mean, d3 = o4.w - mean;
            float q = (d0 * d0 + d1 * d1) + (d2 * d2 + d3 * d3); q += __shfl_xor(q, 1); q += __shfl_xor(q, 2); q += __shfl_xor(q, 4); q += __shfl_xor(q, 8);
            const float rstd = rsqrtf(q * (1.f / 64.f) + 64e-5f);
            const float bon = ((const float*)(a->ws + WS_BON))[row * 4 + (lane >> 4)];
            const v2u g2_ = *(const v2u*)((const bf16*)(a->ws + WS_G) + row * 256 + 4 * lane), vs = *(const v2u*)((const bf16*)(a->ws + WS_VS) + row * 256 + 4 * lane);
            const float z0 = (d0 * rstd * rg4.x + rb4.x + bon * bflo(vs.x)) * bflo(g2_.x), z1 = (d1 * rstd * rg4.y + rb4.y + bon * bfhi(vs.x)) * bfhi(g2_.x),
                        z2 = (d2 * rstd * rg4.z + rb4.z + bon * bflo(vs.y)) * bflo(g2_.y), z3 = (d3 * rstd * rg4.w + rb4.w + bon * bfhi(vs.y)) * bfhi(g2_.y);
            v2u o; o.x = pk2(z0, z1); o.y = pk2(z2, z3); *(v2u*)(Y + row * DM + 768 + 4 * lane) = o; }
    }
    __syncthreads();
}

struct EpiResF32 {
    static constexpr bool PERM = true, AFTER_DRAIN = false;
    const float* X; float* O;
    __device__ __forceinline__ void operator()(const pg8::f32x4 (&acc)[2][2][4][2], const pg8::Unit& u, int wr, int wc, int fr, int fq) const {
        const int row0 = u.pm * 256 + wr * 64 + fr, col0 = u.pn * 256 + wc * 32 + 8 * fq;
#pragma unroll
        for (int ai = 0; ai < 2; ++ai)
#pragma unroll
            for (int m = 0; m < 4; ++m) { const size_t ro = (size_t)(row0 + ai * 128 + m * 16) * DM + col0;
#pragma unroll
                for (int bj = 0; bj < 2; ++bj) { const pg8::f32x4 x0 = *(const pg8::f32x4*)(X + ro + bj * 128), x1 = *(const pg8::f32x4*)(X + ro + bj * 128 + 4);
                    *(pg8::f32x4*)(O + ro + bj * 128) = x0 + acc[ai][bj][m][0]; *(pg8::f32x4*)(O + ro + bj * 128 + 4) = x1 + acc[ai][bj][m][1]; } }
    }
};
struct MoeSched {
    const int* tst; int NJ, nunits, G, c;
    __device__ __forceinline__ bool next(int i, pg8::Unit& u) const {
        const int L = i * G + c; if (L >= nunits) return false;
        const int tile = L / NJ, j = L % NJ; int e = 0;
#pragma unroll
        for (int k = 1; k < NE; ++k) e += (tile >= tst[k]) ? 1 : 0;
        u.pm = tile; u.pn = e * NJ + j; return true;
    }
    __device__ __forceinline__ void a_ready(const pg8::Unit&) const {}
    __device__ __forceinline__ void done(const pg8::Unit&) const {}
};
struct EpiSwiglu {
    static constexpr bool PERM = true, AFTER_DRAIN = false;
    bf16* HID; const float* SW; const int* tst; const int* cnt;
    __device__ __forceinline__ void operator()(const pg8::f32x4 (&acc)[2][2][4][2], const pg8::Unit& u, int wr, int wc, int fr, int fq) const {
        const int e = u.pn >> 1, j = u.pn & 1, seg0 = tst[e] * 256, ce = cnt[e];
        const int row0 = u.pm * 256 + wr * 64 + fr, hc0 = j * 128 + wc * 16 + 4 * fq;
#pragma unroll
        for (int ai = 0; ai < 2; ++ai)
#pragma unroll
            for (int m = 0; m < 4; ++m) { const int row = row0 + ai * 128 + m * 16; const bool valid = (row - seg0) < ce; const float w = valid ? SW[row] : 0.f;
#pragma unroll
                for (int bj = 0; bj < 2; ++bj) { const pg8::f32x4 v0 = acc[ai][bj][m][0], v1 = acc[ai][bj][m][1];
                    float h0 = v0[0] * sigmoidf_(v0[0]) * v0[1] * w, h1 = v0[2] * sigmoidf_(v0[2]) * v0[3] * w, h2 = v1[0] * sigmoidf_(v1[0]) * v1[1] * w, h3 = v1[2] * sigmoidf_(v1[2]) * v1[3] * w;
                    if (!valid) { h0 = 0.f; h1 = 0.f; h2 = 0.f; h3 = 0.f; }
                    v2u o; o.x = pk2(h0, h1); o.y = pk2(h2, h3); *(v2u*)(HID + (size_t)row * DE + hc0 + bj * 64) = o; } }
    }
};
struct EpiYE {
    static constexpr bool PERM = true, AFTER_DRAIN = false;
    bf16* YE;
    __device__ __forceinline__ void operator()(const pg8::f32x4 (&acc)[2][2][4][2], const pg8::Unit& u, int wr, int wc, int fr, int fq) const {
        const int j = u.pn & 3; const int row0 = u.pm * 256 + wr * 64 + fr, col0 = j * 256 + wc * 32 + 8 * fq;
#pragma unroll
        for (int ai = 0; ai < 2; ++ai)
#pragma unroll
            for (int m = 0; m < 4; ++m) { bf16* rowp = YE + (size_t)(row0 + ai * 128 + m * 16) * DM + col0;
#pragma unroll
                for (int bj = 0; bj < 2; ++bj) { const pg8::f32x4 v0 = acc[ai][bj][m][0], v1 = acc[ai][bj][m][1];
                    v4u w; w.x = pk2(v0[0], v0[1]); w.y = pk2(v0[2], v0[3]); w.z = pk2(v1[0], v1[1]); w.w = pk2(v1[2], v1[3]); *(v4u*)(rowp + bj * 128) = w; } }
    }
};

__device__ __forceinline__ void phase_route(CA a, int l, unsigned char* lds, int tid, gu32* ctl) {
    const int lane = tid & 63, wave = tid >> 6; const int gw = blockIdx.x * NWAVES + wave, NGW = gridDim.x * NWAVES;
    float* rw = (float*)lds; int* hist = (int*)(lds + 81920);
    { const float* g2 = a->in[I_N2G] + l * DM; const float* gwp = a->in[I_RGW] + (size_t)l * DM * 4; const float* ewp = a->in[I_REW] + (size_t)l * DM * NE;
        for (int idx = tid; idx < DM * 20; idx += NTHR) { const int d = idx / 20, cx = idx % 20; rw[idx] = g2[d] * (cx < 4 ? gwp[d * 4 + cx] : ewp[d * NE + cx - 4]); } }
    if (tid < NE) hist[tid] = 0;
    __syncthreads();
    bf16* H = (bf16*)(a->ws + WS_H); int* TE = (int*)(a->ws + WS_TOKE); float* TW = (float*)(a->ws + WS_TOKW);
    const float* gb = a->in[I_RGB] + l * 4; const float* eb = a->in[I_REB] + l * NE;
    for (int m = gw; m < T; m += NGW) {
        const f32x4* xr = (const f32x4*)(a->out + (size_t)m * DM) + lane;
        f32x4 v[4]; float s = 0.f;
#pragma unroll
        for (int j = 0; j < 4; ++j) { v[j] = xr[64 * j]; s += (v[j].x * v[j].x + v[j].y * v[j].y) + (v[j].z * v[j].z + v[j].w * v[j].w); }
        const float rstd = rsqrtf(wave_sum(s) * (1.f / DM) + 1e-6f);
        v2u* o8 = (v2u*)(H + (size_t)m * DM) + lane;
        float acc[20];
#pragma unroll
        for (int cx = 0; cx < 20; ++cx) acc[cx] = 0.f;
#pragma unroll
        for (int j = 0; j < 4; ++j) { v[j] = v[j] * rstd; v2u o; o.x = pk2(v[j].x, v[j].y); o.y = pk2(v[j].z, v[j].w); o8[64 * j] = o;
#pragma unroll
            for (int e = 0; e < 4; ++e) { const float xv = v[j][e]; const f32x4* wr = (const f32x4*)(rw + (size_t)(4 * lane + 256 * j + e) * 20);
#pragma unroll
                for (int q = 0; q < 5; ++q) { const f32x4 w4 = wr[q]; acc[4 * q] += xv * w4.x; acc[4 * q + 1] += xv * w4.y; acc[4 * q + 2] += xv * w4.z; acc[4 * q + 3] += xv * w4.w; } } }
#pragma unroll
        for (int cx = 0; cx < 20; ++cx) acc[cx] = wave_sum(acc[cx]);
        const float g0 = acc[0] + gb[0], g1 = acc[1] + gb[1], g2_ = acc[2] + gb[2], g3 = acc[3] + gb[3];
        int gi = 0; float gm = g0; if (g1 > gm) { gm = g1; gi = 1; } if (g2_ > gm) { gm = g2_; gi = 2; } if (g3 > gm) { gm = g3; gi = 3; }
        const float gp = 1.f / (__expf(g0 - gm) + __expf(g1 - gm) + __expf(g2_ - gm) + __expf(g3 - gm));
        float el[4];
#pragma unroll
        for (int k = 0; k < 4; ++k) el[k] = (gi == 0 ? acc[4 + k] : gi == 1 ? acc[8 + k] : gi == 2 ? acc[12 + k] : acc[16 + k]) + eb[gi * 4 + k];
        int i0 = 0; float m0 = el[0]; if (el[1] > m0) { m0 = el[1]; i0 = 1; } if (el[2] > m0) { m0 = el[2]; i0 = 2; } if (el[3] > m0) { m0 = el[3]; i0 = 3; }
        int i1 = -1; float m1 = -INFINITY;
#pragma unroll
        for (int k = 0; k < 4; ++k) { if (k != i0 && el[k] > m1) { m1 = el[k]; i1 = k; } }
        const float p0 = 1.f / (1.f + __expf(m1 - m0)), p1 = 1.f - p0;
        if (lane == 0) { const int e0 = gi * 4 + i0, e1 = gi * 4 + i1; TE[m * 2] = e0; TE[m * 2 + 1] = e1; TW[m * 2] = gp * p0; TW[m * 2 + 1] = gp * p1; atomicAdd(&hist[e0], 1); atomicAdd(&hist[e1], 1); }
    }
    __syncthreads();
    if (tid < NE) __hip_atomic_fetch_add((unsigned*)(ctl + CW_CNT0 + l * CW_LSTRIDE + tid), (unsigned)hist[tid], RLX_AGENT);
}

__device__ __forceinline__ void moe_tables(int l, unsigned char* lds, int tid, gu32* ctl) {
    int* tst = (int*)(lds + LDS_TAB); int* cnt = tst + 32;
    if (tid == 0) { int acc = 0; for (int e = 0; e < NE; ++e) { const int ce = (int)__hip_atomic_load(ctl + CW_CNT0 + l * CW_LSTRIDE + e, RLX_AGENT); cnt[e] = ce; tst[e] = acc; acc += (ce + 255) >> 8; } tst[NE] = acc; }
    __syncthreads();
}
__device__ __forceinline__ void phase_place(CA a, int l, unsigned char* lds, int tid, gu32* ctl) {
    const int lane = tid & 63, wave = tid >> 6;
    int* tst = (int*)(lds + LDS_TAB); int* lcnt = (int*)lds; int* lbase = lcnt + 16; int* sslot = lcnt + 32;
    const int* TE = (const int*)(a->ws + WS_TOKE); const float* TW = (const float*)(a->ws + WS_TOKW); float* SW = (float*)(a->ws + WS_SW); int* TSL = (int*)(a->ws + WS_TSLOT);
    const bf16* H = (const bf16*)(a->ws + WS_H); bf16* AS = (bf16*)(a->ws + WS_ASORT);
    for (int u = blockIdx.x; u < T / 64; u += gridDim.x) {
        if (tid < NE) lcnt[tid] = 0;
        __syncthreads();
        int e = 0, lrank = 0, t = 0; float w = 0.f;
        if (tid < 128) { t = u * 64 + (tid >> 1); e = TE[t * 2 + (tid & 1)]; w = TW[t * 2 + (tid & 1)]; lrank = atomicAdd(&lcnt[e], 1); }
        __syncthreads();
        if (tid < NE) lbase[tid] = (int)__hip_atomic_fetch_add((unsigned*)(ctl + CW_CUR0 + l * CW_LSTRIDE + tid), (unsigned)lcnt[tid], RLX_AGENT);
        __syncthreads();
        if (tid < 128) { const int slot = tst[e] * 256 + lbase[e] + lrank; TSL[t * 2 + (tid & 1)] = slot; SW[slot] = w; sslot[tid] = slot; }
        __syncthreads();
#pragma unroll 4
        for (int i = 0; i < 16; ++i) { const int p = wave * 16 + i; const int tk = u * 64 + (p >> 1); const int slot = sslot[p];
            const v4u* src = (const v4u*)(H + (size_t)tk * DM) + lane; v4u* dst = (v4u*)(AS + (size_t)slot * DM) + lane; dst[0] = src[0]; dst[64] = src[64]; }
        __syncthreads();
    }
}

__global__ void __launch_bounds__(NTHR, 2) fwd(Args a_unused) {
    extern __shared__ __attribute__((aligned(16))) unsigned char lds[];
    volatile LAS unsigned* MISC = (volatile LAS unsigned*)((LAS unsigned char*)lds + MISC_OFF);
    if (threadIdx.x < 64) MISC[threadIdx.x] = 0u;
    __syncthreads();
#if MK_ONE_LAUNCH
    XcdBarrier bar = xcd_barrier_post((unsigned*)(args_now()->ws + WS_CTL) + CW_BAR, MISC + 8);
#define SEAM(k) do { if (IN((k) + 1)) xcd_barrier(bar); } while (0)
#else
#define SEAM(k) do { } while (0)
#endif
    const int lo = args_now()->ph_lo, hi = args_now()->ph_hi;
#ifndef PHASE_MASK
#define PHASE_MASK 0x7ff
#endif
#define IN(k) (((PHASE_MASK >> ((k) % NPH)) & 1) && lo <= (k) && (k) < hi)
    for (int l = 0; l < NL; ++l) {
        const int pb = l * NPH;
        if (IN(pb + PH_PRE)) { phase_pre(args_now(), l, lds, pg8::tid_now()); SEAM(pb + PH_PRE); }
        if (IN(pb + PH_GIN)) { CA a = args_now();
            pg8::Gemm g{(const pg8::bf16_t*)(a->ws + WS_H), (const pg8::bf16_t*)(a->ws + WS_WIN), T, NP, DM}; pg8::StaticOrder So; So.init(T, NP, (int)gridDim.x, (int)blockIdx.x);
            pg8::EpiBf16<0> E{(pg8::bf16_t*)(a->ws + WS_PROJ), NP, nullptr, 0, 0, 1.f};
            pg8::gemm_phase<pg8::EpiBf16<0>, pg8::StaticOrder, true, true>((PG8_LAS unsigned char*)lds, g, So, E);
            SEAM(pb + PH_GIN);
        }
        if (IN(pb + PH_PREP)) { for (int u = blockIdx.x; u < Bsz * NCH; u += gridDim.x) prep_unit(args_now(), l, u, lds, pg8::tid_now()); SEAM(pb + PH_PREP); }
        if (IN(pb + PH_ATTN)) {
            for (int v = blockIdx.x; v < Bsz * 8 * 8; v += gridDim.x) { const int bh = v >> 3, s = v & 7;
                attn_run(args_now(), bh >> 3, bh & 7, 15 - s, lds); attn_run(args_now(), bh >> 3, bh & 7, s, lds); }
            SEAM(pb + PH_ATTN);
        }
        if (IN(pb + PH_RWKV)) { for (int blk = blockIdx.x; blk < Bsz * 4 * 4; blk += gridDim.x) rwkv_block(args_now(), l, blk, lds, pg8::tid_now()); SEAM(pb + PH_RWKV); }
        if (IN(pb + PH_POST)) { for (int u = blockIdx.x; u < Bsz * NCH; u += gridDim.x) post_unit(args_now(), l, u, lds, pg8::tid_now()); SEAM(pb + PH_POST); }
        if (IN(pb + PH_GOUT)) { CA a = args_now();
            pg8::Gemm g{(const pg8::bf16_t*)(a->ws + WS_Y), (const pg8::bf16_t*)(a->ws + WS_WOUT), T, DM, DM}; pg8::StaticOrder So; So.init(T, DM, (int)gridDim.x, (int)blockIdx.x);
            EpiResF32 E{(l == 0) ? a->in[I_X] : a->out, a->out};
            pg8::gemm_phase<EpiResF32, pg8::StaticOrder, true, true>((PG8_LAS unsigned char*)lds, g, So, E);
            SEAM(pb + PH_GOUT);
        }
        if (IN(pb + PH_ROUTE)) { CA a = args_now(); phase_route(a, l, lds, pg8::tid_now(), (gu32*)(a->ws + WS_CTL)); SEAM(pb + PH_ROUTE); }
        if (IN(pb + PH_PLACE)) { CA a = args_now(); const int tid = pg8::tid_now(); gu32* ctl = (gu32*)(a->ws + WS_CTL); moe_tables(l, lds, tid, ctl); phase_place(a, l, lds, tid, ctl); SEAM(pb + PH_PLACE); }
        if (IN(pb + PH_MOE1)) { CA a = args_now();
            moe_tables(l, lds, pg8::tid_now(), (gu32*)(a->ws + WS_CTL));
            const int* tst = (const int*)(lds + LDS_TAB); const int* cnt = tst + 32;
            pg8::Gemm g{(const pg8::bf16_t*)(a->ws + WS_ASORT), (const pg8::bf16_t*)(a->ws + WS_WGU), MAXTILES * 256, NE * 512, DM};
            MoeSched Sm{tst, 2, tst[NE] * 2, (int)gridDim.x, (int)blockIdx.x};
            EpiSwiglu E{(bf16*)(a->ws + WS_HID), (const float*)(a->ws + WS_SW), tst, cnt};
            pg8::gemm_phase<EpiSwiglu, MoeSched, true, true>((PG8_LAS unsigned char*)lds, g, Sm, E);
            SEAM(pb + PH_MOE1);
        }
        if (IN(pb + PH_MOE2)) { CA a = args_now();
            moe_tables(l, lds, pg8::tid_now(), (gu32*)(a->ws + WS_CTL));
            const int* tst = (const int*)(lds + LDS_TAB);
            int Kd = DE; asm volatile("" : "+s"(Kd));
            pg8::Gemm g{(const pg8::bf16_t*)(a->ws + WS_HID), (const pg8::bf16_t*)(a->ws + WS_WD), MAXTILES * 256, NE * DM, Kd};
            MoeSched Sm{tst, 4, tst[NE] * 4, (int)gridDim.x, (int)blockIdx.x};
            EpiYE E{(bf16*)(a->ws + WS_YE)};
            pg8::gemm_phase<EpiYE, MoeSched, true, true>((PG8_LAS unsigned char*)lds, g, Sm, E);
            SEAM(pb + PH_MOE2);
        }
    }
    if (IN(PH_FIN)) phase_fin(args_now(), pg8::tid_now());
#undef IN
#undef SEAM
}

extern "C" void kernel_launch(void* const* d_in, const int* in_sizes, int n_in, void* d_out, int out_size, void* d_ws, size_t ws_size, hipStream_t stream) {
    static int grid = 0;
    if (grid == 0) {
        if (n_in != N_IN || in_sizes[0] != T * DM || out_size != T * DM || ws_size < WS_END) { fprintf(stderr, "kernel_launch: unexpected problem shape (n_in %d, in0 %d, out %d, ws %zu); nothing launched\n", n_in, n_in > 0 ? in_sizes[0] : -1, out_size, ws_size); grid = -1; return; }
        int dev = 0, cus = 0, per_cu = 0;
        if (hipGetDevice(&dev) != hipSuccess || hipDeviceGetAttribute(&cus, hipDeviceAttributeMultiprocessorCount, dev) != hipSuccess) { grid = -1; return; }
        if (hipFuncSetAttribute((const void*)fwd, hipFuncAttributeMaxDynamicSharedMemorySize, LDS_BYTES) != hipSuccess) { fprintf(stderr, "kernel_launch: hipFuncSetAttribute failed\n"); grid = -1; return; }
        if (hipOccupancyMaxActiveBlocksPerMultiprocessor(&per_cu, (const void*)fwd, NTHR, LDS_BYTES) != hipSuccess || per_cu < 1) { fprintf(stderr, "kernel_launch: occupancy query reports %d workgroups per CU\n", per_cu); }
        (void)hipGetLastError();
        grid = cus;
    }
    if (grid < 0) return;
    if (hipMemsetAsync((char*)d_ws + WS_CTL, 0, CTL_ZERO_BYTES, stream) != hipSuccess) return;
    Args a{};
    for (int i = 0; i < N_IN; ++i) a.in[i] = (const float*)d_in[i];
    a.out = (float*)d_out; a.ws = (unsigned char*)d_ws;
#if MK_ONE_LAUNCH
    a.ph_lo = 0; a.ph_hi = N_PHASES;
    hipLaunchKernelGGL(fwd, dim3(grid), dim3(NTHR), LDS_BYTES, stream, a);
#else
    for (int p = 0; p < N_PHASES; ++p) { a.ph_lo = p; a.ph_hi = p + 1; hipLaunchKernelGGL(fwd, dim3(grid), dim3(NTHR), LDS_BYTES, stream, a); }
#endif
}
```

```cpp
#include <hip/hip_runtime.h>
#include <hip/hip_bf16.h>
#include <cstdio>
#include <cstdint>
#include <cmath>
namespace pg8 {
#define PG8_LAS __attribute__((address_space(3)))
typedef unsigned short bf16_t;
typedef short bf16x8 __attribute__((ext_vector_type(8)));
typedef float f32x4 __attribute__((ext_vector_type(4)));
typedef unsigned u32x4 __attribute__((ext_vector_type(4)));
__device__ __forceinline__ int tid_now() { int t = threadIdx.x; asm volatile("" : "+v"(t)); return t; }
constexpr int BM = 256, BK = 64, HALF = 128, HTB = HALF * BK * 2  , STAGE_BYTES = 8 * HTB, NXCD = 8, WGM = 8;

__host__ __device__ __forceinline__ int lds_byte(int r, int c) { const int st = (r >> 4) * 2 + (c >> 5), rr = r & 15, cc = c & 31, ob = rr * 64 + cc * 2; return st * 1024 + (ob ^ (((ob >> 9) & 1) << 5)); }
__host__ __device__ __forceinline__ void stage_rc(int b, int& R, int& C) { const int st = b / 1024, sb = b % 1024, swz = sb ^ (((sb >> 9) & 1) << 5); R = (st >> 1) * 16 + swz / 64; C = (st & 1) * 32 + (swz % 64) / 2; }
__host__ __device__ __forceinline__ int perm32(int rho) { const int n = rho >> 4, i = rho & 15; return 8 * (i >> 2) + 4 * n + (i & 3); }

struct Unit { int pm, pn; };
struct Gemm { const bf16_t* A; const bf16_t* Bt; int M, N, K; };

struct StaticOrder {
    int nM, nN, nwg, G, c;
    __host__ __device__ void init(int M, int N, int G_, int c_) { nM = M / BM; nN = N / BM; nwg = nM * nN; G = G_; c = c_; }
    __host__ __device__ bool next(int i, Unit& u) const {
        const long L = (long)i * G + c; if (L >= nwg) return false;
        int wgid = (int)L; { const int q = nwg / NXCD, r = nwg % NXCD, xcd = wgid % NXCD, off = wgid / NXCD; wgid = (xcd < r ? xcd * (q + 1) : r * (q + 1) + (xcd - r) * q) + off; }
        const int nig = WGM * nN, gid = wgid / nig, fm = gid * WGM, gsz = (nM - fm) < WGM ? (nM - fm) : WGM;
        u.pm = fm + ((wgid % nig) % gsz); u.pn = (wgid % nig) / gsz; return true;
    }
    __device__ __forceinline__ void a_ready(const Unit&) const {}
    __device__ __forceinline__ void done(const Unit&) const {}
};

__device__ __forceinline__ unsigned cvt_pk_bf16(float lo, float hi) { unsigned r; asm volatile("v_cvt_pk_bf16_f32 %0, %1, %2" : "=v"(r) : "v"(lo), "v"(hi)); return r; }
typedef float f32x2 __attribute__((ext_vector_type(2)));
__device__ __forceinline__ f32x2 gelu_pk(f32x2 v) {
    const f32x2 av = __builtin_elementwise_abs(v), d = av * 0.2316418882f + 1.0f;
    f32x2 t; t.x = __builtin_amdgcn_rcpf(d.x); t.y = __builtin_amdgcn_rcpf(d.y);
    f32x2 q = t * 0.5307027145f + (-0.7265760135f); q = q * t + 0.7107068705f; q = q * t + (-0.142248368f); q = q * t + 0.127414796f; q = q * t;
    const f32x2 s = (v * v) * (-0.72134752044f);
    f32x2 e; e.x = __builtin_amdgcn_exp2f(s.x); e.y = __builtin_amdgcn_exp2f(s.y);
    const f32x2 m = v * (q * e), r = v - m;
    f32x2 o; o.x = v.x < 0.f ? m.x : r.x; o.y = v.y < 0.f ? m.y : r.y; return o;
}

template <int ACT  > struct EpiBf16 {
    static constexpr bool PERM = true, AFTER_DRAIN = false; static_assert(ACT == 0 || ACT == 1, "EpiBf16: ACT is 0 (none) or 1 (gelu_pk)");
    bf16_t* O; int ldc; const float* bias; int split_cols; size_t split_stride; float scale0;
    __device__ __forceinline__ void operator()(const f32x4 (&acc)[2][2][4][2], const Unit& u, int wr, int wc, int fr, int fq) const {
        const int row0 = u.pm * BM + wr * 64 + fr; int colt = u.pn * BM; bf16_t* base = O;
        float sc = 1.f; if (split_cols) { const int t = colt / split_cols; base += (size_t)t * split_stride; colt -= t * split_cols; if (t == 0) sc = scale0; }
        const int col0 = colt + wc * 32 + 8 * fq, bcol0 = u.pn * BM + wc * 32 + 8 * fq;
        f32x4 bv[2][2];
#pragma unroll
        for (int bj = 0; bj < 2; ++bj)
#pragma unroll
            for (int n = 0; n < 2; ++n) bv[bj][n] = bias ? *(const f32x4*)(bias + bcol0 + bj * HALF + 4 * n) : (f32x4){0.f, 0.f, 0.f, 0.f};
#pragma unroll
        for (int ai = 0; ai < 2; ++ai)
#pragma unroll
            for (int m = 0; m < 4; ++m) { bf16_t* rowp = base + (size_t)(row0 + ai * HALF + m * 16) * ldc + col0;
#pragma unroll
                for (int bj = 0; bj < 2; ++bj) { f32x4 v0 = acc[ai][bj][m][0] + bv[bj][0], v1 = acc[ai][bj][m][1] + bv[bj][1];
                    if (ACT == 1) { f32x2 a = gelu_pk((f32x2){v0[0], v0[1]}), b = gelu_pk((f32x2){v0[2], v0[3]}), c = gelu_pk((f32x2){v1[0], v1[1]}), d = gelu_pk((f32x2){v1[2], v1[3]});
                        v0 = (f32x4){a.x, a.y, b.x, b.y}; v1 = (f32x4){c.x, c.y, d.x, d.y}; }
                    v0 = v0 * sc; v1 = v1 * sc; u32x4 w; w.x = cvt_pk_bf16(v0[0], v0[1]); w.y = cvt_pk_bf16(v0[2], v0[3]); w.z = cvt_pk_bf16(v1[0], v1[1]); w.w = cvt_pk_bf16(v1[2], v1[3]);
                    *(u32x4*)(rowp + bj * HALF) = w; } }
    }
};
template <class Epi, class Sched, bool ALIGN_EPI = false, bool SP2 = false>
__device__ __forceinline__ void gemm_phase(PG8_LAS unsigned char* lds, const Gemm g, const Sched& S, const Epi& E) {
    const int tid = tid_now(), wid = __builtin_amdgcn_readfirstlane(tid >> 6), lane = tid & 63, wr = wid >> 2, wc = wid & 3, fr = lane & 15, fq = lane >> 4;
    const int K = g.K, nt = K / BK;
    unsigned voffA[2], voffB[2];
#pragma unroll
    for (int i = 0; i < 2; ++i) { int R, C; stage_rc(tid * 16 + i * 8192, R, C); const int Rb = Epi::PERM ? ((R & ~31) + perm32(R & 31)) : R;
        voffA[i] = (unsigned)(R * K + C) * 2u; voffB[i] = (unsigned)(Rb * K + C) * 2u; }
    const size_t kstep = (size_t)(BK * 2);
    const size_t hstep = (size_t)HALF * K * 2;
    const size_t tstep = 2 * hstep;
    const unsigned ldsw = (unsigned)wid * 1024u;
    const int aoff = lds_byte(wr * 64 + fr, fq * 8), boff = lds_byte(wc * 32 + fr, fq * 8);
#define PG8_SA(b, h) (((b) * 2 + (h)) * HTB)
#define PG8_SB(b, h) ((4 + (b) * 2 + (h)) * HTB)
#define PG8_STAGE(bufoff, gbase, voff) do { _Pragma("unroll") for (int _i = 0; _i < 2; ++_i) \
        __builtin_amdgcn_global_load_lds((const unsigned*)((const char*)(gbase) + (voff)[_i]), (PG8_LAS unsigned*)(lds + (bufoff) + ldsw + _i * 8192), 16, 0, 0); } while (0)
#define PG8_LDA(dst, b, h) do { _Pragma("unroll") for (int m = 0; m < 4; ++m) _Pragma("unroll") for (int k = 0; k < 2; ++k) dst[m][k] = *(const PG8_LAS bf16x8*)(lds + PG8_SA(b, h) + aoff + m * 2048 + k * 1024); } while (0)
#define PG8_LDB(dst, b, h) do { _Pragma("unroll") for (int n = 0; n < 2; ++n) _Pragma("unroll") for (int k = 0; k < 2; ++k) dst[n][k] = *(const PG8_LAS bf16x8*)(lds + PG8_SB(b, h) + boff + n * 2048 + k * 1024); } while (0)
#define PG8_MMA(ai, bj, At, Bt) do { __builtin_amdgcn_s_setprio(1); _Pragma("unroll") for (int m = 0; m < 4; ++m) _Pragma("unroll") for (int n = 0; n < 2; ++n) _Pragma("unroll") for (int k = 0; k < 2; ++k) \
        acc[ai][bj][m][n] = __builtin_amdgcn_mfma_f32_16x16x32_bf16(Bt[n][k], At[m][k], acc[ai][bj][m][n], 0, 0, 0); __builtin_amdgcn_s_setprio(0); } while (0)
#define PG8_WAIT_V(n) asm volatile("s_waitcnt vmcnt(" #n ")" ::: "memory")
#define PG8_WAIT_L(n) asm volatile("s_waitcnt lgkmcnt(" #n ")" ::: "memory")
#define PG8_BAR __builtin_amdgcn_s_barrier()
#define PG8_SCHED __builtin_amdgcn_sched_barrier(0)
    Unit cur, nxt; int ui = 0;
    if (!S.next(0, cur)) return;
    f32x4 acc[2][2][4][2];
#pragma unroll
    for (int a = 0; a < 2; ++a)
#pragma unroll
        for (int b = 0; b < 2; ++b)
#pragma unroll
            for (int m = 0; m < 4; ++m)
#pragma unroll
                for (int n = 0; n < 2; ++n) acc[a][b][m][n] = (f32x4){0.f, 0.f, 0.f, 0.f};
    bf16x8 At[4][2], B0[2][2], B1[2][2];
    const char* cA = (const char*)g.A + (size_t)cur.pm * tstep; const char* cB = (const char*)g.Bt + (size_t)cur.pn * tstep;
    S.a_ready(cur);
    if constexpr (SP2) {
        PG8_STAGE(PG8_SB(0, 0), cB, voffB); PG8_STAGE(PG8_SB(0, 1), cB + hstep, voffB); PG8_STAGE(PG8_SA(0, 0), cA, voffA); PG8_STAGE(PG8_SA(0, 1), cA + hstep, voffA);
        if (wr == 1) PG8_BAR;
        PG8_WAIT_V(2); PG8_BAR;
        PG8_STAGE(PG8_SB(1, 0), cB + kstep, voffB); PG8_STAGE(PG8_SA(1, 0), cA + kstep, voffA); PG8_STAGE(PG8_SB(1, 1), cB + hstep + kstep, voffB);
        PG8_WAIT_V(6); PG8_BAR;
    } else {
        PG8_STAGE(PG8_SB(0, 0), cB, voffB); PG8_STAGE(PG8_SA(0, 0), cA, voffA); PG8_STAGE(PG8_SB(0, 1), cB + hstep, voffB); PG8_STAGE(PG8_SA(0, 1), cA + hstep, voffA);
        if (wr == 1) PG8_BAR;
        PG8_WAIT_V(4); PG8_BAR;
        PG8_STAGE(PG8_SB(1, 0), cB + kstep, voffB); PG8_STAGE(PG8_SA(1, 0), cA + kstep, voffA); PG8_STAGE(PG8_SB(1, 1), cB + hstep + kstep, voffB);
        PG8_WAIT_V(6); PG8_BAR;
    }
    for (;;) {
        const bool has_next = S.next(ui + 1, nxt);
        const char* nA = has_next ? (const char*)g.A + (size_t)nxt.pm * tstep : cA; const char* nB = has_next ? (const char*)g.Bt + (size_t)nxt.pn * tstep : cB;
        for (int t = 0; t < nt; t += 2) {
            const bool last = (t == nt - 2);
            const char* a1 = cA + (size_t)(t + 1) * kstep;
            const char* a2 = last ? nA : cA + (size_t)(t + 2) * kstep; const char* b2 = last ? nB : cB + (size_t)(t + 2) * kstep;
            const char* a3 = a2 + kstep; const char* b3 = b2 + kstep;
            if (last && has_next) S.a_ready(nxt);
            if constexpr (SP2) {
            PG8_LDB(B0, 0, 0); PG8_LDB(B1, 0, 1); PG8_SCHED; PG8_LDA(At, 0, 0); PG8_STAGE(PG8_SA(1, 1), a1 + hstep, voffA);
            PG8_WAIT_V(8); PG8_WAIT_L(0); PG8_BAR; PG8_MMA(0, 0, At, B0); PG8_MMA(0, 1, At, B1); PG8_BAR; PG8_SCHED;
            PG8_LDA(At, 0, 1); PG8_STAGE(PG8_SB(0, 0), b2, voffB); PG8_STAGE(PG8_SB(0, 1), b2 + hstep, voffB); PG8_STAGE(PG8_SA(0, 0), a2, voffA);
            PG8_WAIT_V(8); PG8_WAIT_L(0); PG8_BAR; PG8_MMA(1, 0, At, B0); PG8_MMA(1, 1, At, B1); PG8_BAR; PG8_SCHED;
            PG8_LDB(B0, 1, 0); PG8_LDB(B1, 1, 1); PG8_SCHED; PG8_LDA(At, 1, 0); PG8_STAGE(PG8_SA(0, 1), a2 + hstep, voffA);
            PG8_WAIT_V(8); PG8_WAIT_L(0); PG8_BAR; PG8_MMA(0, 0, At, B0); PG8_MMA(0, 1, At, B1); PG8_BAR; PG8_SCHED;
            PG8_LDA(At, 1, 1); PG8_STAGE(PG8_SB(1, 0), b3, voffB); PG8_STAGE(PG8_SB(1, 1), b3 + hstep, voffB); PG8_STAGE(PG8_SA(1, 0), a3, voffA);
            PG8_WAIT_V(8); PG8_WAIT_L(0); PG8_BAR; PG8_MMA(1, 0, At, B0); PG8_MMA(1, 1, At, B1); PG8_BAR; PG8_SCHED;
            } else {
            PG8_LDB(B0, 0, 0); PG8_SCHED; PG8_LDA(At, 0, 0); PG8_STAGE(PG8_SA(1, 1), a1 + hstep, voffA);
            PG8_WAIT_L(8); PG8_BAR; PG8_WAIT_L(0); PG8_MMA(0, 0, At, B0); PG8_BAR; PG8_SCHED;
            PG8_LDB(B1, 0, 1); PG8_STAGE(PG8_SB(0, 0), b2, voffB);
            PG8_BAR; PG8_WAIT_L(0); PG8_MMA(0, 1, At, B1); PG8_BAR;
            PG8_LDA(At, 0, 1); PG8_STAGE(PG8_SA(0, 0), a2, voffA);
            PG8_BAR; PG8_WAIT_L(0); PG8_MMA(1, 0, At, B0); PG8_BAR; PG8_SCHED;
            PG8_STAGE(PG8_SB(0, 1), b2 + hstep, voffB);
            PG8_WAIT_V(6); PG8_BAR; PG8_MMA(1, 1, At, B1); PG8_BAR;
            PG8_LDB(B0, 1, 0); PG8_SCHED; PG8_LDA(At, 1, 0); PG8_STAGE(PG8_SA(0, 1), a2 + hstep, voffA);
            PG8_WAIT_L(8); PG8_BAR; PG8_WAIT_L(0); PG8_MMA(0, 0, At, B0); PG8_BAR; PG8_SCHED;
            PG8_LDB(B1, 1, 1); PG8_STAGE(PG8_SB(1, 0), b3, voffB);
            PG8_BAR; PG8_WAIT_L(0); PG8_MMA(0, 1, At, B1); PG8_BAR;
            PG8_LDA(At, 1, 1); PG8_STAGE(PG8_SA(1, 0), a3, voffA);
            PG8_BAR; PG8_WAIT_L(0); PG8_MMA(1, 0, At, B0); PG8_BAR; PG8_SCHED;
            PG8_STAGE(PG8_SB(1, 1), b3 + hstep, voffB);
            PG8_WAIT_V(6); PG8_BAR; PG8_MMA(1, 1, At, B1); PG8_BAR;
            }
        }
        if constexpr (ALIGN_EPI) { if (wr == 0) PG8_BAR; }
        if constexpr (!Epi::AFTER_DRAIN) { E(acc, cur, wr, wc, fr, fq); S.done(cur); }
        if (!has_next) break;
#pragma unroll
        for (int a = 0; a < 2; ++a)
#pragma unroll
            for (int b = 0; b < 2; ++b)
#pragma unroll
                for (int m = 0; m < 4; ++m)
#pragma unroll
                    for (int n = 0; n < 2; ++n) acc[a][b][m][n] = (f32x4){0.f, 0.f, 0.f, 0.f};
        cur = nxt; cA = nA; cB = nB; ++ui;
        if constexpr (ALIGN_EPI) { if (wr == 1) PG8_BAR; }
    }
    PG8_WAIT_V(0);
    if constexpr (!ALIGN_EPI) { if (wr == 0) PG8_BAR; }
    PG8_BAR;
    if constexpr (Epi::AFTER_DRAIN) { E.fused(acc, cur, wr, wc, fr, fq, lds, wid, lane); S.done(cur); }
#undef PG8_SA
#undef PG8_SB
#undef PG8_STAGE
#undef PG8_LDA
#undef PG8_LDB
#undef PG8_MMA
#undef PG8_WAIT_V
#undef PG8_WAIT_L
#undef PG8_BAR
#undef PG8_SCHED
}
}
namespace attn_body {
using bf16=__hip_bfloat16;
using bf16x8=__attribute__((ext_vector_type(8)))short;
using s16x4=__attribute__((ext_vector_type(4)))short;
using f32x16=__attribute__((ext_vector_type(16)))float;
using u32x4=__attribute__((ext_vector_type(4)))unsigned;
constexpr int BATCH=4,NHEAD=8,SEQ=4096,D=64,PQ=3072,PO=1024;
typedef float f32x4_t __attribute__((ext_vector_type(4)));
__device__ __forceinline__ int lane_now(){int l;asm volatile("v_mbcnt_lo_u32_b32 %0, -1, 0\n\tv_mbcnt_hi_u32_b32 %0, -1, %0":"=v"(l));return l;}
constexpr int NW=8,QBLK=32,QB=QBLK*NW,KVBLK=64,NQB=SEQ/QB;
constexpr int ATTN_UNIT_ROWS=QB;
__device__ __forceinline__ int crow(int r,int hi){return (r&3)+8*(r>>2)+4*hi;}
#define SBAR() __builtin_amdgcn_sched_barrier(0)
__device__ __forceinline__ void cmask(f32x16&p0,f32x16&p1,int jb,int qrel,int hi){
  const float NEG=-INFINITY; int kb=64*jb+4*hi;
  #pragma unroll
  for(int r=0;r<16;++r){int kv=kb+(r&3)+8*(r>>2); if(kv>qrel)p0[r]=NEG; if(kv+32>qrel)p1[r]=NEG;}
}

constexpr int NSLOT=3, SLOTB=8192;
constexpr int LDS_K=0, LDS_V=NSLOT*SLOTB, LDS_WS=2*NSLOT*SLOTB, LDS_OST=LDS_WS+NW*64*4, LDS_BYTES=LDS_OST+NW*4096;
constexpr float C2=0.125f*1.4426950408889634f;
__device__ __forceinline__ void glds16(const void*gsrc,unsigned lds_dst){unsigned keep;
  asm volatile("s_mov_b32 %0, m0\n\ts_mov_b32 m0, %2\n\ts_nop 0\n\tglobal_load_lds_dwordx4 %1, off\n\ts_mov_b32 m0, %0":"=&s"(keep):"v"(gsrc),"s"(lds_dst):"memory");}
__device__ __forceinline__ float max3f(float a,float b,float c){float r;asm("v_max3_f32 %0, %1, %2, %3":"=v"(r):"v"(a),"v"(b),"v"(c));return r;}
__device__ __forceinline__ float max2f(float a,float b){float r;asm("v_max_f32_e32 %0, %1, %2":"=v"(r):"v"(a),"v"(b));return r;}
__device__ __forceinline__ float fadd_s(float a,float b){float r;asm("v_add_f32_e32 %0, %1, %2":"=v"(r):"v"(a),"v"(b));return r;}
__device__ __forceinline__ float fsub_s(float a,float b){float r;asm("v_sub_f32_e32 %0, %1, %2":"=v"(r):"v"(a),"v"(b));return r;}
typedef float f32x2_t __attribute__((ext_vector_type(2))); typedef __bf16 bf16x2_t __attribute__((ext_vector_type(2)));
__device__ __forceinline__ unsigned cvtpk_s(float lo,float hi){f32x2_t v={lo,hi};bf16x2_t b=__builtin_convertvector(v,bf16x2_t);return __builtin_bit_cast(unsigned,b);}
#define WAIT_BAR(N) asm volatile("s_waitcnt vmcnt(" #N ") lgkmcnt(0)\n\ts_barrier":::"memory")

__device__ __forceinline__ void qkt(f32x16&p0,f32x16&p1,const char*Kslot,const bf16x8*qr,int r32,int hi){ const f32x16 negm=f32x16{};
  const char*kb=Kslot+hi*1024+r32*16;
  #pragma unroll
  for(int d0=0;d0<4;++d0){
    const bf16x8 b0=*reinterpret_cast<const bf16x8*>(kb+d0*2048);
    const bf16x8 b1=*reinterpret_cast<const bf16x8*>(kb+d0*2048+512);
    if(d0==0){p0=__builtin_amdgcn_mfma_f32_32x32x16_bf16(b0,qr[0],negm,0,0,0);p1=__builtin_amdgcn_mfma_f32_32x32x16_bf16(b1,qr[0],negm,0,0,0);}
    else{p0=__builtin_amdgcn_mfma_f32_32x32x16_bf16(b0,qr[d0],p0,0,0,0);p1=__builtin_amdgcn_mfma_f32_32x32x16_bf16(b1,qr[d0],p1,0,0,0);}}
}
typedef __attribute__((address_space(3))) const char* lds_cptr;
typedef short v4i16_t __attribute__((ext_vector_type(4)));
__device__ __forceinline__ void kload8(bf16x8*kf,lds_cptr kp){
  kf[0]=*(const __attribute__((address_space(3))) bf16x8*)(kp);      kf[1]=*(const __attribute__((address_space(3))) bf16x8*)(kp+512);
  kf[2]=*(const __attribute__((address_space(3))) bf16x8*)(kp+2048); kf[3]=*(const __attribute__((address_space(3))) bf16x8*)(kp+2560);
  kf[4]=*(const __attribute__((address_space(3))) bf16x8*)(kp+4096); kf[5]=*(const __attribute__((address_space(3))) bf16x8*)(kp+4608);
  kf[6]=*(const __attribute__((address_space(3))) bf16x8*)(kp+6144); kf[7]=*(const __attribute__((address_space(3))) bf16x8*)(kp+6656);
}
__device__ __forceinline__ void kload2(bf16x8*kf,lds_cptr kp,int j){ kf[2*j]=*(const __attribute__((address_space(3))) bf16x8*)(kp+j*2048); kf[2*j+1]=*(const __attribute__((address_space(3))) bf16x8*)(kp+j*2048+512); }
__device__ __forceinline__ s16x4 vtr(lds_cptr p){ return __builtin_bit_cast(s16x4,__builtin_amdgcn_ds_read_tr16_b64_v4i16((__attribute__((address_space(3))) v4i16_t*)p)); }
__device__ __forceinline__ float rowmax(const f32x16&p0,const f32x16&p1){
  float a=max3f(p0[0],p0[1],p1[0]),b=max3f(p0[2],p0[3],p1[1]);a=max3f(a,p1[2],p1[3]);
  #pragma unroll
  for(int r=4;r<16;r+=4){a=max3f(a,p0[r],p0[r+1]);b=max3f(b,p0[r+2],p0[r+3]);a=max3f(a,p1[r],p1[r+1]);b=max3f(b,p1[r+2],p1[r+3]);}
  const float m=max2f(a,b);
  auto rr=__builtin_amdgcn_permlane32_swap(__float_as_uint(m),__float_as_uint(m),false,false);
  return max2f(__uint_as_float(rr[0]),__uint_as_float(rr[1]));
}
__device__ __forceinline__ void pv(f32x16*o,int vb,bf16x8 pa0,bf16x8 pa1,bf16x8 pa2,bf16x8 pa3){
  #pragma unroll
  for(int d0=0;d0<2;++d0){s16x4 lo[4],hi[4];
    #pragma unroll
    for(int ks=0;ks<4;++ks){
      asm volatile("ds_read_b64_tr_b16 %0,%1 offset:%c2":"=&v"(lo[ks]):"v"(vb),"i"(d0*4096+ks*1024):"memory");
      asm volatile("ds_read_b64_tr_b16 %0,%1 offset:%c2":"=&v"(hi[ks]):"v"(vb),"i"(d0*4096+ks*1024+512):"memory");}
    asm volatile("s_waitcnt lgkmcnt(0)":::"memory");SBAR();
    #define PK(k) (bf16x8){lo[k][0],lo[k][1],lo[k][2],lo[k][3],hi[k][0],hi[k][1],hi[k][2],hi[k][3]}
    o[d0]=__builtin_amdgcn_mfma_f32_32x32x16_bf16(pa0,PK(0),o[d0],0,0,0);
    o[d0]=__builtin_amdgcn_mfma_f32_32x32x16_bf16(pa1,PK(1),o[d0],0,0,0);
    o[d0]=__builtin_amdgcn_mfma_f32_32x32x16_bf16(pa2,PK(2),o[d0],0,0,0);
    o[d0]=__builtin_amdgcn_mfma_f32_32x32x16_bf16(pa3,PK(3),o[d0],0,0,0);
    #undef PK
  }
}

#ifndef ATTN_STORE16
#define ATTN_STORE16(p,v) (*(u32x4*)(p)=(v))
#endif
template<int THRL> __device__ __forceinline__ void attn_unit(int b,int h,int qb,const bf16*Q,const bf16*__restrict__ K,const bf16*__restrict__ V,bf16*O,char*shm,const char*cs){
  const int tid=pg8::tid_now(),lane=tid&63,r32=lane&31,hi=lane>>5; const int wid=__builtin_amdgcn_readfirstlane(tid>>6);
  const long rowbase=(long)b*SEQ; const int q0=qb*QB;
  const bf16*Qw=Q+(rowbase+q0+wid*QBLK)*PQ+h*D;
  const bf16*Kh=K+rowbase*PQ+h*D,*Vh=V+rowbase*PQ+h*D;
  const unsigned lds0=(unsigned)(uintptr_t)shm;
  float*wsf=(float*)(shm+LDS_WS)+wid*64;
  const bf16*ksrc=Kh+(long)lane*PQ+wid*8;
  const bf16*vsrc=Vh+(long)(16*(wid&3)+(lane>>2))*PQ+(wid>>2)*32+(lane&3)*8;
  const unsigned kdst=lds0+LDS_K+wid*1024, vdst=lds0+LDS_V+wid*1024;
  #define DMA_K(t,slot) glds16(ksrc+(long)(t)*KVBLK*PQ,(unsigned)__builtin_amdgcn_readfirstlane(kdst+(slot)))
  #define DMA_V(t,slot) glds16(vsrc+(long)(t)*KVBLK*PQ,(unsigned)__builtin_amdgcn_readfirstlane(vdst+(slot)))
  const int vb0=(int)(lds0+LDS_V)+((lane>>4)&1)*32+(lane&3)*8+(4*hi+((lane&15)>>2))*64;
  const char*Kbase=shm+LDS_K; bf16x8 kf[8];
  const lds_cptr shm3=(lds_cptr)shm; const lds_cptr kp0=shm3+LDS_K+hi*1024+r32*16; const lds_cptr vp0=shm3+LDS_V+((lane>>4)&1)*32+(lane&3)*8+(4*hi+((lane&15)>>2))*64;
  const int NT=(q0+QB)/KVBLK;
  DMA_K(0,0);DMA_V(0,0);DMA_K(1,SLOTB);
  bf16x8 qr[4];
  #pragma unroll
  for(int d0=0;d0<4;++d0)qr[d0]=*reinterpret_cast<const bf16x8*>(&Qw[(long)r32*PQ+d0*16+hi*8]);
  float mhat=0.f,l_reg=0.f;f32x16 o[2];o[0]=f32x16{};o[1]=f32x16{};const f32x16 zero16=f32x16{};
  const int qrel=wid*QBLK+r32;
  #define CMASK(P0,P1,t) do{int jb_=(t)-(NT-4); if(jb_>=0)cmask(P0,P1,jb_,qrel,hi);}while(0)
  const lds_cptr csb=(lds_cptr)cs+hi*16;
  #define BIAS(P0,P1,t) do{ const __attribute__((address_space(3))) f32x4_t* cb_=(const __attribute__((address_space(3))) f32x4_t*)(csb+(t)*256); const float nm_=-mhat; \
    _Pragma("unroll") for(int g_=0;g_<4;++g_){ const f32x4_t v0_=cb_[2*g_]+nm_; \
      P0[4*g_]+=v0_[0];P0[4*g_+1]+=v0_[1];P0[4*g_+2]+=v0_[2];P0[4*g_+3]+=v0_[3]; if(g_&1)SBAR(); } \
    _Pragma("unroll") for(int g_=0;g_<4;++g_){ const f32x4_t v1_=cb_[8+2*g_]+nm_; \
      P1[4*g_]+=v1_[0];P1[4*g_+1]+=v1_[1];P1[4*g_+2]+=v1_[2];P1[4*g_+3]+=v1_[3]; if(g_&1)SBAR(); } }while(0)
  bool resc=false;
  #define START(P0,P1) do{ const float rm=rowmax(P0,P1); resc=false; \
    { const float dl=rm; mhat=fadd_s(mhat,dl); \
      _Pragma("unroll") for(int r=0;r<16;++r){P0[r]=fsub_s(P0[r],dl);P1[r]=fsub_s(P1[r],dl);} \
    } \
    _Pragma("unroll") for(int r=0;r<16;++r)P0[r]=__builtin_amdgcn_exp2f(P0[r]); }while(0)
  #define RESC() do{ if(resc){ asm volatile("s_waitcnt lgkmcnt(0)":::"memory"); \
      _Pragma("unroll") for(int d_=0;d_<2;++d_) _Pragma("unroll") for(int r=0;r<16;++r)o[d_][r]*=wsf[crow(r,hi)]; } }while(0)
  f32x16 pA0,pA1,pB0,pB1;
  int sl_prev=0,sl_cur=0,sl_next=SLOTB;
  #define ROT() do{sl_prev=sl_cur;sl_cur=sl_next;sl_next=(sl_next==(NSLOT-1)*SLOTB)?0:sl_next+SLOTB;}while(0)
  DMA_K(2,2*SLOTB);
  WAIT_BAR(3);
  qkt(pA0,pA1,Kbase,qr,r32,hi);asm volatile("s_nop 15\n\ts_nop 7":"+v"(pA0),"+v"(pA1));BIAS(pA0,pA1,0);CMASK(pA0,pA1,0);
  START(pA0,pA1);
  _Pragma("unroll") for(int r=0;r<16;++r)pA1[r]=__builtin_amdgcn_exp2f(pA1[r]);
  WAIT_BAR(0);
  DMA_K(3,0);DMA_V(1,SLOTB);
  ROT();
  kload8(kf,kp0+sl_cur);
  WAIT_BAR(2);
  s16x4 vlo[8],vhi[8]; u32x4 pw0,pw1,pw2,pw3;
  #define PKW(P,B) cvtpk_s(P[B],P[B+1])
  #define PAF(k) __builtin_bit_cast(bf16x8,pw##k)
  #define VFR(i) (bf16x8){vlo[i][0],vlo[i][1],vlo[i][2],vlo[i][3],vhi[i][0],vhi[i][1],vhi[i][2],vhi[i][3]}
  #define PIN(x) asm volatile("":"+v"(x))
  #define MX3(a,b,c) __builtin_fmaxf(__builtin_fmaxf((a),(b)),(c))
  #define GAPA(MF,A0,A1,A2,A3,W0,W1,PW) do{ MF; sacc+=A0; sacc+=A1; sacc+=A2; sacc+=A3; PIN(sacc); W0; W1; PIN(PW); SBAR(); }while(0)
  #define EX(v) __builtin_amdgcn_exp2f(v)
  #define GAPB(MF,X,B) do{ MF; X[B]=EX(X[B]); X[B+1]=EX(X[B+1]); X[B+2]=EX(X[B+2]); X[B+3]=EX(X[B+3]); PIN(X); SBAR(); }while(0)
  #define VRD(i) do{ vlo[i]=vtr(vp_+(((i)>>2)*4096+((i)&3)*1024)); vhi[i]=vtr(vp_+(((i)>>2)*4096+((i)&3)*1024+512)); }while(0)
  #define KRD(G,j) do{ if(G){ kload2(kf,kp0+sl_next,j); SBAR(); } }while(0)
  #define STEP(C0,C1,P0,P1,t,GK,GV,GL) do{ SBAR(); \
    const lds_cptr vp_=vp0+sl_prev; \
    VRD(0); SBAR(); float sacc=(P0[0]+P0[1]); \
    GAPA(C0=__builtin_amdgcn_mfma_f32_32x32x16_bf16(kf[0],qr[0],zero16,0,0,0), P0[2],P0[3],P0[4],P0[5],     pw0[0]=PKW(P0,0), pw0[1]=PKW(P0,2), pw0); \
    VRD(4); SBAR(); GAPA(C1=__builtin_amdgcn_mfma_f32_32x32x16_bf16(kf[1],qr[0],zero16,0,0,0), P0[6],P0[7],P0[8],P0[9],     pw0[2]=PKW(P0,4), pw0[3]=PKW(P0,6), pw0); \
    VRD(1); SBAR(); GAPA(C0=__builtin_amdgcn_mfma_f32_32x32x16_bf16(kf[2],qr[1],C0,0,0,0),   P0[10],P0[11],P0[12],P0[13], pw1[0]=PKW(P0,8), pw1[1]=PKW(P0,10), pw1); \
    VRD(5); SBAR(); GAPA(C1=__builtin_amdgcn_mfma_f32_32x32x16_bf16(kf[3],qr[1],C1,0,0,0),   P0[14],P0[15],P1[0],P1[1],   pw1[2]=PKW(P0,12),pw1[3]=PKW(P0,14), pw1); \
    VRD(2); SBAR(); GAPA(C0=__builtin_amdgcn_mfma_f32_32x32x16_bf16(kf[4],qr[2],C0,0,0,0),   P1[2],P1[3],P1[4],P1[5],     pw2[0]=PKW(P1,0), pw2[1]=PKW(P1,2), pw2); \
    VRD(6); SBAR(); GAPA(C1=__builtin_amdgcn_mfma_f32_32x32x16_bf16(kf[5],qr[2],C1,0,0,0),   P1[6],P1[7],P1[8],P1[9],     pw2[2]=PKW(P1,4), pw2[3]=PKW(P1,6), pw2); \
    VRD(3); SBAR(); GAPA(C0=__builtin_amdgcn_mfma_f32_32x32x16_bf16(kf[6],qr[3],C0,0,0,0),   P1[10],P1[11],P1[12],P1[13], pw3[0]=PKW(P1,8), pw3[1]=PKW(P1,10), pw3); \
    VRD(7); SBAR(); GAPA(C1=__builtin_amdgcn_mfma_f32_32x32x16_bf16(kf[7],qr[3],C1,0,0,0),   P1[14],P1[15],0.f,0.f,       pw3[2]=PKW(P1,12),pw3[3]=PKW(P1,14), pw3); \
    l_reg+=sacc; \
    if(GK){DMA_K((t)+3,sl_cur);} if(GV){DMA_V((t)+1,sl_next);} \
    BIAS(C0,C1,t); CMASK(C0,C1,t); \
    { float a=MX3(C0[0],C0[1],C1[0]),b=MX3(C0[2],C0[3],C1[1]); a=MX3(a,C1[2],C1[3]); \
      _Pragma("unroll") for(int r=4;r<16;r+=4){a=MX3(a,C0[r],C0[r+1]);b=MX3(b,C0[r+2],C0[r+3]);a=MX3(a,C1[r],C1[r+1]);b=MX3(b,C1[r+2],C1[r+3]);} \
      float rm=__builtin_fmaxf(a,b); { auto rr=__builtin_amdgcn_permlane32_swap(__float_as_uint(rm),__float_as_uint(rm),false,false); rm=__builtin_fmaxf(__uint_as_float(rr[0]),__uint_as_float(rr[1])); } \
      resc=false; \
      if(__builtin_expect(__any(rm>(float)THRL),0)){ const float dl=__builtin_fmaxf(rm,0.f); mhat+=dl; \
        _Pragma("unroll") for(int r=0;r<16;++r){C0[r]-=dl;C1[r]-=dl;} \
        const float f=__builtin_amdgcn_exp2f(-dl); l_reg*=f; if(hi==0)wsf[r32]=f; resc=true; } } \
    SBAR(); \
    GAPB(o[0]=__builtin_amdgcn_mfma_f32_32x32x16_bf16(PAF(0),VFR(0),o[0],0,0,0), C0,0); \
    GAPB(o[1]=__builtin_amdgcn_mfma_f32_32x32x16_bf16(PAF(0),VFR(4),o[1],0,0,0), C0,4); \
    KRD(GL,0); GAPB(o[0]=__builtin_amdgcn_mfma_f32_32x32x16_bf16(PAF(1),VFR(1),o[0],0,0,0), C0,8); \
    KRD(GL,1); GAPB(o[1]=__builtin_amdgcn_mfma_f32_32x32x16_bf16(PAF(1),VFR(5),o[1],0,0,0), C0,12); \
    KRD(GL,2); GAPB(o[0]=__builtin_amdgcn_mfma_f32_32x32x16_bf16(PAF(2),VFR(2),o[0],0,0,0), C1,0); \
    KRD(GL,3); GAPB(o[1]=__builtin_amdgcn_mfma_f32_32x32x16_bf16(PAF(2),VFR(6),o[1],0,0,0), C1,4); \
    GAPB(o[0]=__builtin_amdgcn_mfma_f32_32x32x16_bf16(PAF(3),VFR(3),o[0],0,0,0), C1,8); \
    GAPB(o[1]=__builtin_amdgcn_mfma_f32_32x32x16_bf16(PAF(3),VFR(7),o[1],0,0,0), C1,12); \
    }while(0)
  int t=1;
  #undef CMASK
  #define CMASK(P0,P1,t) do{}while(0)
  for(;t+5<NT;t+=2){
    STEP(pB0,pB1,pA0,pA1,t,true,true,true);     WAIT_BAR(2); RESC(); ROT();
    STEP(pA0,pA1,pB0,pB1,t+1,true,true,true);   WAIT_BAR(2); RESC(); ROT();
  }
  #undef CMASK
  #define CMASK(P0,P1,t) do{int jb_=(t)-(NT-4); if(jb_>=0)cmask(P0,P1,jb_,qrel,hi);}while(0)
  #define ENDW(tt) do{ if((tt)+3<NT){WAIT_BAR(2);} else if((tt)+2<NT){WAIT_BAR(1);} else {WAIT_BAR(0);} }while(0)
  for(;t+1<NT;t+=2){
    STEP(pB0,pB1,pA0,pA1,t,(t+3<NT),(t+1<NT),(t+1<NT));       ENDW(t);   RESC(); ROT();
    STEP(pA0,pA1,pB0,pB1,t+1,(t+4<NT),(t+2<NT),(t+2<NT));     ENDW(t+1); RESC(); ROT();
  }
  STEP(pB0,pB1,pA0,pA1,NT-1,false,false,false); RESC();
  { float sacc=pB0[0]+pB0[1]; _Pragma("unroll") for(int r=2;r<16;++r)sacc+=pB0[r]; _Pragma("unroll") for(int r=0;r<16;++r)sacc+=pB1[r]; l_reg+=sacc;
    pw0=(u32x4){PKW(pB0,0),PKW(pB0,2),PKW(pB0,4),PKW(pB0,6)};pw1=(u32x4){PKW(pB0,8),PKW(pB0,10),PKW(pB0,12),PKW(pB0,14)};pw2=(u32x4){PKW(pB1,0),PKW(pB1,2),PKW(pB1,4),PKW(pB1,6)};pw3=(u32x4){PKW(pB1,8),PKW(pB1,10),PKW(pB1,12),PKW(pB1,14)};
    SBAR(); pv(o,vb0+sl_cur,PAF(0),PAF(1),PAF(2),PAF(3)); }
  #undef PKW
  #undef PAF
  #undef VFR
  #undef PIN
  #undef MX3
  #undef GAPA
  #undef GAPB
  #undef EX
  #undef VRD
  #undef KRD
  #undef STEP
  #undef ENDW
  {auto rr=__builtin_amdgcn_permlane32_swap(__float_as_uint(l_reg),__float_as_uint(l_reg),false,false);l_reg=__uint_as_float(rr[0])+__uint_as_float(rr[1]);}
  if(hi==0)wsf[32+r32]=l_reg;asm volatile("s_waitcnt lgkmcnt(0)":::"memory");
  float rli[16];
  #pragma unroll
  for(int r=0;r<16;++r)rli[r]=__builtin_amdgcn_rcpf(wsf[32+crow(r,hi)]);
  bf16*Ow=O+(rowbase+q0+wid*QBLK)*PO+h*D;
  { bf16*stg=(bf16*)(shm+LDS_OST)+wid*2048;
    #pragma unroll
    for(int r=0;r<16;++r){const int orow=crow(r,hi);
      #pragma unroll
      for(int d0=0;d0<2;++d0)stg[orow*64+d0*32+r32]=__float2bfloat16(o[d0][r]*rli[r]);}
    asm volatile("s_waitcnt lgkmcnt(0)":::"memory");
    const int le_=lane_now();
    #pragma unroll
    for(int i=0;i<4;++i){const int row=i*8+(le_>>3),ch=le_&7; const u32x4 v=*(const u32x4*)(stg+row*64+ch*8); ATTN_STORE16(Ow+(long)row*PO+ch*8,v);} }
  asm volatile("s_waitcnt lgkmcnt(0)\n\ts_barrier":::"memory");
  #undef BIAS
  #undef DMA_K
  #undef DMA_V
  #undef CMASK
  #undef START
  #undef RESC
  #undef ROT
}
constexpr int ATTN_LDS_BYTES=LDS_BYTES;
#undef SBAR
#undef WAIT_BAR
}

#ifndef MK_ONE_LAUNCH
#define MK_ONE_LAUNCH 1
#endif
constexpr int NWAVES = 8, NTHR = NWAVES * 64;
constexpr int Bsz = 4, S = 4096, T = Bsz * S, DM = 1024, NL = 2;
constexpr int NCH = S / 64;
constexpr int C_XA = 0, C_GA = 256, C_Q = 512, C_K = 1024, C_V = 1536, C_FL = 2048, C_P = 2056;
constexpr int C_R = C_P, C_RK = C_P + 256, C_RV = C_P + 512, C_WD = C_P + 768, C_AD = C_P + 800, C_GD = C_P + 832, DIN = C_P + 896, NP = 3072, RCOLS = 896;
constexpr int NE = 16, DE = 256, MAXTILES = 144;
constexpr float L2E = 1.4426950408889634f;
constexpr int NPH = 10;
enum { PH_PRE = 0, PH_GIN, PH_PREP, PH_MIX, PH_POST, PH_GOUT, PH_ROUTE, PH_PLACE, PH_MOE1, PH_MOE2 };
constexpr int PH_FIN = NL * NPH, N_PHASES = PH_FIN + 1;
enum { I_X = 0, I_N1G, I_WIN, I_CONVW, I_CONVB, I_WA, I_BA, I_WX, I_BX, I_LAM, I_LNG, I_FB, I_QNG, I_KNG, I_FNG, I_MU, I_W0, I_W2, I_A0, I_A2, I_G2, I_KK, I_KA, I_RK, I_RLG, I_RLB,
       I_WOUT, I_N2G, I_RGW, I_RGB, I_REW, I_REB, I_EG, I_EU, I_ED, N_IN };

constexpr size_t MiB = 1u << 20;
constexpr size_t WS_CTL = 0, CTL_ZERO_BYTES = 1 * MiB;
constexpr size_t WS_WIN = 2 * MiB, WS_WOUT = 8 * MiB, WS_WGU = 10 * MiB, WS_WD = 26 * MiB;
constexpr size_t WS_H = 34 * MiB;
constexpr size_t WS_PROJ = 66 * MiB;
constexpr size_t WS_Y = 162 * MiB;
constexpr size_t WS_HLOC = 194 * MiB, WS_CUMA = 202 * MiB;
constexpr size_t WS_ORAW = 210 * MiB;
constexpr size_t WS_G = 226 * MiB, WS_VS = 234 * MiB;
constexpr size_t WS_CLOC = 242 * MiB, WS_BON = WS_CLOC + 512 * 1024, WS_AAGG = WS_BON + 256 * 1024, WS_HAGG = WS_AAGG + 256 * 1024, WS_CTOT = WS_HAGG + 256 * 1024;
constexpr size_t WS_TOKE = 244 * MiB, WS_TOKW = WS_TOKE + 128 * 1024, WS_TSLOT = WS_TOKW + 128 * 1024;
constexpr size_t WS_ASORT = 66 * MiB, WS_HID = 138 * MiB, WS_STOK = 156 * MiB, WS_SW = 157 * MiB;
constexpr size_t WS_YE = WS_ASORT;
constexpr size_t WS_END = 256 * MiB;
static_assert(WS_ASORT + (size_t)MAXTILES * 256 * 1024 * 2 <= WS_HID && WS_HID + (size_t)MAXTILES * 256 * 256 * 2 <= WS_STOK && WS_SW + MAXTILES * 256 * 4 <= WS_Y, "MoE overlay");
static_assert(WS_PROJ + (size_t)T * NP * 2 <= WS_Y && WS_CTOT + 4 * 64 * 8 * 4 <= WS_TOKE && WS_TSLOT + 128 * 1024 <= WS_END, "d_ws map");

constexpr int CW_TMO = 0;
constexpr int CW_BAR = 4096;
constexpr int CW_CNT0 = 8192, CW_CUR0 = 8192 + 64, CW_LSTRIDE = 256;

constexpr int LDS_BYTES = 156 * 1024;
constexpr int MISC_OFF = LDS_BYTES - 256;
constexpr int LDS_TAB = 131072;

#define GAS __attribute__((address_space(1)))
#define LAS __attribute__((address_space(3)))
typedef unsigned short bf16;
typedef unsigned v4u __attribute__((ext_vector_type(4)));
typedef unsigned v2u __attribute__((ext_vector_type(2)));
typedef float f32x4 __attribute__((ext_vector_type(4)));
typedef GAS unsigned gu32;
#define RLX_AGENT __ATOMIC_RELAXED, __HIP_MEMORY_SCOPE_AGENT
typedef float f32x2_ __attribute__((ext_vector_type(2))); typedef __bf16 bf16x2_ __attribute__((ext_vector_type(2)));
__device__ __forceinline__ unsigned pk2(float lo, float hi) { f32x2_ v = {lo, hi}; bf16x2_ b = __builtin_convertvector(v, bf16x2_); return __builtin_bit_cast(unsigned, b); }
__device__ __forceinline__ unsigned f2bf(float f) { return pk2(f, 0.f) & 0xffffu; }
__device__ __forceinline__ float bf2f(bf16 v) { return __builtin_bit_cast(float, (unsigned)v << 16); }
__device__ __forceinline__ float bflo(unsigned w) { return __builtin_bit_cast(float, w << 16); }
__device__ __forceinline__ float bfhi(unsigned w) { return __builtin_bit_cast(float, w & 0xffff0000u); }
__device__ __forceinline__ float sigmoidf_(float x) { return 1.f / (1.f + __expf(-x)); }
__device__ __forceinline__ float softplusf_(float x) { return fmaxf(x, 0.f) + log1pf(__expf(-fabsf(x))); }
__device__ __forceinline__ float wave_sum(float v) {
#pragma unroll
    for (int o = 1; o < 64; o <<= 1) v += __shfl_xor(v, o);
    return v;
}
#define XB_TMO      128
#define XB_XCNT(j)  (256  + 64 * (j))
#define XB_XSUB(j)  (1280 + 64 * (j))
#define XB_XGEN(j)  (2304 + 64 * (j))
#define XB_TOP      3328
#define XB_TOPGEN   3392
#define XCD_BAR_WORDS 3456
#define XB_SPIN_CAP (1u << 21)

__device__ __forceinline__ unsigned xb_ld(unsigned* p)              { return __hip_atomic_load(p, __ATOMIC_RELAXED, __HIP_MEMORY_SCOPE_AGENT); }
__device__ __forceinline__ unsigned xb_add(unsigned* p, unsigned v) { return __hip_atomic_fetch_add(p, v, __ATOMIC_RELAXED, __HIP_MEMORY_SCOPE_AGENT); }
__device__ __forceinline__ unsigned xb_xcc_id() { return (unsigned)__builtin_amdgcn_s_getreg((3 << 11) | 20) & 0xFu; }
#define XB_SPIN(cond, bar) do { unsigned _sp = 0; while (cond) { __builtin_amdgcn_s_sleep(1); \
    if ((++_sp & 255u) == 0u) { if (xb_ld(&(bar)[XB_TMO])) break; if (_sp > XB_SPIN_CAP) { atomicAdd(&(bar)[XB_TMO], 1u); break; } } } } while (0)

struct XcdBarrier {
    unsigned* bar; unsigned x;
    volatile LAS unsigned* st;
};

__device__ __forceinline__ XcdBarrier xcd_barrier_post(unsigned* bar, volatile LAS unsigned* st) {
    XcdBarrier b; b.bar = bar; b.x = xb_xcc_id(); b.st = st;
    if (threadIdx.x == 0) (void)xb_add(&bar[XB_XCNT(b.x)], 1u);
    return b;
}
__device__ __forceinline__ void xcd_barrier_complete(unsigned* bar, unsigned x, unsigned& nloc, unsigned& nx) {
    const unsigned G = gridDim.x * gridDim.y * gridDim.z;
    unsigned sum, cnt, mine, sp = 0u;
    for (;;) {
        sum = 0u; cnt = 0u; mine = 0u;
#pragma unroll
        for (unsigned j = 0; j < 16; ++j) { const unsigned c = xb_ld(&bar[XB_XCNT(j)]); sum += c; cnt += (c > 0u) ? 1u : 0u; mine = (j == x) ? c : mine; }
        if (sum == G) break;
        __builtin_amdgcn_s_sleep(1);
        if ((++sp & 255u) == 0u) { if (xb_ld(&bar[XB_TMO])) break; if (sp > XB_SPIN_CAP) { atomicAdd(&bar[XB_TMO], 1u); break; } }
    }
    nloc = mine > 0u ? mine : 1u; nx = cnt > 0u ? cnt : 1u;
}

__device__ __forceinline__ void xcd_barrier(const XcdBarrier& b) {
    asm volatile("s_waitcnt vmcnt(0)" ::: "memory");
    __syncthreads();
    if (threadIdx.x == 0) {
        unsigned* bar = b.bar;
        __builtin_amdgcn_s_waitcnt(0);
        unsigned nloc = b.st[0], nx = b.st[1];
        if (nloc == 0u) { xcd_barrier_complete(bar, b.x, nloc, nx); b.st[0] = nloc; b.st[1] = nx; }
        const unsigned old = xb_add(&bar[XB_XSUB(b.x)], 1u);
        const unsigned gen = old / nloc;
        if (old + 1u == (gen + 1u) * nloc) {
            __builtin_amdgcn_fence(__ATOMIC_RELEASE, "agent");
            asm volatile("s_waitcnt vmcnt(0)" ::: "memory");
            const unsigned og = xb_add(&bar[XB_TOP], 1u);
            const unsigned tg = og / nx;
            if (og + 1u == (tg + 1u) * nx) xb_add(&bar[XB_TOPGEN], 1u);
            else XB_SPIN(xb_ld(&bar[XB_TOPGEN]) == tg, bar);
            __builtin_amdgcn_fence(__ATOMIC_ACQUIRE, "agent");
            xb_add(&bar[XB_XGEN(b.x)], 1u);
            asm volatile("s_waitcnt vmcnt(0)" ::: "memory");
        } else {
            XB_SPIN(xb_ld(&bar[XB_XGEN(b.x)]) == gen, bar);
            __builtin_amdgcn_fence(__ATOMIC_ACQUIRE, "agent");
            asm volatile("s_waitcnt vmcnt(0)" ::: "memory");
        }
    }
    __syncthreads();
}

struct Args { const float* in[N_IN]; float* out; unsigned char* ws; int ph_lo, ph_hi; };
typedef const __attribute__((address_space(4))) Args* CA;
__device__ __forceinline__ CA args_now() { CA p = (CA)__builtin_amdgcn_kernarg_segment_ptr(); asm volatile("" : "+s"(p)); return p; }

__device__ __forceinline__ void tr_item(const float* W, int K, int N, const float* gk, bf16* WT, int row_off, int row_stride, float* scr, int item, int nblk, int lane) {
    const int kb = item / nblk, nb = item % nblk, k0 = 64 * kb, n0 = 32 * nb;
    const int nn = n0 + (lane & 31);
#pragma unroll 8
    for (int i = 0; i < 32; ++i) { const int kk = 2 * i + (lane >> 5); float v = (nn < N) ? W[(size_t)(k0 + kk) * N + nn] : 0.f; if (gk) v *= gk[k0 + kk]; scr[kk * 33 + (lane & 31)] = v; }
    asm volatile("s_waitcnt lgkmcnt(0)" ::: "memory");
    const int c = lane & 7;
#pragma unroll
    for (int j = 0; j < 4; ++j) { const int n = (lane >> 3) + 8 * j; const float* s = scr + (8 * c) * 33 + n;
        v4u o; o.x = pk2(s[0 * 33], s[1 * 33]); o.y = pk2(s[2 * 33], s[3 * 33]); o.z = pk2(s[4 * 33], s[5 * 33]); o.w = pk2(s[6 * 33], s[7 * 33]);
        *(v4u*)(WT + (size_t)(row_off + row_stride * (n0 + n)) * K + k0 + 8 * c) = o; }
    asm volatile("s_waitcnt lgkmcnt(0)" ::: "memory");
}
__device__ __forceinline__ void rms_row_to_bf16(const float* xrow, bf16* orow, int lane) {
    const f32x4* xr = (const f32x4*)xrow + lane;
    f32x4 v[4]; float s = 0.f;
#pragma unroll
    for (int j = 0; j < 4; ++j) { v[j] = xr[64 * j]; s += (v[j].x * v[j].x + v[j].y * v[j].y) + (v[j].z * v[j].z + v[j].w * v[j].w); }
    const float rstd = rsqrtf(wave_sum(s) * (1.f / DM) + 1e-6f);
    v2u* o8 = (v2u*)orow + lane;
#pragma unroll
    for (int j = 0; j < 4; ++j) { v2u o; o.x = pk2(v[j].x * rstd, v[j].y * rstd); o.y = pk2(v[j].z * rstd, v[j].w * rstd); o8[64 * j] = o; }
}
__device__ __forceinline__ void combine_row(float* xrow, const bf16* y0, const bf16* y1, bf16* orow, int lane) {
    f32x4* xr = (f32x4*)xrow + lane; const v2u* p0 = (const v2u*)y0 + lane; const v2u* p1 = (const v2u*)y1 + lane;
    f32x4 v[4]; float s = 0.f;
#pragma unroll
    for (int j = 0; j < 4; ++j) { v[j] = xr[64 * j]; const v2u q0 = p0[64 * j], q1 = p1[64 * j];
        v[j].x += bflo(q0.x) + bflo(q1.x); v[j].y += bfhi(q0.x) + bfhi(q1.x); v[j].z += bflo(q0.y) + bflo(q1.y); v[j].w += bfhi(q0.y) + bfhi(q1.y);
        xr[64 * j] = v[j]; s += (v[j].x * v[j].x + v[j].y * v[j].y) + (v[j].z * v[j].z + v[j].w * v[j].w); }
    if (orow) { const float rstd = rsqrtf(wave_sum(s) * (1.f / DM) + 1e-6f); v2u* o8 = (v2u*)orow + lane;
#pragma unroll
        for (int j = 0; j < 4; ++j) { v2u o; o.x = pk2(v[j].x * rstd, v[j].y * rstd); o.y = pk2(v[j].z * rstd, v[j].w * rstd); o8[64 * j] = o; } }
}
__device__ __forceinline__ void phase_pre(CA a, int l, unsigned char* lds, int tid) {
    const int lane = tid & 63, wave = tid >> 6;
    float* scr = (float*)lds + wave * (64 * 33);
    const int gw = blockIdx.x * NWAVES + wave, NGW = gridDim.x * NWAVES;
    bf16* WinT = (bf16*)(a->ws + WS_WIN); bf16* WoutT = (bf16*)(a->ws + WS_WOUT); bf16* WguT = (bf16*)(a->ws + WS_WGU); bf16* WdT = (bf16*)(a->ws + WS_WD);
    constexpr int I_IN = 16 * 96, I_OUT = 16 * 32, I_E = 16 * 128;
    constexpr int NITEMS = I_IN + I_OUT + 3 * I_E;
    for (int it = gw; it < NITEMS; it += NGW) {
        int r = it;
        if (r < I_IN) { tr_item(a->in[I_WIN] + (size_t)l * DM * DIN, DM, DIN, a->in[I_N1G] + l * DM, WinT, 0, 1, scr, r, 96, lane); continue; } r -= I_IN;
        if (r < I_OUT) { tr_item(a->in[I_WOUT] + (size_t)l * DM * DM, DM, DM, nullptr, WoutT, 0, 1, scr, r, 32, lane); continue; } r -= I_OUT;
        if (r < I_E) { const int e = r >> 7, rr = r & 127; tr_item(a->in[I_EG] + (size_t)(l * NE + e) * DM * DE, DM, DE, a->in[I_N2G] + l * DM, WguT + (size_t)e * 512 * DM, 0, 2, scr, rr, 8, lane); continue; } r -= I_E;
        if (r < I_E) { const int e = r >> 7, rr = r & 127; tr_item(a->in[I_EU] + (size_t)(l * NE + e) * DM * DE, DM, DE, a->in[I_N2G] + l * DM, WguT + (size_t)e * 512 * DM, 1, 2, scr, rr, 8, lane); continue; } r -= I_E;
        { const int e = r >> 7, rr = r & 127; tr_item(a->in[I_ED] + (size_t)(l * NE + e) * DE * DM, DE, DM, nullptr, WdT + (size_t)e * DM * DE, 0, 1, scr, rr, 32, lane); }
    }
    bf16* H = (bf16*)(a->ws + WS_H);
    if (l == 0) { for (int m = gw; m < T; m += NGW) rms_row_to_bf16(a->in[I_X] + (size_t)m * DM, H + (size_t)m * DM, lane); }
    else { const int* TS = (const int*)(a->ws + WS_TSLOT); const bf16* YE = (const bf16*)(a->ws + WS_YE);
        for (int m = gw; m < T; m += NGW) combine_row(a->out + (size_t)m * DM, YE + (size_t)TS[2 * m] * DM, YE + (size_t)TS[2 * m + 1] * DM, H + (size_t)m * DM, lane); }
}
__device__ __forceinline__ void phase_fin(CA a, int tid) {
    const int lane = tid & 63, wave = tid >> 6; const int gw = blockIdx.x * NWAVES + wave, NGW = gridDim.x * NWAVES;
    const int* TS = (const int*)(a->ws + WS_TSLOT); const bf16* YE = (const bf16*)(a->ws + WS_YE);
    for (int m = gw; m < T; m += NGW) combine_row(a->out + (size_t)m * DM, YE + (size_t)TS[2 * m] * DM, YE + (size_t)TS[2 * m + 1] * DM, nullptr, lane);
}

__device__ __forceinline__ void prep_unit(CA a, int l, int u, unsigned char* lds, int tid) {
    const int b = u / NCH, c = u % NCH, t0 = c * 64; const size_t row0 = (size_t)b * S + t0;
    bf16* P = (bf16*)(a->ws + WS_PROJ);
    float* xcT = (float*)lds; float* ex = (float*)(lds + 69632); float* lfb = (float*)(lds + 71680);
    const int j = tid & 255, half = tid >> 8, hh = j >> 6, jj = j & 63;
    float xcv[32];
    {
        const float* cw = a->in[I_CONVW] + l * 4 * 256; const float cb = a->in[I_CONVB][l * 256 + j];
        const float w0 = cw[j], w1 = cw[256 + j], w2 = cw[512 + j], w3 = cw[768 + j];
        const int tb = t0 + half * 32;
        const bf16* px = P + ((size_t)b * S) * NP + C_XA + j;
        float x3 = (tb >= 3) ? bf2f(px[(size_t)(tb - 3) * NP]) : 0.f, x2 = (tb >= 2) ? bf2f(px[(size_t)(tb - 2) * NP]) : 0.f, x1 = (tb >= 1) ? bf2f(px[(size_t)(tb - 1) * NP]) : 0.f;
#pragma unroll
        for (int tt = 0; tt < 32; ++tt) { const float x0 = bf2f(px[(size_t)(tb + tt) * NP]); const float v = cb + w0 * x3 + w1 * x2 + w2 * x1 + w3 * x0;
            xcv[tt] = v; xcT[j * 68 + half * 32 + tt] = v; x3 = x2; x2 = x1; x1 = x0; }
    }
    __syncthreads();
    float aR[32], aI[32];
#pragma unroll
    for (int tt = 0; tt < 32; ++tt) { aR[tt] = 0.f; aI[tt] = 0.f; }
    {
        const float* wa = a->in[I_WA] + ((size_t)(l * 4 + hh) * 64) * 64 + jj; const float* wx = a->in[I_WX] + ((size_t)(l * 4 + hh) * 64) * 64 + jj;
#pragma unroll 2
        for (int i = 0; i < 64; ++i) { const float wai = wa[i * 64], wxi = wx[i * 64]; const f32x4* xr = (const f32x4*)(xcT + (hh * 64 + i) * 68 + half * 32);
#pragma unroll
            for (int q = 0; q < 8; ++q) { const f32x4 xv = xr[q];
                aR[4 * q] += xv.x * wai; aR[4 * q + 1] += xv.y * wai; aR[4 * q + 2] += xv.z * wai; aR[4 * q + 3] += xv.w * wai;
                aI[4 * q] += xv.x * wxi; aI[4 * q + 1] += xv.y * wxi; aI[4 * q + 2] += xv.z * wxi; aI[4 * q + 3] += xv.w * wxi; } }
    }
    {
        const float ba = a->in[I_BA][l * 256 + j], bx = a->in[I_BX][l * 256 + j], lam = a->in[I_LAM][l * 256 + j];
        const float sp = softplusf_(-lam);
        float hrun = 0.f, arun = 1.f;
#pragma unroll
        for (int tt = 0; tt < 32; ++tt) { const float r = sigmoidf_(aR[tt] + ba), ig = sigmoidf_(aI[tt] + bx); const float la = -8.f * r * sp; const float av = __expf(la);
            const float bb = sqrtf(fmaxf(-expm1f(2.f * la), 0.f)) * (ig * xcv[tt]); hrun = av * hrun + bb; arun *= av; aR[tt] = hrun; aI[tt] = arun; }
        if (half == 0) { ex[j] = hrun; ex[256 + j] = arun; }
    }
    __syncthreads();
    if (half == 1) { const float h0 = ex[j], a0 = ex[256 + j];
#pragma unroll
        for (int tt = 0; tt < 32; ++tt) { aR[tt] += aI[tt] * h0; aI[tt] *= a0; }
        ((float*)(a->ws + WS_AAGG))[(size_t)(b * NCH + c) * 256 + j] = aI[31]; ((float*)(a->ws + WS_HAGG))[(size_t)(b * NCH + c) * 256 + j] = aR[31]; }
    { bf16* HL = (bf16*)(a->ws + WS_HLOC); bf16* CA = (bf16*)(a->ws + WS_CUMA);
#pragma unroll
        for (int tt = 0; tt < 32; ++tt) { const size_t o = (row0 + half * 32 + tt) * 256 + j; HL[o] = (bf16)f2bf(aR[tt]); CA[o] = (bf16)f2bf(aI[tt]); } }
    {
        const float* qg = a->in[I_QNG] + l * 64; const float* kg = a->in[I_KNG] + l * 64;
        for (int pass = 0; pass < 16; ++pass) { const int item = pass * 64 + (tid >> 3), sub = tid & 7; const int which = item >> 9, rem = item & 511, t = rem >> 3, h = rem & 7;
            bf16* p = P + (row0 + t) * NP + (which ? C_K : C_Q) + h * 64 + sub * 8;
            const v4u raw = *(const v4u*)p; float v[8] = {bflo(raw.x), bfhi(raw.x), bflo(raw.y), bfhi(raw.y), bflo(raw.z), bfhi(raw.z), bflo(raw.w), bfhi(raw.w)};
            float ss = 0.f;
#pragma unroll
            for (int e = 0; e < 8; ++e) ss += v[e] * v[e];
            ss += __shfl_xor(ss, 1); ss += __shfl_xor(ss, 2); ss += __shfl_xor(ss, 4);
            const float rstd = rsqrtf(ss * (1.f / 64.f) + 1e-6f) * (which ? 1.f : 0.125f * L2E);
            const float* g = (which ? kg : qg) + sub * 8;
            v4u o; o.x = pk2(v[0] * rstd * g[0], v[1] * rstd * g[1]); o.y = pk2(v[2] * rstd * g[2], v[3] * rstd * g[3]); o.z = pk2(v[4] * rstd * g[4], v[5] * rstd * g[5]); o.w = pk2(v[6] * rstd * g[6], v[7] * rstd * g[7]);
            *(v4u*)p = o; }
    }
    { const int t = tid >> 3, h = tid & 7; const float fl = bf2f(P[(row0 + t) * NP + C_FL + h]) + a->in[I_FB][l * 8 + h]; lfb[t * 8 + h] = fminf(fl, 0.f) - log1pf(__expf(-fabsf(fl))); }
    __syncthreads();
    if (tid < 8) { float run = 0.f; float* CL = (float*)(a->ws + WS_CLOC);
        for (int t = 0; t < 64; ++t) { run += lfb[t * 8 + tid]; CL[(row0 + t) * 8 + tid] = run; }
        ((float*)(a->ws + WS_CTOT))[(size_t)(b * NCH + c) * 8 + tid] = run; }
    __syncthreads();
}

constexpr int ATT_CS_OFF = 86016, ATT_CB_OFF = ATT_CS_OFF + 16384;
static_assert(attn_body::ATTN_LDS_BYTES <= ATT_CS_OFF && ATT_CB_OFF + 256 <= LDS_TAB, "attention LDS map");
__device__ __forceinline__ void attn_run(CA a, int b, int h, int qb, unsigned char* lds) {
    const int lane = attn_body::lane_now(); const int tid = __builtin_amdgcn_readfirstlane(threadIdx.x >> 6) * 64 + lane;
    float* cs = (float*)(lds + ATT_CS_OFF); float* cbase = (float*)(lds + ATT_CB_OFF);
    const float* CT = (const float*)(a->ws + WS_CTOT); const float* CL = (const float*)(a->ws + WS_CLOC);
    if (tid < 64) { const float v = CT[(size_t)(b * NCH + tid) * 8 + h]; float s = v;
#pragma unroll
        for (int o = 1; o < 64; o <<= 1) { const float n = __shfl_up(s, o); if (tid >= o) s += n; }
        cbase[tid] = s - v; }
    __syncthreads();
    const int q0 = qb * 256; const float cref = cbase[q0 >> 6] + CL[((size_t)b * S + q0) * 8 + h];
    for (int jx = tid; jx < q0 + 256; jx += NTHR) cs[jx] = (cref - (cbase[jx >> 6] + CL[((size_t)b * S + jx) * 8 + h])) * L2E;
    __syncthreads();
    const attn_body::bf16* P = (const attn_body::bf16*)(a->ws + WS_PROJ);
    attn_body::attn_unit<8>(b, h, qb, P + C_Q, P + C_K, P + C_V, (attn_body::bf16*)(a->ws + WS_Y) + 256, (char*)lds, (const char*)cs);
}

typedef short bf16x8 __attribute__((ext_vector_type(8)));
constexpr int LDB = 72, MB = 64 * LDB * 2;
__device__ __forceinline__ f32x4 tile16(const unsigned char* X, int xr, const unsigned char* Y, int yr, f32x4 acc, int lane) {
    const int r = lane & 15, q = lane >> 4;
    const bf16x8 x0 = *(const bf16x8*)(X + ((xr + r) * LDB + q * 8) * 2), x1 = *(const bf16x8*)(X + ((xr + r) * LDB + 32 + q * 8) * 2);
    const bf16x8 y0 = *(const bf16x8*)(Y + ((yr + r) * LDB + q * 8) * 2), y1 = *(const bf16x8*)(Y + ((yr + r) * LDB + 32 + q * 8) * 2);
    acc = __builtin_amdgcn_mfma_f32_16x16x32_bf16(y0, x0, acc, 0, 0, 0);
    return __builtin_amdgcn_mfma_f32_16x16x32_bf16(y1, x1, acc, 0, 0, 0);
}
constexpr int R1_LR = 0, R1_W = 32768, R1_G = 65536, R1_M = 81920;
constexpr int R1_KH = R1_M, R1_BH = R1_M + MB, R1_KT = R1_M + 2 * MB, R1_RT = R1_M + 3 * MB, R1_KTT = R1_M + 4 * MB, R1_VT = R1_M + 5 * MB, R1_BGT = R1_M + 6 * MB, R1_KGT = R1_M + 7 * MB;
constexpr int R1_AT32 = 0, R1_AKKT = 16384, R1_W32 = 25600, R1_AKRT = 32768, R1_ABRT = 32768 + MB, R1_GC = 51200, R1_SEG = 51456, R1_T32 = R1_G;
constexpr int R1_NP = R1_KH, R1_VA = R1_BH, R1_TMT = R1_KT, R1_NE0 = R1_AKKT;
static_assert(R1_M + 8 * MB <= MISC_OFF && R1_W32 + 4096 <= 32768 && R1_SEG + 2048 <= 65536, "rw1 LDS map");
constexpr size_t WS_RWM = WS_H, WS_RWN = WS_H + 8 * MiB, WS_RWQ = WS_H + 16 * MiB, WS_RWO = WS_H + 24 * MiB;
constexpr size_t WS_SC = WS_ORAW;

__device__ __forceinline__ void rw1_unit(CA a, int l, int u, unsigned char* lds, int tid) {
    const int bh = u >> 6, c = u & 63, b = bh >> 2, h = bh & 3, lane = tid & 63, wave = tid >> 6;
    const size_t row0 = (size_t)b * S + c * 64;
    float* lr = (float*)(lds + R1_LR); float* w2h = (float*)(lds + R1_W); float* a2h = w2h + 2048; float* g2h = w2h + 4096; float* Gm = (float*)(lds + R1_G);
    const bf16* P = (const bf16*)(a->ws + WS_PROJ);
    const float* mu = a->in[I_MU] + l * RCOLS;
    for (int idx = tid; idx < 32 * 64; idx += NTHR) { const int jx = idx >> 6, n = idx & 63; w2h[idx] = a->in[I_W2][(size_t)(l * 32 + jx) * 256 + h * 64 + n]; a2h[idx] = a->in[I_A2][(size_t)(l * 32 + jx) * 256 + h * 64 + n]; }
    for (int idx = tid; idx < 64 * 64; idx += NTHR) { const int jx = idx >> 6, n = idx & 63; g2h[idx] = a->in[I_G2][(size_t)(l * 64 + jx) * 256 + h * 64 + n]; }
    for (int idx = tid; idx < 64 * 128; idx += NTHR) { const int t = idx >> 7, jx = idx & 127; const size_t o = (row0 + t) * NP + C_WD + jx;
        const float cur = bf2f(P[o]); const float prev = (c * 64 + t > 0) ? bf2f(P[o - NP]) : 0.f; float val = cur + (prev - cur) * mu[768 + jx];
        if (jx < 32) val = tanhf(val); else if (jx >= 64) val = sigmoidf_(val);
        lr[idx] = val; }
    __syncthreads();
    const int t = tid >> 3, n0 = (tid & 7) * 8; const size_t row = row0 + t;
    float av[8], gv[8];
    {
        float accw[8], acca[8], accg[8];
#pragma unroll
        for (int e = 0; e < 8; ++e) { accw[e] = a->in[I_W0][l * 256 + h * 64 + n0 + e]; acca[e] = a->in[I_A0][l * 256 + h * 64 + n0 + e]; accg[e] = 0.f; }
        const float* lrt = lr + t * 128;
#pragma unroll 2
        for (int jx = 0; jx < 32; ++jx) { const float lw = lrt[jx], la = lrt[32 + jx]; const f32x4 wA = *(const f32x4*)(w2h + jx * 64 + n0), wB = *(const f32x4*)(w2h + jx * 64 + n0 + 4), aA = *(const f32x4*)(a2h + jx * 64 + n0), aB = *(const f32x4*)(a2h + jx * 64 + n0 + 4);
            accw[0] += lw * wA.x; accw[1] += lw * wA.y; accw[2] += lw * wA.z; accw[3] += lw * wA.w; accw[4] += lw * wB.x; accw[5] += lw * wB.y; accw[6] += lw * wB.z; accw[7] += lw * wB.w;
            acca[0] += la * aA.x; acca[1] += la * aA.y; acca[2] += la * aA.z; acca[3] += la * aA.w; acca[4] += la * aB.x; acca[5] += la * aB.y; acca[6] += la * aB.z; acca[7] += la * aB.w; }
#pragma unroll 2
        for (int jx = 0; jx < 64; ++jx) { const float lg = lrt[64 + jx]; const f32x4 gA = *(const f32x4*)(g2h + jx * 64 + n0), gB = *(const f32x4*)(g2h + jx * 64 + n0 + 4);
            accg[0] += lg * gA.x; accg[1] += lg * gA.y; accg[2] += lg * gA.z; accg[3] += lg * gA.w; accg[4] += lg * gB.x; accg[5] += lg * gB.y; accg[6] += lg * gB.z; accg[7] += lg * gB.w; }
#pragma unroll
        for (int e = 0; e < 8; ++e) { const float wl = -softplusf_(-accw[e]) - 0.5f; Gm[t * 64 + n0 + e] = __expf(-__expf(wl)); av[e] = sigmoidf_(acca[e]); gv[e] = accg[e]; }
    }
    __syncthreads();
    {
        float* seg = (float*)(lds + R1_SEG); const int n = tid & 63, sg = tid >> 6; float p = 1.f;
#pragma unroll
        for (int i = 0; i < 8; ++i) { p *= Gm[(sg * 8 + i) * 64 + n]; Gm[(sg * 8 + i) * 64 + n] = p; }
        seg[sg * 64 + n] = p;
        __syncthreads();
        float pre = 1.f;
        for (int s2 = 0; s2 < sg; ++s2) pre *= seg[s2 * 64 + n];
#pragma unroll
        for (int i = 0; i < 8; ++i) Gm[(sg * 8 + i) * 64 + n] *= pre;
    }
    __syncthreads();
    {
        const bool hasprev = (c * 64 + t) > 0;
        const bf16* pr = P + row * NP + C_R + h * 64 + n0;
        const v4u rc = *(const v4u*)pr, kc = *(const v4u*)(pr + 256), vc = *(const v4u*)(pr + 512);
        v4u rp = {0u, 0u, 0u, 0u}, kp_ = rp, vp = rp;
        if (hasprev) { rp = *(const v4u*)(pr - NP); kp_ = *(const v4u*)(pr - NP + 256); vp = *(const v4u*)(pr - NP + 512); }
        const unsigned rcw[4] = {rc.x, rc.y, rc.z, rc.w}, kcw[4] = {kc.x, kc.y, kc.z, kc.w}, vcw[4] = {vc.x, vc.y, vc.z, vc.w};
        const unsigned rpw[4] = {rp.x, rp.y, rp.z, rp.w}, kpw[4] = {kp_.x, kp_.y, kp_.z, kp_.w}, vpw[4] = {vp.x, vp.y, vp.z, vp.w};
        float kkv[8], kpv[8], rv[8], vv[8]; float ss = 0.f, bon = 0.f;
#pragma unroll
        for (int e = 0; e < 8; ++e) { const int hn = h * 64 + n0 + e, w_ = e >> 1; const bool hi_ = e & 1;
            const float rcur = hi_ ? bfhi(rcw[w_]) : bflo(rcw[w_]), kcur = hi_ ? bfhi(kcw[w_]) : bflo(kcw[w_]), vcur = hi_ ? bfhi(vcw[w_]) : bflo(vcw[w_]);
            const float rprev = hi_ ? bfhi(rpw[w_]) : bflo(rpw[w_]), kprev = hi_ ? bfhi(kpw[w_]) : bflo(kpw[w_]), vprev = hi_ ? bfhi(vpw[w_]) : bflo(vpw[w_]);
            const float r = rcur + (rprev - rcur) * mu[hn], k = kcur + (kprev - kcur) * mu[256 + hn], v = vcur + (vprev - vcur) * mu[512 + hn];
            kkv[e] = k * a->in[I_KK][l * 256 + hn]; ss += kkv[e] * kkv[e];
            kpv[e] = k * (1.f + (av[e] - 1.f) * a->in[I_KA][l * 256 + hn]); bon += r * kpv[e] * a->in[I_RK][l * 256 + hn];
            rv[e] = r; vv[e] = v; }
        ss += __shfl_xor(ss, 1); ss += __shfl_xor(ss, 2); ss += __shfl_xor(ss, 4);
        bon += __shfl_xor(bon, 1); bon += __shfl_xor(bon, 2); bon += __shfl_xor(bon, 4);
        const float inv = 1.f / fmaxf(sqrtf(ss), 1e-12f);
        float kh[8], bh_[8], kt[8], rt[8], kg[8], bg[8];
#pragma unroll
        for (int e = 0; e < 8; ++e) { const int n = n0 + e; const float Gt = Gm[t * 64 + n], Gp = (t > 0) ? Gm[(t - 1) * 64 + n] : 1.f, GC = Gm[63 * 64 + n]; const float ig = 1.f / Gt;
            const float kkn = kkv[e] * inv; kh[e] = kpv[e] * ig; bh_[e] = kkn * av[e] * ig; kt[e] = kkn * Gp; rt[e] = rv[e] * Gt; kg[e] = kh[e] * GC; bg[e] = bh_[e] * GC; }
        v4u o;
        o.x = pk2(kh[0], kh[1]); o.y = pk2(kh[2], kh[3]); o.z = pk2(kh[4], kh[5]); o.w = pk2(kh[6], kh[7]); *(v4u*)(lds + R1_KH + (t * LDB + n0) * 2) = o;
        o.x = pk2(bh_[0], bh_[1]); o.y = pk2(bh_[2], bh_[3]); o.z = pk2(bh_[4], bh_[5]); o.w = pk2(bh_[6], bh_[7]); *(v4u*)(lds + R1_BH + (t * LDB + n0) * 2) = o;
        o.x = pk2(kt[0], kt[1]); o.y = pk2(kt[2], kt[3]); o.z = pk2(kt[4], kt[5]); o.w = pk2(kt[6], kt[7]); *(v4u*)(lds + R1_KT + (t * LDB + n0) * 2) = o;
        o.x = pk2(rt[0], rt[1]); o.y = pk2(rt[2], rt[3]); o.z = pk2(rt[4], rt[5]); o.w = pk2(rt[6], rt[7]); *(v4u*)(lds + R1_RT + (t * LDB + n0) * 2) = o;
#pragma unroll
        for (int e = 0; e < 8; ++e) { const int n = n0 + e;
            *(bf16*)(lds + R1_KTT + (n * LDB + t) * 2) = (bf16)f2bf(kt[e]); *(bf16*)(lds + R1_VT + (n * LDB + t) * 2) = (bf16)f2bf(vv[e]);
            *(bf16*)(lds + R1_BGT + (n * LDB + t) * 2) = (bf16)f2bf(bg[e]); *(bf16*)(lds + R1_KGT + (n * LDB + t) * 2) = (bf16)f2bf(kg[e]); }
        { v4u go, vo; go.x = pk2(gv[0], gv[1]); go.y = pk2(gv[2], gv[3]); go.z = pk2(gv[4], gv[5]); go.w = pk2(gv[6], gv[7]);
            vo.x = pk2(vv[0], vv[1]); vo.y = pk2(vv[2], vv[3]); vo.z = pk2(vv[4], vv[5]); vo.w = pk2(vv[6], vv[7]);
            *(v4u*)((bf16*)(a->ws + WS_G) + row * 256 + h * 64 + n0) = go; *(v4u*)((bf16*)(a->ws + WS_VS) + row * 256 + h * 64 + n0) = vo;
            if ((tid & 7) == 0) ((float*)(a->ws + WS_BON))[row * 4 + h] = bon; }
    }
    __syncthreads();
    const int mi = wave & 3, nb = (wave >> 2) * 2, r16 = lane & 15, q4 = lane >> 4;
    float* AT32 = (float*)(lds + R1_AT32); float* T32 = (float*)(lds + R1_T32); float* W32 = (float*)(lds + R1_W32); float* GCv = (float*)(lds + R1_GC);
    if (tid < 64) GCv[tid] = Gm[63 * 64 + tid];
#pragma unroll
    for (int k2 = 0; k2 < 2; ++k2) { const int ni = nb + k2; const f32x4 z = {0.f, 0.f, 0.f, 0.f};
        const f32x4 gkk = tile16(lds + R1_KT, mi * 16, lds + R1_KH, ni * 16, z, lane), gbk = tile16(lds + R1_KT, mi * 16, lds + R1_BH, ni * 16, z, lane);
        const f32x4 gkr = tile16(lds + R1_RT, mi * 16, lds + R1_KH, ni * 16, z, lane), gbr = tile16(lds + R1_RT, mi * 16, lds + R1_BH, ni * 16, z, lane);
        const int tt = mi * 16 + r16, i0 = ni * 16 + 4 * q4;
        float s0[4], s1[4], s2[4], s3[4];
#pragma unroll
        for (int j = 0; j < 4; ++j) { const bool st = (i0 + j) < tt, in = (i0 + j) <= tt; s0[j] = st ? gkk[j] : 0.f; s1[j] = st ? gbk[j] : 0.f; s2[j] = in ? gkr[j] : 0.f; s3[j] = in ? gbr[j] : 0.f; }
        v2u o; o.x = pk2(s0[0], s0[1]); o.y = pk2(s0[2], s0[3]); *(v2u*)(lds + R1_AKKT + (tt * LDB + i0) * 2) = o;
        o.x = pk2(s2[0], s2[1]); o.y = pk2(s2[2], s2[3]); *(v2u*)(lds + R1_AKRT + (tt * LDB + i0) * 2) = o;
        o.x = pk2(s3[0], s3[1]); o.y = pk2(s3[2], s3[3]); *(v2u*)(lds + R1_ABRT + (tt * LDB + i0) * 2) = o;
        *(f32x4*)(AT32 + tt * 64 + i0) = (f32x4){s1[0], s1[1], s1[2], s1[3]}; }
    __syncthreads();
    for (int idx = tid; idx < 4096; idx += NTHR) T32[idx] = 0.f;
    __syncthreads();
    if (tid < 64) { const int bk = tid >> 4, cc = tid & 15; const float* Lb = AT32 + (bk * 16) * 64 + bk * 16; float xc[16];
#pragma unroll
        for (int rr = 0; rr < 16; ++rr) { float sacc = 0.f;
#pragma unroll
            for (int j = 0; j < rr; ++j) sacc += Lb[rr * 64 + j] * xc[j];
            xc[rr] = (rr > cc) ? -sacc : ((rr == cc) ? 1.f : 0.f); T32[(bk * 16 + rr) * 64 + bk * 16 + cc] = xc[rr]; } }
    __syncthreads();
    {
        const int p = tid >> 8, rr = (tid >> 4) & 15, cc = tid & 15; const float* Bq = AT32 + ((2 * p + 1) * 16) * 64 + (2 * p) * 16; const float* X0 = T32 + ((2 * p) * 16) * 64 + (2 * p) * 16; const float* X1 = T32 + ((2 * p + 1) * 16) * 64 + (2 * p + 1) * 16;
        float sacc = 0.f;
#pragma unroll
        for (int k = 0; k < 16; ++k) sacc += Bq[rr * 64 + k] * X0[k * 64 + cc];
        W32[p * 256 + rr * 16 + cc] = sacc;
        __syncthreads();
        sacc = 0.f;
#pragma unroll
        for (int k = 0; k < 16; ++k) sacc += X1[rr * 64 + k] * W32[p * 256 + k * 16 + cc];
        T32[((2 * p + 1) * 16 + rr) * 64 + (2 * p) * 16 + cc] = -sacc;
    }
    __syncthreads();
    {
        const int rr = tid >> 4, c0 = (tid & 15) * 2; const float* Bq = AT32 + 32 * 64; const float* X1 = T32 + 32 * 64 + 32;
        float sa = 0.f, sb = 0.f;
#pragma unroll 8
        for (int k = 0; k < 32; ++k) { const float bv_ = Bq[rr * 64 + k]; sa += bv_ * T32[k * 64 + c0]; sb += bv_ * T32[k * 64 + c0 + 1]; }
        W32[rr * 32 + c0] = sa; W32[rr * 32 + c0 + 1] = sb;
        __syncthreads();
        sa = 0.f; sb = 0.f;
#pragma unroll 8
        for (int k = 0; k < 32; ++k) { const float xv = X1[rr * 64 + k]; sa += xv * W32[k * 32 + c0]; sb += xv * W32[k * 32 + c0 + 1]; }
        T32[(32 + rr) * 64 + c0] = -sa; T32[(32 + rr) * 64 + c0 + 1] = -sb;
    }
    __syncthreads();
    { const int tt = tid >> 3, i0 = (tid & 7) * 8; const f32x4 ta = *(const f32x4*)(T32 + tt * 64 + i0), tb = *(const f32x4*)(T32 + tt * 64 + i0 + 4);
        v4u o; o.x = pk2(ta.x, ta.y); o.y = pk2(ta.z, ta.w); o.z = pk2(tb.x, tb.y); o.w = pk2(tb.z, tb.w); *(v4u*)(lds + R1_TMT + (tt * LDB + i0) * 2) = o; }
    __syncthreads();
#pragma unroll
    for (int k2 = 0; k2 < 2; ++k2) { const int ni = nb + k2; const f32x4 z = {0.f, 0.f, 0.f, 0.f};
        const f32x4 gp = tile16(lds + R1_KTT, mi * 16, lds + R1_TMT, ni * 16, z, lane), gva = tile16(lds + R1_VT, mi * 16, lds + R1_AKKT, ni * 16, z, lane);
        const int xr = mi * 16 + r16, y0 = ni * 16 + 4 * q4;
        v2u o; o.x = pk2(-gp[0], -gp[1]); o.y = pk2(-gp[2], -gp[3]); *(v2u*)(lds + R1_NP + (xr * LDB + y0) * 2) = o;
        o.x = pk2(gva[0], gva[1]); o.y = pk2(gva[2], gva[3]); *(v2u*)(lds + R1_VA + (xr * LDB + y0) * 2) = o; }
    __syncthreads();
    {
        const size_t ob = (size_t)u * 4096;
        bf16* MTg = (bf16*)(a->ws + WS_RWM) + ob; bf16* QTg = (bf16*)(a->ws + WS_RWQ) + ob;
#pragma unroll
        for (int k2 = 0; k2 < 2; ++k2) { const int ni = nb + k2; const f32x4 z = {0.f, 0.f, 0.f, 0.f};
            const f32x4 ge = tile16(lds + R1_VA, mi * 16, lds + R1_TMT, ni * 16, z, lane);
            const f32x4 gm = tile16(lds + R1_BGT, mi * 16, lds + R1_NP, ni * 16, z, lane);
            const int xr = mi * 16 + r16, y0 = ni * 16 + 4 * q4;
            const v2u rt2 = *(const v2u*)(lds + R1_RT + (xr * LDB + y0) * 2);
            f32x4 q0 = {bflo(rt2.x), bfhi(rt2.x), bflo(rt2.y), bfhi(rt2.y)};
            q0 = tile16(lds + R1_ABRT, mi * 16, lds + R1_NP, ni * 16, q0, lane);
            v2u o; o.x = pk2(-ge[0], -ge[1]); o.y = pk2(-ge[2], -ge[3]); *(v2u*)(lds + R1_NE0 + (xr * LDB + y0) * 2) = o;
            const float gcx = GCv[xr];
            o.x = pk2(gm[0] + ((y0 == xr) ? gcx : 0.f), gm[1] + ((y0 + 1 == xr) ? gcx : 0.f)); o.y = pk2(gm[2] + ((y0 + 2 == xr) ? gcx : 0.f), gm[3] + ((y0 + 3 == xr) ? gcx : 0.f));
            *(v2u*)(MTg + xr * 64 + y0) = o;
            o.x = pk2(q0[0], q0[1]); o.y = pk2(q0[2], q0[3]); *(v2u*)(QTg + xr * 64 + y0) = o; }
    }
    __syncthreads();
    {
        const size_t ob = (size_t)u * 4096;
        bf16* N0g = (bf16*)(a->ws + WS_RWN) + ob; bf16* O0g = (bf16*)(a->ws + WS_RWO) + ob;
#pragma unroll
        for (int k2 = 0; k2 < 2; ++k2) { const int ni = nb + k2; f32x4 go = {0.f, 0.f, 0.f, 0.f}, gn = {0.f, 0.f, 0.f, 0.f};
            go = tile16(lds + R1_AKRT, mi * 16, lds + R1_VT, ni * 16, go, lane); go = tile16(lds + R1_ABRT, mi * 16, lds + R1_NE0, ni * 16, go, lane);
            gn = tile16(lds + R1_VT, mi * 16, lds + R1_KGT, ni * 16, gn, lane); gn = tile16(lds + R1_NE0, mi * 16, lds + R1_BGT, ni * 16, gn, lane);
            const int xr = mi * 16 + r16, y0 = ni * 16 + 4 * q4;
            v2u o; o.x = pk2(go[0], go[1]); o.y = pk2(go[2], go[3]); *(v2u*)(O0g + xr * 64 + y0) = o;
            o.x = pk2(gn[0], gn[1]); o.y = pk2(gn[2], gn[3]); *(v2u*)(N0g + xr * 64 + y0) = o; }
    }
    __syncthreads();
}

__device__ __forceinline__ void scan_unit(CA a, int su, unsigned char* lds, int tid) {
    const int bh = su >> 1, half = su & 1, lane = tid & 63, wave = tid >> 6, mi = wave & 1, ni = wave >> 1, r16 = lane & 15, q4 = lane >> 4;
    const bf16* MTg = (const bf16*)(a->ws + WS_RWM) + (size_t)bh * 64 * 4096 + (ni * 16 + r16) * 64 + q4 * 8;
    const bf16* N0g = (const bf16*)(a->ws + WS_RWN) + (size_t)bh * 64 * 4096 + (half * 32 + mi * 16 + r16) * 64 + ni * 16 + 4 * q4;
    bf16* SCg = (bf16*)(a->ws + WS_SC) + (size_t)bh * 64 * 4096 + (half * 32 + mi * 16 + r16) * 64 + ni * 16 + 4 * q4;
    unsigned char* Sb = lds;
    const int soff = ((mi * 16 + r16) * LDB + ni * 16 + 4 * q4) * 2, xoff = ((mi * 16 + r16) * LDB + q4 * 8) * 2;
    constexpr int D = 8, SBB = 32 * LDB * 2;
    bf16x8 m0[D], m1[D]; v2u nn[D];
#pragma unroll
    for (int d = 0; d < D; ++d) { m0[d] = *(const bf16x8*)(MTg + (size_t)d * 4096); m1[d] = *(const bf16x8*)(MTg + (size_t)d * 4096 + 32); nn[d] = *(const v2u*)(N0g + (size_t)d * 4096); }
    { const v2u z = {0u, 0u}; *(v2u*)(Sb + soff) = z; *(v2u*)SCg = z; }
    for (int cb = 0; cb < 64; cb += D) {
#pragma unroll
        for (int d = 0; d < D; ++d) { const int c = cb + d;
            __syncthreads();
            const unsigned char* Sc = Sb + (c & 1) * SBB;
            const bf16x8 x0 = *(const bf16x8*)(Sc + xoff), x1 = *(const bf16x8*)(Sc + xoff + 64);
            f32x4 acc = {bflo(nn[d].x), bfhi(nn[d].x), bflo(nn[d].y), bfhi(nn[d].y)};
            acc = __builtin_amdgcn_mfma_f32_16x16x32_bf16(m0[d], x0, acc, 0, 0, 0); acc = __builtin_amdgcn_mfma_f32_16x16x32_bf16(m1[d], x1, acc, 0, 0, 0);
            v2u o; o.x = pk2(acc[0], acc[1]); o.y = pk2(acc[2], acc[3]);
            *(v2u*)(Sb + ((c + 1) & 1) * SBB + soff) = o;
            if (c + 1 < 64) *(v2u*)(SCg + (size_t)(c + 1) * 4096) = o;
            if (c + D < 64) { m0[d] = *(const bf16x8*)(MTg + (size_t)(c + D) * 4096); m1[d] = *(const bf16x8*)(MTg + (size_t)(c + D) * 4096 + 32); nn[d] = *(const v2u*)(N0g + (size_t)(c + D) * 4096); } }
    }
    __syncthreads();
}

__device__ __forceinline__ float gelu_tanh(float x) { const float u = 0.7978845608028654f * (x + 0.044715f * x * x * x); return 0.5f * x * (1.f + tanhf(u)); }
__device__ __forceinline__ void post_unit(CA a, int l, int u, unsigned char* lds, int tid) {
    const int b = u / NCH, c = u % NCH, lane = tid & 63, wave = tid >> 6; const size_t row0 = (size_t)b * S + c * 64;
    float* carry = (float*)lds;
    if (tid < 256) { const float* AA = (const float*)(a->ws + WS_AAGG) + (size_t)b * NCH * 256 + tid; const float* HA = (const float*)(a->ws + WS_HAGG) + (size_t)b * NCH * 256 + tid;
        float cr = 0.f; for (int cc = 0; cc < c; ++cc) cr = AA[cc * 256] * cr + HA[cc * 256]; carry[tid] = cr; }
    __syncthreads();
    const bf16* P = (const bf16*)(a->ws + WS_PROJ); bf16* Y = (bf16*)(a->ws + WS_Y);
    const f32x4 cr4 = *(const f32x4*)(carry + 4 * lane);
    const f32x4 lg4 = *(const f32x4*)(a->in[I_LNG] + l * 256 + 4 * lane);
    const f32x4 fgA = *(const f32x4*)(a->in[I_FNG] + l * 512 + 8 * lane), fgB = *(const f32x4*)(a->in[I_FNG] + l * 512 + 8 * lane + 4);
    for (int tt = wave; tt < 64; tt += NWAVES) { const size_t row = row0 + tt;
        {
            const v2u hl = *(const v2u*)((const bf16*)(a->ws + WS_HLOC) + row * 256 + 4 * lane), ca = *(const v2u*)((const bf16*)(a->ws + WS_CUMA) + row * 256 + 4 * lane), ga = *(const v2u*)(P + row * NP + C_GA + 4 * lane);
            const float y0 = gelu_tanh(bflo(ga.x)) * (bflo(hl.x) + bflo(ca.x) * cr4.x), y1 = gelu_tanh(bfhi(ga.x)) * (bfhi(hl.x) + bfhi(ca.x) * cr4.y),
                        y2 = gelu_tanh(bflo(ga.y)) * (bflo(hl.y) + bflo(ca.y) * cr4.z), y3 = gelu_tanh(bfhi(ga.y)) * (bfhi(hl.y) + bfhi(ca.y) * cr4.w);
            const float rstd = rsqrtf(wave_sum((y0 * y0 + y1 * y1) + (y2 * y2 + y3 * y3)) * (1.f / 256.f) + 1e-6f);
            v2u o; o.x = pk2(y0 * rstd * lg4.x, y1 * rstd * lg4.y); o.y = pk2(y2 * rstd * lg4.z, y3 * rstd * lg4.w); *(v2u*)(Y + row * DM + 4 * lane) = o; }
        {
            bf16* p = Y + row * DM + 256 + 8 * lane; const v4u raw = *(const v4u*)p;
            const float v0 = bflo(raw.x), v1 = bfhi(raw.x), v2 = bflo(raw.y), v3 = bfhi(raw.y), v4 = bflo(raw.z), v5 = bfhi(raw.z), v6 = bflo(raw.w), v7 = bfhi(raw.w);
            const float rstd = rsqrtf(wave_sum(((v0 * v0 + v1 * v1) + (v2 * v2 + v3 * v3)) + ((v4 * v4 + v5 * v5) + (v6 * v6 + v7 * v7))) * (1.f / 512.f) + 1e-6f);
            v4u o; o.x = pk2(v0 * rstd * fgA.x, v1 * rstd * fgA.y); o.y = pk2(v2 * rstd * fgA.z, v3 * rstd * fgA.w); o.z = pk2(v4 * rstd * fgB.x, v5 * rstd * fgB.y); o.w = pk2(v6 * rstd * fgB.z, v7 * rstd * fgB.w);
            *(v4u*)p = o; }
    }
    {
        const int h = wave >> 1, r16 = lane & 15, q4 = lane >> 4; const size_t ub = ((size_t)((b * 4 + h) * 64 + c)) * 4096;
        const bf16* QTg = (const bf16*)(a->ws + WS_RWQ) + ub; const bf16* SCg = (const bf16*)(a->ws + WS_SC) + ub; const bf16* O0g = (const bf16*)(a->ws + WS_RWO) + ub;
        const float* rlg = a->in[I_RLG] + l * 256 + h * 64; const float* rlb = a->in[I_RLB] + l * 256 + h * 64;
#pragma unroll
        for (int m2 = 0; m2 < 2; ++m2) { const int t = (2 * (wave & 1) + m2) * 16 + r16; const size_t row = row0 + t;
            const bf16x8 x0 = *(const bf16x8*)(QTg + t * 64 + q4 * 8), x1 = *(const bf16x8*)(QTg + t * 64 + 32 + q4 * 8);
            f32x4 o[4]; float s = 0.f;
#pragma unroll
            for (int ni = 0; ni < 4; ++ni) { const bf16x8 y0 = *(const bf16x8*)(SCg + (ni * 16 + r16) * 64 + q4 * 8), y1 = *(const bf16x8*)(SCg + (ni * 16 + r16) * 64 + 32 + q4 * 8);
                const v2u ov = *(const v2u*)(O0g + t * 64 + ni * 16 + 4 * q4); o[ni] = (f32x4){bflo(ov.x), bfhi(ov.x), bflo(ov.y), bfhi(ov.y)};
                o[ni] = __builtin_amdgcn_mfma_f32_16x16x32_bf16(y0, x0, o[ni], 0, 0, 0); o[ni] = __builtin_amdgcn_mfma_f32_16x16x32_bf16(y1, x1, o[ni], 0, 0, 0);
                s += (o[ni][0] + o[ni][1]) + (o[ni][2] + o[ni][3]); }
            s += __shfl_xor(s, 16); s += __shfl_xor(s, 32);
            const float mean = s * (1.f / 64.f); float q = 0.f;
#pragma unroll
            for (int ni = 0; ni < 4; ++ni) { o[ni] = o[ni] - mean; q += (o[ni][0] * o[ni][0] + o[ni][1] * o[ni][1]) + (o[ni][2] * o[ni][2] + o[ni][3] * o[ni][3]); }
            q += __shfl_xor(q, 16); q += __shfl_xor(q, 32);
            const float rstd = rsqrtf(q * (1.f / 64.f) + 64e-5f);
            const float bon = ((const float*)(a->ws + WS_BON))[row * 4 + h];
#pragma unroll
            for (int ni = 0; ni < 4; ++ni) { const int n = ni * 16 + 4 * q4, hn = h * 64 + n;
                const f32x4 lg = *(const f32x4*)(rlg + n), lb = *(const f32x4*)(rlb + n);
                const v2u g2_ = *(const v2u*)((const bf16*)(a->ws + WS_G) + row * 256 + hn), vs = *(const v2u*)((const bf16*)(a->ws + WS_VS) + row * 256 + hn);
                const float z0 = (o[ni][0] * rstd * lg.x + lb.x + bon * bflo(vs.x)) * bflo(g2_.x), z1 = (o[ni][1] * rstd * lg.y + lb.y + bon * bfhi(vs.x)) * bfhi(g2_.x),
                            z2 = (o[ni][2] * rstd * lg.z + lb.z + bon * bflo(vs.y)) * bflo(g2_.y), z3 = (o[ni][3] * rstd * lg.w + lb.w + bon * bfhi(vs.y)) * bfhi(g2_.y);
                v2u ow; ow.x = pk2(z0, z1); ow.y = pk2(z2, z3); *(v2u*)(Y + row * DM + 768 + hn) = ow; } }
    }
    __syncthreads();
}

struct EpiResF32 {
    static constexpr bool PERM = true, AFTER_DRAIN = false;
    const float* X; float* O;
    __device__ __forceinline__ void operator()(const pg8::f32x4 (&acc)[2][2][4][2], const pg8::Unit& u, int wr, int wc, int fr, int fq) const {
        const int row0 = u.pm * 256 + wr * 64 + fr, col0 = u.pn * 256 + wc * 32 + 8 * fq;
#pragma unroll
        for (int ai = 0; ai < 2; ++ai)
#pragma unroll
            for (int m = 0; m < 4; ++m) { const size_t ro = (size_t)(row0 + ai * 128 + m * 16) * DM + col0;
#pragma unroll
                for (int bj = 0; bj < 2; ++bj) { const pg8::f32x4 x0 = *(const pg8::f32x4*)(X + ro + bj * 128), x1 = *(const pg8::f32x4*)(X + ro + bj * 128 + 4);
                    *(pg8::f32x4*)(O + ro + bj * 128) = x0 + acc[ai][bj][m][0]; *(pg8::f32x4*)(O + ro + bj * 128 + 4) = x1 + acc[ai][bj][m][1]; } }
    }
};
struct MoeSched {
    const int* tst; int NJ, nunits, G, c;
    __device__ __forceinline__ bool next(int i, pg8::Unit& u) const {
        const int L = i * G + c; if (L >= nunits) return false;
        const int tile = L / NJ, j = L % NJ; int e = 0;
#pragma unroll
        for (int k = 1; k < NE; ++k) e += (tile >= tst[k]) ? 1 : 0;
        u.pm = tile; u.pn = e * NJ + j; return true;
    }
    __device__ __forceinline__ void a_ready(const pg8::Unit&) const {}
    __device__ __forceinline__ void done(const pg8::Unit&) const {}
};
struct EpiSwiglu {
    static constexpr bool PERM = true, AFTER_DRAIN = false;
    bf16* HID; const float* SW; const int* tst; const int* cnt;
    __device__ __forceinline__ void operator()(const pg8::f32x4 (&acc)[2][2][4][2], const pg8::Unit& u, int wr, int wc, int fr, int fq) const {
        const int e = u.pn >> 1, j = u.pn & 1, seg0 = tst[e] * 256, ce = cnt[e];
        const int row0 = u.pm * 256 + wr * 64 + fr, hc0 = j * 128 + wc * 16 + 4 * fq;
#pragma unroll
        for (int ai = 0; ai < 2; ++ai)
#pragma unroll
            for (int m = 0; m < 4; ++m) { const int row = row0 + ai * 128 + m * 16; const bool valid = (row - seg0) < ce; const float w = valid ? SW[row] : 0.f;
#pragma unroll
                for (int bj = 0; bj < 2; ++bj) { const pg8::f32x4 v0 = acc[ai][bj][m][0], v1 = acc[ai][bj][m][1];
                    float h0 = v0[0] * sigmoidf_(v0[0]) * v0[1] * w, h1 = v0[2] * sigmoidf_(v0[2]) * v0[3] * w, h2 = v1[0] * sigmoidf_(v1[0]) * v1[1] * w, h3 = v1[2] * sigmoidf_(v1[2]) * v1[3] * w;
                    if (!valid) { h0 = 0.f; h1 = 0.f; h2 = 0.f; h3 = 0.f; }
                    v2u o; o.x = pk2(h0, h1); o.y = pk2(h2, h3); *(v2u*)(HID + (size_t)row * DE + hc0 + bj * 64) = o; } }
    }
};
struct EpiYE {
    static constexpr bool PERM = true, AFTER_DRAIN = false;
    bf16* YE;
    __device__ __forceinline__ void operator()(const pg8::f32x4 (&acc)[2][2][4][2], const pg8::Unit& u, int wr, int wc, int fr, int fq) const {
        const int j = u.pn & 3; const int row0 = u.pm * 256 + wr * 64 + fr, col0 = j * 256 + wc * 32 + 8 * fq;
#pragma unroll
        for (int ai = 0; ai < 2; ++ai)
#pragma unroll
            for (int m = 0; m < 4; ++m) { bf16* rowp = YE + (size_t)(row0 + ai * 128 + m * 16) * DM + col0;
#pragma unroll
                for (int bj = 0; bj < 2; ++bj) { const pg8::f32x4 v0 = acc[ai][bj][m][0], v1 = acc[ai][bj][m][1];
                    v4u w; w.x = pk2(v0[0], v0[1]); w.y = pk2(v0[2], v0[3]); w.z = pk2(v1[0], v1[1]); w.w = pk2(v1[2], v1[3]); *(v4u*)(rowp + bj * 128) = w; } }
    }
};

__device__ __forceinline__ void phase_route(CA a, int l, unsigned char* lds, int tid, gu32* ctl) {
    const int lane = tid & 63, wave = tid >> 6; const int gw = blockIdx.x * NWAVES + wave, NGW = gridDim.x * NWAVES;
    float* rw = (float*)lds; int* hist = (int*)(lds + 81920);
    { const float* g2 = a->in[I_N2G] + l * DM; const float* gwp = a->in[I_RGW] + (size_t)l * DM * 4; const float* ewp = a->in[I_REW] + (size_t)l * DM * NE;
        for (int idx = tid; idx < DM * 20; idx += NTHR) { const int d = idx / 20, cx = idx % 20; rw[idx] = g2[d] * (cx < 4 ? gwp[d * 4 + cx] : ewp[d * NE + cx - 4]); } }
    if (tid < NE) hist[tid] = 0;
    __syncthreads();
    bf16* H = (bf16*)(a->ws + WS_H); int* TE = (int*)(a->ws + WS_TOKE); float* TW = (float*)(a->ws + WS_TOKW);
    const float* gb = a->in[I_RGB] + l * 4; const float* eb = a->in[I_REB] + l * NE;
    for (int m = gw; m < T; m += NGW) {
        const f32x4* xr = (const f32x4*)(a->out + (size_t)m * DM) + lane;
        f32x4 v[4]; float s = 0.f;
#pragma unroll
        for (int j = 0; j < 4; ++j) { v[j] = xr[64 * j]; s += (v[j].x * v[j].x + v[j].y * v[j].y) + (v[j].z * v[j].z + v[j].w * v[j].w); }
        const float rstd = rsqrtf(wave_sum(s) * (1.f / DM) + 1e-6f);
        v2u* o8 = (v2u*)(H + (size_t)m * DM) + lane;
        float acc[20];
#pragma unroll
        for (int cx = 0; cx < 20; ++cx) acc[cx] = 0.f;
#pragma unroll
        for (int j = 0; j < 4; ++j) { v[j] = v[j] * rstd; v2u o; o.x = pk2(v[j].x, v[j].y); o.y = pk2(v[j].z, v[j].w); o8[64 * j] = o;
#pragma unroll
            for (int e = 0; e < 4; ++e) { const float xv = v[j][e]; const f32x4* wr = (const f32x4*)(rw + (size_t)(4 * lane + 256 * j + e) * 20);
#pragma unroll
                for (int q = 0; q < 5; ++q) { const f32x4 w4 = wr[q]; acc[4 * q] += xv * w4.x; acc[4 * q + 1] += xv * w4.y; acc[4 * q + 2] += xv * w4.z; acc[4 * q + 3] += xv * w4.w; } } }
#pragma unroll
        for (int cx = 0; cx < 20; ++cx) acc[cx] = wave_sum(acc[cx]);
        const float g0 = acc[0] + gb[0], g1 = acc[1] + gb[1], g2_ = acc[2] + gb[2], g3 = acc[3] + gb[3];
        int gi = 0; float gm = g0; if (g1 > gm) { gm = g1; gi = 1; } if (g2_ > gm) { gm = g2_; gi = 2; } if (g3 > gm) { gm = g3; gi = 3; }
        const float gp = 1.f / (__expf(g0 - gm) + __expf(g1 - gm) + __expf(g2_ - gm) + __expf(g3 - gm));
        float el[4];
#pragma unroll
        for (int k = 0; k < 4; ++k) el[k] = (gi == 0 ? acc[4 + k] : gi == 1 ? acc[8 + k] : gi == 2 ? acc[12 + k] : acc[16 + k]) + eb[gi * 4 + k];
        int i0 = 0; float m0 = el[0]; if (el[1] > m0) { m0 = el[1]; i0 = 1; } if (el[2] > m0) { m0 = el[2]; i0 = 2; } if (el[3] > m0) { m0 = el[3]; i0 = 3; }
        int i1 = -1; float m1 = -INFINITY;
#pragma unroll
        for (int k = 0; k < 4; ++k) { if (k != i0 && el[k] > m1) { m1 = el[k]; i1 = k; } }
        const float p0 = 1.f / (1.f + __expf(m1 - m0)), p1 = 1.f - p0;
        if (lane == 0) { const int e0 = gi * 4 + i0, e1 = gi * 4 + i1; TE[m * 2] = e0; TE[m * 2 + 1] = e1; TW[m * 2] = gp * p0; TW[m * 2 + 1] = gp * p1; atomicAdd(&hist[e0], 1); atomicAdd(&hist[e1], 1); }
    }
    __syncthreads();
    if (tid < NE) __hip_atomic_fetch_add((unsigned*)(ctl + CW_CNT0 + l * CW_LSTRIDE + tid), (unsigned)hist[tid], RLX_AGENT);
}

__device__ __forceinline__ void moe_tables(int l, unsigned char* lds, int tid, gu32* ctl) {
    int* tst = (int*)(lds + LDS_TAB); int* cnt = tst + 32;
    if (tid == 0) { int acc = 0; for (int e = 0; e < NE; ++e) { const int ce = (int)__hip_atomic_load(ctl + CW_CNT0 + l * CW_LSTRIDE + e, RLX_AGENT); cnt[e] = ce; tst[e] = acc; acc += (ce + 255) >> 8; } tst[NE] = acc; }
    __syncthreads();
}
__device__ __forceinline__ void phase_place(CA a, int l, unsigned char* lds, int tid, gu32* ctl) {
    const int lane = tid & 63, wave = tid >> 6;
    int* tst = (int*)(lds + LDS_TAB); int* lcnt = (int*)lds; int* lbase = lcnt + 16; int* sslot = lcnt + 32;
    const int* TE = (const int*)(a->ws + WS_TOKE); const float* TW = (const float*)(a->ws + WS_TOKW); float* SW = (float*)(a->ws + WS_SW); int* TSL = (int*)(a->ws + WS_TSLOT);
    const bf16* H = (const bf16*)(a->ws + WS_H); bf16* AS = (bf16*)(a->ws + WS_ASORT);
    for (int u = blockIdx.x; u < T / 64; u += gridDim.x) {
        if (tid < NE) lcnt[tid] = 0;
        __syncthreads();
        int e = 0, lrank = 0, t = 0; float w = 0.f;
        if (tid < 128) { t = u * 64 + (tid >> 1); e = TE[t * 2 + (tid & 1)]; w = TW[t * 2 + (tid & 1)]; lrank = atomicAdd(&lcnt[e], 1); }
        __syncthreads();
        if (tid < NE) lbase[tid] = (int)__hip_atomic_fetch_add((unsigned*)(ctl + CW_CUR0 + l * CW_LSTRIDE + tid), (unsigned)lcnt[tid], RLX_AGENT);
        __syncthreads();
        if (tid < 128) { const int slot = tst[e] * 256 + lbase[e] + lrank; TSL[t * 2 + (tid & 1)] = slot; SW[slot] = w; sslot[tid] = slot; }
        __syncthreads();
#pragma unroll 4
        for (int i = 0; i < 16; ++i) { const int p = wave * 16 + i; const int tk = u * 64 + (p >> 1); const int slot = sslot[p];
            const v4u* src = (const v4u*)(H + (size_t)tk * DM) + lane; v4u* dst = (v4u*)(AS + (size_t)slot * DM) + lane; dst[0] = src[0]; dst[64] = src[64]; }
        __syncthreads();
    }
}

__global__ void __launch_bounds__(NTHR, 2) fwd(Args a_unused) {
    extern __shared__ __attribute__((aligned(16))) unsigned char lds[];
    volatile LAS unsigned* MISC = (volatile LAS unsigned*)((LAS unsigned char*)lds + MISC_OFF);
    if (threadIdx.x < 64) MISC[threadIdx.x] = 0u;
    __syncthreads();
#if MK_ONE_LAUNCH
    XcdBarrier bar = xcd_barrier_post((unsigned*)(args_now()->ws + WS_CTL) + CW_BAR, MISC + 8);
#define SEAM(k) do { if (IN((k) + 1)) xcd_barrier(bar); } while (0)
#else
#define SEAM(k) do { } while (0)
#endif
    const int lo = args_now()->ph_lo, hi = args_now()->ph_hi;
#ifndef PHASE_MASK
#define PHASE_MASK 0x3ff
#endif
#define IN(k) (((PHASE_MASK >> ((k) % NPH)) & 1) && lo <= (k) && (k) < hi)
    for (int l = 0; l < NL; ++l) {
        const int pb = l * NPH;
        if (IN(pb + PH_PRE)) { phase_pre(args_now(), l, lds, pg8::tid_now()); SEAM(pb + PH_PRE); }
        if (IN(pb + PH_GIN)) { CA a = args_now();
            pg8::Gemm g{(const pg8::bf16_t*)(a->ws + WS_H), (const pg8::bf16_t*)(a->ws + WS_WIN), T, NP, DM}; pg8::StaticOrder So; So.init(T, NP, (int)gridDim.x, (int)blockIdx.x);
            pg8::EpiBf16<0> E{(pg8::bf16_t*)(a->ws + WS_PROJ), NP, nullptr, 0, 0, 1.f};
            pg8::gemm_phase<pg8::EpiBf16<0>, pg8::StaticOrder, true, true>((PG8_LAS unsigned char*)lds, g, So, E);
            SEAM(pb + PH_GIN);
        }
        if (IN(pb + PH_PREP)) {
            for (int u = blockIdx.x; u < Bsz * NCH; u += gridDim.x) prep_unit(args_now(), l, u, lds, pg8::tid_now());
            for (int u = blockIdx.x; u < Bsz * 4 * NCH; u += gridDim.x) rw1_unit(args_now(), l, u, lds, pg8::tid_now());
            SEAM(pb + PH_PREP);
        }
        if (IN(pb + PH_MIX)) {
            for (int su = blockIdx.x; su < Bsz * 4 * 2; su += gridDim.x) scan_unit(args_now(), su, lds, pg8::tid_now());
            for (int v = blockIdx.x; v < Bsz * 8 * 8; v += gridDim.x) { const int bh = v >> 3, s = v & 7;
                attn_run(args_now(), bh >> 3, bh & 7, 15 - s, lds); attn_run(args_now(), bh >> 3, bh & 7, s, lds); }
            SEAM(pb + PH_MIX);
        }
        if (IN(pb + PH_POST)) { for (int u = blockIdx.x; u < Bsz * NCH; u += gridDim.x) post_unit(args_now(), l, u, lds, pg8::tid_now()); SEAM(pb + PH_POST); }
        if (IN(pb + PH_GOUT)) { CA a = args_now();
            pg8::Gemm g{(const pg8::bf16_t*)(a->ws + WS_Y), (const pg8::bf16_t*)(a->ws + WS_WOUT), T, DM, DM}; pg8::StaticOrder So; So.init(T, DM, (int)gridDim.x, (int)blockIdx.x);
            EpiResF32 E{(l == 0) ? a->in[I_X] : a->out, a->out};
            pg8::gemm_phase<EpiResF32, pg8::StaticOrder, true, true>((PG8_LAS unsigned char*)lds, g, So, E);
            SEAM(pb + PH_GOUT);
        }
        if (IN(pb + PH_ROUTE)) { CA a = args_now(); phase_route(a, l, lds, pg8::tid_now(), (gu32*)(a->ws + WS_CTL)); SEAM(pb + PH_ROUTE); }
        if (IN(pb + PH_PLACE)) { CA a = args_now(); const int tid = pg8::tid_now(); gu32* ctl = (gu32*)(a->ws + WS_CTL); moe_tables(l, lds, tid, ctl); phase_place(a, l, lds, tid, ctl); SEAM(pb + PH_PLACE); }
        if (IN(pb + PH_MOE1)) { CA a = args_now();
            moe_tables(l, lds, pg8::tid_now(), (gu32*)(a->ws + WS_CTL));
            const int* tst = (const int*)(lds + LDS_TAB); const int* cnt = tst + 32;
            pg8::Gemm g{(const pg8::bf16_t*)(a->ws + WS_ASORT), (const pg8::bf16_t*)(a->ws + WS_WGU), MAXTILES * 256, NE * 512, DM};
            MoeSched Sm{tst, 2, tst[NE] * 2, (int)gridDim.x, (int)blockIdx.x};
            EpiSwiglu E{(bf16*)(a->ws + WS_HID), (const float*)(a->ws + WS_SW), tst, cnt};
            pg8::gemm_phase<EpiSwiglu, MoeSched, true, true>((PG8_LAS unsigned char*)lds, g, Sm, E);
            SEAM(pb + PH_MOE1);
        }
        if (IN(pb + PH_MOE2)) { CA a = args_now();
            moe_tables(l, lds, pg8::tid_now(), (gu32*)(a->ws + WS_CTL));
            const int* tst = (const int*)(lds + LDS_TAB);
            int Kd = DE; asm volatile("" : "+s"(Kd));
            pg8::Gemm g{(const pg8::bf16_t*)(a->ws + WS_HID), (const pg8::bf16_t*)(a->ws + WS_WD), MAXTILES * 256, NE * DM, Kd};
            MoeSched Sm{tst, 4, tst[NE] * 4, (int)gridDim.x, (int)blockIdx.x};
            EpiYE E{(bf16*)(a->ws + WS_YE)};
            pg8::gemm_phase<EpiYE, MoeSched, true, true>((PG8_LAS unsigned char*)lds, g, Sm, E);
            SEAM(pb + PH_MOE2);
        }
    }
    if (IN(PH_FIN)) phase_fin(args_now(), pg8::tid_now());
#undef IN
#undef SEAM
}

extern "C" void kernel_launch(void* const* d_in, const int* in_sizes, int n_in, void* d_out, int out_size, void* d_ws, size_t ws_size, hipStream_t stream) {
    static int grid = 0;
    if (grid == 0) {
        if (n_in != N_IN || in_sizes[0] != T * DM || out_size != T * DM || ws_size < WS_END) { fprintf(stderr, "kernel_launch: unexpected problem shape (n_in %d, in0 %d, out %d, ws %zu); nothing launched\n", n_in, n_in > 0 ? in_sizes[0] : -1, out_size, ws_size); grid = -1; return; }
        int dev = 0, cus = 0, per_cu = 0;
        if (hipGetDevice(&dev) != hipSuccess || hipDeviceGetAttribute(&cus, hipDeviceAttributeMultiprocessorCount, dev) != hipSuccess) { grid = -1; return; }
        if (hipFuncSetAttribute((const void*)fwd, hipFuncAttributeMaxDynamicSharedMemorySize, LDS_BYTES) != hipSuccess) { fprintf(stderr, "kernel_launch: hipFuncSetAttribute failed\n"); grid = -1; return; }
        if (hipOccupancyMaxActiveBlocksPerMultiprocessor(&per_cu, (const void*)fwd, NTHR, LDS_BYTES) != hipSuccess || per_cu < 1) { fprintf(stderr, "kernel_launch: occupancy query reports %d workgroups per CU\n", per_cu); }
        (void)hipGetLastError();
        grid = cus;
    }
    if (grid < 0) return;
    if (hipMemsetAsync((char*)d_ws + WS_CTL, 0, CTL_ZERO_BYTES, stream) != hipSuccess) return;
    Args a{};
    for (int i = 0; i < N_IN; ++i) a.in[i] = (const float*)d_in[i];
    a.out = (float*)d_out; a.ws = (unsigned char*)d_ws;
#if MK_ONE_LAUNCH
    a.ph_lo = 0; a.ph_hi = N_PHASES;
    hipLaunchKernelGGL(fwd, dim3(grid), dim3(NTHR), LDS_BYTES, stream, a);
#else
    for (int p = 0; p < N_PHASES; ++p) { a.ph_lo = p; a.ph_hi = p + 1; hipLaunchKernelGGL(fwd, dim3(grid), dim3(NTHR), LDS_BYTES, stream, a); }
#endif
}
```

```cpp
#include <hip/hip_runtime.h>
#include <hip/hip_bf16.h>
#include <cstdio>
#include <cstdint>
#include <cmath>
namespace pg8 {
#define PG8_LAS __attribute__((address_space(3)))
typedef unsigned short bf16_t;
typedef short bf16x8 __attribute__((ext_vector_type(8)));
typedef float f32x4 __attribute__((ext_vector_type(4)));
typedef unsigned u32x4 __attribute__((ext_vector_type(4)));
__device__ __forceinline__ int tid_now() { int t = threadIdx.x; asm volatile("" : "+v"(t)); return t; }
constexpr int BM = 256, BK = 64, HALF = 128, HTB = HALF * BK * 2  , STAGE_BYTES = 8 * HTB, NXCD = 8, WGM = 8;

__host__ __device__ __forceinline__ int lds_byte(int r, int c) { const int st = (r >> 4) * 2 + (c >> 5), rr = r & 15, cc = c & 31, ob = rr * 64 + cc * 2; return st * 1024 + (ob ^ (((ob >> 9) & 1) << 5)); }
__host__ __device__ __forceinline__ void stage_rc(int b, int& R, int& C) { const int st = b / 1024, sb = b % 1024, swz = sb ^ (((sb >> 9) & 1) << 5); R = (st >> 1) * 16 + swz / 64; C = (st & 1) * 32 + (swz % 64) / 2; }
__host__ __device__ __forceinline__ int perm32(int rho) { const int n = rho >> 4, i = rho & 15; return 8 * (i >> 2) + 4 * n + (i & 3); }

struct Unit { int pm, pn; };
struct Gemm { const bf16_t* A; const bf16_t* Bt; int M, N, K; };

struct StaticOrder {
    int nM, nN, nwg, G, c;
    __host__ __device__ void init(int M, int N, int G_, int c_) { nM = M / BM; nN = N / BM; nwg = nM * nN; G = G_; c = c_; }
    __host__ __device__ bool next(int i, Unit& u) const {
        const long L = (long)i * G + c; if (L >= nwg) return false;
        int wgid = (int)L; { const int q = nwg / NXCD, r = nwg % NXCD, xcd = wgid % NXCD, off = wgid / NXCD; wgid = (xcd < r ? xcd * (q + 1) : r * (q + 1) + (xcd - r) * q) + off; }
        const int nig = WGM * nN, gid = wgid / nig, fm = gid * WGM, gsz = (nM - fm) < WGM ? (nM - fm) : WGM;
        u.pm = fm + ((wgid % nig) % gsz); u.pn = (wgid % nig) / gsz; return true;
    }
    __device__ __forceinline__ void a_ready(const Unit&) const {}
    __device__ __forceinline__ void done(const Unit&) const {}
};

__device__ __forceinline__ unsigned cvt_pk_bf16(float lo, float hi) { unsigned r; asm volatile("v_cvt_pk_bf16_f32 %0, %1, %2" : "=v"(r) : "v"(lo), "v"(hi)); return r; }
typedef float f32x2 __attribute__((ext_vector_type(2)));
__device__ __forceinline__ f32x2 gelu_pk(f32x2 v) {
    const f32x2 av = __builtin_elementwise_abs(v), d = av * 0.2316418882f + 1.0f;
    f32x2 t; t.x = __builtin_amdgcn_rcpf(d.x); t.y = __builtin_amdgcn_rcpf(d.y);
    f32x2 q = t * 0.5307027145f + (-0.7265760135f); q = q * t + 0.7107068705f; q = q * t + (-0.142248368f); q = q * t + 0.127414796f; q = q * t;
    const f32x2 s = (v * v) * (-0.72134752044f);
    f32x2 e; e.x = __builtin_amdgcn_exp2f(s.x); e.y = __builtin_amdgcn_exp2f(s.y);
    const f32x2 m = v * (q * e), r = v - m;
    f32x2 o; o.x = v.x < 0.f ? m.x : r.x; o.y = v.y < 0.f ? m.y : r.y; return o;
}

template <int ACT  > struct EpiBf16 {
    static constexpr bool PERM = true, AFTER_DRAIN = false; static_assert(ACT == 0 || ACT == 1, "EpiBf16: ACT is 0 (none) or 1 (gelu_pk)");
    bf16_t* O; int ldc; const float* bias; int split_cols; size_t split_stride; float scale0;
    __device__ __forceinline__ void operator()(const f32x4 (&acc)[2][2][4][2], const Unit& u, int wr, int wc, int fr, int fq) const {
        const int row0 = u.pm * BM + wr * 64 + fr; int colt = u.pn * BM; bf16_t* base = O;
        float sc = 1.f; if (split_cols) { const int t = colt / split_cols; base += (size_t)t * split_stride; colt -= t * split_cols; if (t == 0) sc = scale0; }
        const int col0 = colt + wc * 32 + 8 * fq, bcol0 = u.pn * BM + wc * 32 + 8 * fq;
        f32x4 bv[2][2];
#pragma unroll
        for (int bj = 0; bj < 2; ++bj)
#pragma unroll
            for (int n = 0; n < 2; ++n) bv[bj][n] = bias ? *(const f32x4*)(bias + bcol0 + bj * HALF + 4 * n) : (f32x4){0.f, 0.f, 0.f, 0.f};
#pragma unroll
        for (int ai = 0; ai < 2; ++ai)
#pragma unroll
            for (int m = 0; m < 4; ++m) { bf16_t* rowp = base + (size_t)(row0 + ai * HALF + m * 16) * ldc + col0;
#pragma unroll
                for (int bj = 0; bj < 2; ++bj) { f32x4 v0 = acc[ai][bj][m][0] + bv[bj][0], v1 = acc[ai][bj][m][1] + bv[bj][1];
                    if (ACT == 1) { f32x2 a = gelu_pk((f32x2){v0[0], v0[1]}), b = gelu_pk((f32x2){v0[2], v0[3]}), c = gelu_pk((f32x2){v1[0], v1[1]}), d = gelu_pk((f32x2){v1[2], v1[3]});
                        v0 = (f32x4){a.x, a.y, b.x, b.y}; v1 = (f32x4){c.x, c.y, d.x, d.y}; }
                    v0 = v0 * sc; v1 = v1 * sc; u32x4 w; w.x = cvt_pk_bf16(v0[0], v0[1]); w.y = cvt_pk_bf16(v0[2], v0[3]); w.z = cvt_pk_bf16(v1[0], v1[1]); w.w = cvt_pk_bf16(v1[2], v1[3]);
                    *(u32x4*)(rowp + bj * HALF) = w; } }
    }
};
template <class Epi, class Sched, bool ALIGN_EPI = false, bool SP2 = false>
__device__ __forceinline__ void gemm_phase(PG8_LAS unsigned char* lds, const Gemm g, const Sched& S, const Epi& E) {
    const int tid = tid_now(), wid = __builtin_amdgcn_readfirstlane(tid >> 6), lane = tid & 63, wr = wid >> 2, wc = wid & 3, fr = lane & 15, fq = lane >> 4;
    const int K = g.K, nt = K / BK;
    unsigned voffA[2], voffB[2];
#pragma unroll
    for (int i = 0; i < 2; ++i) { int R, C; stage_rc(tid * 16 + i * 8192, R, C); const int Rb = Epi::PERM ? ((R & ~31) + perm32(R & 31)) : R;
        voffA[i] = (unsigned)(R * K + C) * 2u; voffB[i] = (unsigned)(Rb * K + C) * 2u; }
    const size_t kstep = (size_t)(BK * 2);
    const size_t hstep = (size_t)HALF * K * 2;
    const size_t tstep = 2 * hstep;
    const unsigned ldsw = (unsigned)wid * 1024u;
    const int aoff = lds_byte(wr * 64 + fr, fq * 8), boff = lds_byte(wc * 32 + fr, fq * 8);
#define PG8_SA(b, h) (((b) * 2 + (h)) * HTB)
#define PG8_SB(b, h) ((4 + (b) * 2 + (h)) * HTB)
#define PG8_STAGE(bufoff, gbase, voff) do { _Pragma("unroll") for (int _i = 0; _i < 2; ++_i) \
        __builtin_amdgcn_global_load_lds((const unsigned*)((const char*)(gbase) + (voff)[_i]), (PG8_LAS unsigned*)(lds + (bufoff) + ldsw + _i * 8192), 16, 0, 0); } while (0)
#define PG8_LDA(dst, b, h) do { _Pragma("unroll") for (int m = 0; m < 4; ++m) _Pragma("unroll") for (int k = 0; k < 2; ++k) dst[m][k] = *(const PG8_LAS bf16x8*)(lds + PG8_SA(b, h) + aoff + m * 2048 + k * 1024); } while (0)
#define PG8_LDB(dst, b, h) do { _Pragma("unroll") for (int n = 0; n < 2; ++n) _Pragma("unroll") for (int k = 0; k < 2; ++k) dst[n][k] = *(const PG8_LAS bf16x8*)(lds + PG8_SB(b, h) + boff + n * 2048 + k * 1024); } while (0)
#define PG8_MMA(ai, bj, At, Bt) do { __builtin_amdgcn_s_setprio(1); _Pragma("unroll") for (int m = 0; m < 4; ++m) _Pragma("unroll") for (int n = 0; n < 2; ++n) _Pragma("unroll") for (int k = 0; k < 2; ++k) \
        acc[ai][bj][m][n] = __builtin_amdgcn_mfma_f32_16x16x32_bf16(Bt[n][k], At[m][k], acc[ai][bj][m][n], 0, 0, 0); __builtin_amdgcn_s_setprio(0); } while (0)
#define PG8_WAIT_V(n) asm volatile("s_waitcnt vmcnt(" #n ")" ::: "memory")
#define PG8_WAIT_L(n) asm volatile("s_waitcnt lgkmcnt(" #n ")" ::: "memory")
#define PG8_BAR __builtin_amdgcn_s_barrier()
#define PG8_SCHED __builtin_amdgcn_sched_barrier(0)
    Unit cur, nxt; int ui = 0;
    if (!S.next(0, cur)) return;
    f32x4 acc[2][2][4][2];
#pragma unroll
    for (int a = 0; a < 2; ++a)
#pragma unroll
        for (int b = 0; b < 2; ++b)
#pragma unroll
            for (int m = 0; m < 4; ++m)
#pragma unroll
                for (int n = 0; n < 2; ++n) acc[a][b][m][n] = (f32x4){0.f, 0.f, 0.f, 0.f};
    bf16x8 At[4][2], B0[2][2], B1[2][2];
    const char* cA = (const char*)g.A + (size_t)cur.pm * tstep; const char* cB = (const char*)g.Bt + (size_t)cur.pn * tstep;
    S.a_ready(cur);
    if constexpr (SP2) {
        PG8_STAGE(PG8_SB(0, 0), cB, voffB); PG8_STAGE(PG8_SB(0, 1), cB + hstep, voffB); PG8_STAGE(PG8_SA(0, 0), cA, voffA); PG8_STAGE(PG8_SA(0, 1), cA + hstep, voffA);
        if (wr == 1) PG8_BAR;
        PG8_WAIT_V(2); PG8_BAR;
        PG8_STAGE(PG8_SB(1, 0), cB + kstep, voffB); PG8_STAGE(PG8_SA(1, 0), cA + kstep, voffA); PG8_STAGE(PG8_SB(1, 1), cB + hstep + kstep, voffB);
        PG8_WAIT_V(6); PG8_BAR;
    } else {
        PG8_STAGE(PG8_SB(0, 0), cB, voffB); PG8_STAGE(PG8_SA(0, 0), cA, voffA); PG8_STAGE(PG8_SB(0, 1), cB + hstep, voffB); PG8_STAGE(PG8_SA(0, 1), cA + hstep, voffA);
        if (wr == 1) PG8_BAR;
        PG8_WAIT_V(4); PG8_BAR;
        PG8_STAGE(PG8_SB(1, 0), cB + kstep, voffB); PG8_STAGE(PG8_SA(1, 0), cA + kstep, voffA); PG8_STAGE(PG8_SB(1, 1), cB + hstep + kstep, voffB);
        PG8_WAIT_V(6); PG8_BAR;
    }
    for (;;) {
        const bool has_next = S.next(ui + 1, nxt);
        const char* nA = has_next ? (const char*)g.A + (size_t)nxt.pm * tstep : cA; const char* nB = has_next ? (const char*)g.Bt + (size_t)nxt.pn * tstep : cB;
        for (int t = 0; t < nt; t += 2) {
            const bool last = (t == nt - 2);
            const char* a1 = cA + (size_t)(t + 1) * kstep;
            const char* a2 = last ? nA : cA + (size_t)(t + 2) * kstep; const char* b2 = last ? nB : cB + (size_t)(t + 2) * kstep;
            const char* a3 = a2 + kstep; const char* b3 = b2 + kstep;
            if (last && has_next) S.a_ready(nxt);
            if constexpr (SP2) {
            PG8_LDB(B0, 0, 0); PG8_LDB(B1, 0, 1); PG8_SCHED; PG8_LDA(At, 0, 0); PG8_STAGE(PG8_SA(1, 1), a1 + hstep, voffA);
            PG8_WAIT_V(8); PG8_WAIT_L(0); PG8_BAR; PG8_MMA(0, 0, At, B0); PG8_MMA(0, 1, At, B1); PG8_BAR; PG8_SCHED;
            PG8_LDA(At, 0, 1); PG8_STAGE(PG8_SB(0, 0), b2, voffB); PG8_STAGE(PG8_SB(0, 1), b2 + hstep, voffB); PG8_STAGE(PG8_SA(0, 0), a2, voffA);
            PG8_WAIT_V(8); PG8_WAIT_L(0); PG8_BAR; PG8_MMA(1, 0, At, B0); PG8_MMA(1, 1, At, B1); PG8_BAR; PG8_SCHED;
            PG8_LDB(B0, 1, 0); PG8_LDB(B1, 1, 1); PG8_SCHED; PG8_LDA(At, 1, 0); PG8_STAGE(PG8_SA(0, 1), a2 + hstep, voffA);
            PG8_WAIT_V(8); PG8_WAIT_L(0); PG8_BAR; PG8_MMA(0, 0, At, B0); PG8_MMA(0, 1, At, B1); PG8_BAR; PG8_SCHED;
            PG8_LDA(At, 1, 1); PG8_STAGE(PG8_SB(1, 0), b3, voffB); PG8_STAGE(PG8_SB(1, 1), b3 + hstep, voffB); PG8_STAGE(PG8_SA(1, 0), a3, voffA);
            PG8_WAIT_V(8); PG8_WAIT_L(0); PG8_BAR; PG8_MMA(1, 0, At, B0); PG8_MMA(1, 1, At, B1); PG8_BAR; PG8_SCHED;
            } else {
            PG8_LDB(B0, 0, 0); PG8_SCHED; PG8_LDA(At, 0, 0); PG8_STAGE(PG8_SA(1, 1), a1 + hstep, voffA);
            PG8_WAIT_L(8); PG8_BAR; PG8_WAIT_L(0); PG8_MMA(0, 0, At, B0); PG8_BAR; PG8_SCHED;
            PG8_LDB(B1, 0, 1); PG8_STAGE(PG8_SB(0, 0), b2, voffB);
            PG8_BAR; PG8_WAIT_L(0); PG8_MMA(0, 1, At, B1); PG8_BAR;
            PG8_LDA(At, 0, 1); PG8_STAGE(PG8_SA(0, 0), a2, voffA);
            PG8_BAR; PG8_WAIT_L(0); PG8_MMA(1, 0, At, B0); PG8_BAR; PG8_SCHED;
            PG8_STAGE(PG8_SB(0, 1), b2 + hstep, voffB);
            PG8_WAIT_V(6); PG8_BAR; PG8_MMA(1, 1, At, B1); PG8_BAR;
            PG8_LDB(B0, 1, 0); PG8_SCHED; PG8_LDA(At, 1, 0); PG8_STAGE(PG8_SA(0, 1), a2 + hstep, voffA);
            PG8_WAIT_L(8); PG8_BAR; PG8_WAIT_L(0); PG8_MMA(0, 0, At, B0); PG8_BAR; PG8_SCHED;
            PG8_LDB(B1, 1, 1); PG8_STAGE(PG8_SB(1, 0), b3, voffB);
            PG8_BAR; PG8_WAIT_L(0); PG8_MMA(0, 1, At, B1); PG8_BAR;
            PG8_LDA(At, 1, 1); PG8_STAGE(PG8_SA(1, 0), a3, voffA);
            PG8_BAR; PG8_WAIT_L(0); PG8_MMA(1, 0, At, B0); PG8_BAR; PG8_SCHED;
            PG8_STAGE(PG8_SB(1, 1), b3 + hstep, voffB);
            PG8_WAIT_V(6); PG8_BAR; PG8_MMA(1, 1, At, B1); PG8_BAR;
            }
        }
        if constexpr (ALIGN_EPI) { if (wr == 0) PG8_BAR; }
        if constexpr (!Epi::AFTER_DRAIN) { E(acc, cur, wr, wc, fr, fq); S.done(cur); }
        if (!has_next) break;
#pragma unroll
        for (int a = 0; a < 2; ++a)
#pragma unroll
            for (int b = 0; b < 2; ++b)
#pragma unroll
                for (int m = 0; m < 4; ++m)
#pragma unroll
                    for (int n = 0; n < 2; ++n) acc[a][b][m][n] = (f32x4){0.f, 0.f, 0.f, 0.f};
        cur = nxt; cA = nA; cB = nB; ++ui;
        if constexpr (ALIGN_EPI) { if (wr == 1) PG8_BAR; }
    }
    PG8_WAIT_V(0);
    if constexpr (!ALIGN_EPI) { if (wr == 0) PG8_BAR; }
    PG8_BAR;
    if constexpr (Epi::AFTER_DRAIN) { E.fused(acc, cur, wr, wc, fr, fq, lds, wid, lane); S.done(cur); }
#undef PG8_SA
#undef PG8_SB
#undef PG8_STAGE
#undef PG8_LDA
#undef PG8_LDB
#undef PG8_MMA
#undef PG8_WAIT_V
#undef PG8_WAIT_L
#undef PG8_BAR
#undef PG8_SCHED
}
}
namespace attn_body {
using bf16=__hip_bfloat16;
using bf16x8=__attribute__((ext_vector_type(8)))short;
using s16x4=__attribute__((ext_vector_type(4)))short;
using f32x16=__attribute__((ext_vector_type(16)))float;
using u32x4=__attribute__((ext_vector_type(4)))unsigned;
constexpr int BATCH=4,NHEAD=8,SEQ=4096,D=64,PQ=3072,PO=1024;
typedef float f32x4_t __attribute__((ext_vector_type(4)));
__device__ __forceinline__ int lane_now(){int l;asm volatile("v_mbcnt_lo_u32_b32 %0, -1, 0\n\tv_mbcnt_hi_u32_b32 %0, -1, %0":"=v"(l));return l;}
constexpr int NW=8,QBLK=32,QB=QBLK*NW,KVBLK=64,NQB=SEQ/QB;
constexpr int ATTN_UNIT_ROWS=QB;
__device__ __forceinline__ int crow(int r,int hi){return (r&3)+8*(r>>2)+4*hi;}
#define SBAR() __builtin_amdgcn_sched_barrier(0)
__device__ __forceinline__ void cmask(f32x16&p0,f32x16&p1,int jb,int qrel,int hi){
  const float NEG=-INFINITY; int kb=64*jb+4*hi;
  #pragma unroll
  for(int r=0;r<16;++r){int kv=kb+(r&3)+8*(r>>2); if(kv>qrel)p0[r]=NEG; if(kv+32>qrel)p1[r]=NEG;}
}

constexpr int NSLOT=3, SLOTB=8192;
constexpr int LDS_K=0, LDS_V=NSLOT*SLOTB, LDS_WS=2*NSLOT*SLOTB, LDS_OST=LDS_WS+NW*64*4, LDS_BYTES=LDS_OST+NW*4096;
constexpr float C2=0.125f*1.4426950408889634f;
__device__ __forceinline__ void glds16(const void*gsrc,unsigned lds_dst){unsigned keep;
  asm volatile("s_mov_b32 %0, m0\n\ts_mov_b32 m0, %2\n\ts_nop 0\n\tglobal_load_lds_dwordx4 %1, off\n\ts_mov_b32 m0, %0":"=&s"(keep):"v"(gsrc),"s"(lds_dst):"memory");}
__device__ __forceinline__ float max3f(float a,float b,float c){float r;asm("v_max3_f32 %0, %1, %2, %3":"=v"(r):"v"(a),"v"(b),"v"(c));return r;}
__device__ __forceinline__ float max2f(float a,float b){float r;asm("v_max_f32_e32 %0, %1, %2":"=v"(r):"v"(a),"v"(b));return r;}
__device__ __forceinline__ float fadd_s(float a,float b){float r;asm("v_add_f32_e32 %0, %1, %2":"=v"(r):"v"(a),"v"(b));return r;}
__device__ __forceinline__ float fsub_s(float a,float b){float r;asm("v_sub_f32_e32 %0, %1, %2":"=v"(r):"v"(a),"v"(b));return r;}
typedef float f32x2_t __attribute__((ext_vector_type(2))); typedef __bf16 bf16x2_t __attribute__((ext_vector_type(2)));
__device__ __forceinline__ unsigned cvtpk_s(float lo,float hi){f32x2_t v={lo,hi};bf16x2_t b=__builtin_convertvector(v,bf16x2_t);return __builtin_bit_cast(unsigned,b);}
#define WAIT_BAR(N) asm volatile("s_waitcnt vmcnt(" #N ") lgkmcnt(0)\n\ts_barrier":::"memory")

__device__ __forceinline__ void qkt(f32x16&p0,f32x16&p1,const char*Kslot,const bf16x8*qr,int r32,int hi){ const f32x16 negm=f32x16{};
  const char*kb=Kslot+hi*1024+r32*16;
  #pragma unroll
  for(int d0=0;d0<4;++d0){
    const bf16x8 b0=*reinterpret_cast<const bf16x8*>(kb+d0*2048);
    const bf16x8 b1=*reinterpret_cast<const bf16x8*>(kb+d0*2048+512);
    if(d0==0){p0=__builtin_amdgcn_mfma_f32_32x32x16_bf16(b0,qr[0],negm,0,0,0);p1=__builtin_amdgcn_mfma_f32_32x32x16_bf16(b1,qr[0],negm,0,0,0);}
    else{p0=__builtin_amdgcn_mfma_f32_32x32x16_bf16(b0,qr[d0],p0,0,0,0);p1=__builtin_amdgcn_mfma_f32_32x32x16_bf16(b1,qr[d0],p1,0,0,0);}}
}
typedef __attribute__((address_space(3))) const char* lds_cptr;
typedef short v4i16_t __attribute__((ext_vector_type(4)));
__device__ __forceinline__ void kload8(bf16x8*kf,lds_cptr kp){
  kf[0]=*(const __attribute__((address_space(3))) bf16x8*)(kp);      kf[1]=*(const __attribute__((address_space(3))) bf16x8*)(kp+512);
  kf[2]=*(const __attribute__((address_space(3))) bf16x8*)(kp+2048); kf[3]=*(const __attribute__((address_space(3))) bf16x8*)(kp+2560);
  kf[4]=*(const __attribute__((address_space(3))) bf16x8*)(kp+4096); kf[5]=*(const __attribute__((address_space(3))) bf16x8*)(kp+4608);
  kf[6]=*(const __attribute__((address_space(3))) bf16x8*)(kp+6144); kf[7]=*(const __attribute__((address_space(3))) bf16x8*)(kp+6656);
}
__device__ __forceinline__ void kload2(bf16x8*kf,lds_cptr kp,int j){ kf[2*j]=*(const __attribute__((address_space(3))) bf16x8*)(kp+j*2048); kf[2*j+1]=*(const __attribute__((address_space(3))) bf16x8*)(kp+j*2048+512); }
__device__ __forceinline__ s16x4 vtr(lds_cptr p){ return __builtin_bit_cast(s16x4,__builtin_amdgcn_ds_read_tr16_b64_v4i16((__attribute__((address_space(3))) v4i16_t*)p)); }
__device__ __forceinline__ float rowmax(const f32x16&p0,const f32x16&p1){
  float a=max3f(p0[0],p0[1],p1[0]),b=max3f(p0[2],p0[3],p1[1]);a=max3f(a,p1[2],p1[3]);
  #pragma unroll
  for(int r=4;r<16;r+=4){a=max3f(a,p0[r],p0[r+1]);b=max3f(b,p0[r+2],p0[r+3]);a=max3f(a,p1[r],p1[r+1]);b=max3f(b,p1[r+2],p1[r+3]);}
  const float m=max2f(a,b);
  auto rr=__builtin_amdgcn_permlane32_swap(__float_as_uint(m),__float_as_uint(m),false,false);
  return max2f(__uint_as_float(rr[0]),__uint_as_float(rr[1]));
}
__device__ __forceinline__ void pv(f32x16*o,int vb,bf16x8 pa0,bf16x8 pa1,bf16x8 pa2,bf16x8 pa3){
  #pragma unroll
  for(int d0=0;d0<2;++d0){s16x4 lo[4],hi[4];
    #pragma unroll
    for(int ks=0;ks<4;++ks){
      asm volatile("ds_read_b64_tr_b16 %0,%1 offset:%c2":"=&v"(lo[ks]):"v"(vb),"i"(d0*4096+ks*1024):"memory");
      asm volatile("ds_read_b64_tr_b16 %0,%1 offset:%c2":"=&v"(hi[ks]):"v"(vb),"i"(d0*4096+ks*1024+512):"memory");}
    asm volatile("s_waitcnt lgkmcnt(0)":::"memory");SBAR();
    #define PK(k) (bf16x8){lo[k][0],lo[k][1],lo[k][2],lo[k][3],hi[k][0],hi[k][1],hi[k][2],hi[k][3]}
    o[d0]=__builtin_amdgcn_mfma_f32_32x32x16_bf16(pa0,PK(0),o[d0],0,0,0);
    o[d0]=__builtin_amdgcn_mfma_f32_32x32x16_bf16(pa1,PK(1),o[d0],0,0,0);
    o[d0]=__builtin_amdgcn_mfma_f32_32x32x16_bf16(pa2,PK(2),o[d0],0,0,0);
    o[d0]=__builtin_amdgcn_mfma_f32_32x32x16_bf16(pa3,PK(3),o[d0],0,0,0);
    #undef PK
  }
}

#ifndef ATTN_STORE16
#define ATTN_STORE16(p,v) (*(u32x4*)(p)=(v))
#endif
template<int THRL> __device__ __forceinline__ void attn_unit(int b,int h,int qb,const bf16*Q,const bf16*__restrict__ K,const bf16*__restrict__ V,bf16*O,char*shm,const char*cs,int t0){
  const int tid=pg8::tid_now(),lane=tid&63,r32=lane&31,hi=lane>>5; const int wid=__builtin_amdgcn_readfirstlane(tid>>6);
  const long rowbase=(long)b*SEQ; const int q0=qb*QB;
  const bf16*Qw=Q+(rowbase+q0+wid*QBLK)*PQ+h*D;
  const bf16*Kh=K+(rowbase+(long)t0*KVBLK)*PQ+h*D,*Vh=V+(rowbase+(long)t0*KVBLK)*PQ+h*D;
  const unsigned lds0=(unsigned)(uintptr_t)shm;
  float*wsf=(float*)(shm+LDS_WS)+wid*64;
  const bf16*ksrc=Kh+(long)lane*PQ+wid*8;
  const bf16*vsrc=Vh+(long)(16*(wid&3)+(lane>>2))*PQ+(wid>>2)*32+(lane&3)*8;
  const unsigned kdst=lds0+LDS_K+wid*1024, vdst=lds0+LDS_V+wid*1024;
  #define DMA_K(t,slot) glds16(ksrc+(long)(t)*KVBLK*PQ,(unsigned)__builtin_amdgcn_readfirstlane(kdst+(slot)))
  #define DMA_V(t,slot) glds16(vsrc+(long)(t)*KVBLK*PQ,(unsigned)__builtin_amdgcn_readfirstlane(vdst+(slot)))
  const int vb0=(int)(lds0+LDS_V)+((lane>>4)&1)*32+(lane&3)*8+(4*hi+((lane&15)>>2))*64;
  const char*Kbase=shm+LDS_K; bf16x8 kf[8];
  const lds_cptr shm3=(lds_cptr)shm; const lds_cptr kp0=shm3+LDS_K+hi*1024+r32*16; const lds_cptr vp0=shm3+LDS_V+((lane>>4)&1)*32+(lane&3)*8+(4*hi+((lane&15)>>2))*64;
  const int NT=(q0+QB)/KVBLK-t0;
  DMA_K(0,0);DMA_V(0,0);DMA_K(1,SLOTB);
  bf16x8 qr[4];
  #pragma unroll
  for(int d0=0;d0<4;++d0)qr[d0]=*reinterpret_cast<const bf16x8*>(&Qw[(long)r32*PQ+d0*16+hi*8]);
  float mhat=0.f,l_reg=0.f;f32x16 o[2];o[0]=f32x16{};o[1]=f32x16{};const f32x16 zero16=f32x16{};
  const int qrel=wid*QBLK+r32;
  #define CMASK(P0,P1,t) do{int jb_=(t)-(NT-4); if(jb_>=0)cmask(P0,P1,jb_,qrel,hi);}while(0)
  const lds_cptr csb=(lds_cptr)cs+hi*16+t0*256;
  #define BIAS(P0,P1,t) do{ const __attribute__((address_space(3))) f32x4_t* cb_=(const __attribute__((address_space(3))) f32x4_t*)(csb+(t)*256); const float nm_=-mhat; \
    _Pragma("unroll") for(int g_=0;g_<4;++g_){ const f32x4_t v0_=cb_[2*g_]+nm_; \
      P0[4*g_]+=v0_[0];P0[4*g_+1]+=v0_[1];P0[4*g_+2]+=v0_[2];P0[4*g_+3]+=v0_[3]; if(g_&1)SBAR(); } \
    _Pragma("unroll") for(int g_=0;g_<4;++g_){ const f32x4_t v1_=cb_[8+2*g_]+nm_; \
      P1[4*g_]+=v1_[0];P1[4*g_+1]+=v1_[1];P1[4*g_+2]+=v1_[2];P1[4*g_+3]+=v1_[3]; if(g_&1)SBAR(); } }while(0)
  bool resc=false;
  #define START(P0,P1) do{ const float rm=rowmax(P0,P1); resc=false; \
    { const float dl=rm; mhat=fadd_s(mhat,dl); \
      _Pragma("unroll") for(int r=0;r<16;++r){P0[r]=fsub_s(P0[r],dl);P1[r]=fsub_s(P1[r],dl);} \
    } \
    _Pragma("unroll") for(int r=0;r<16;++r)P0[r]=__builtin_amdgcn_exp2f(P0[r]); }while(0)
  #define RESC() do{ if(resc){ asm volatile("s_waitcnt lgkmcnt(0)":::"memory"); \
      _Pragma("unroll") for(int d_=0;d_<2;++d_) _Pragma("unroll") for(int r=0;r<16;++r)o[d_][r]*=wsf[crow(r,hi)]; } }while(0)
  f32x16 pA0,pA1,pB0,pB1;
  int sl_prev=0,sl_cur=0,sl_next=SLOTB;
  #define ROT() do{sl_prev=sl_cur;sl_cur=sl_next;sl_next=(sl_next==(NSLOT-1)*SLOTB)?0:sl_next+SLOTB;}while(0)
  DMA_K(2,2*SLOTB);
  WAIT_BAR(3);
  qkt(pA0,pA1,Kbase,qr,r32,hi);asm volatile("s_nop 15\n\ts_nop 7":"+v"(pA0),"+v"(pA1));BIAS(pA0,pA1,0);CMASK(pA0,pA1,0);
  START(pA0,pA1);
  _Pragma("unroll") for(int r=0;r<16;++r)pA1[r]=__builtin_amdgcn_exp2f(pA1[r]);
  WAIT_BAR(0);
  DMA_K(3,0);DMA_V(1,SLOTB);
  ROT();
  kload8(kf,kp0+sl_cur);
  WAIT_BAR(2);
  s16x4 vlo[8],vhi[8]; u32x4 pw0,pw1,pw2,pw3;
  #define PKW(P,B) cvtpk_s(P[B],P[B+1])
  #define PAF(k) __builtin_bit_cast(bf16x8,pw##k)
  #define VFR(i) (bf16x8){vlo[i][0],vlo[i][1],vlo[i][2],vlo[i][3],vhi[i][0],vhi[i][1],vhi[i][2],vhi[i][3]}
  #define PIN(x) asm volatile("":"+v"(x))
  #define MX3(a,b,c) __builtin_fmaxf(__builtin_fmaxf((a),(b)),(c))
  #define GAPA(MF,A0,A1,A2,A3,W0,W1,PW) do{ MF; sacc+=A0; sacc+=A1; sacc+=A2; sacc+=A3; PIN(sacc); W0; W1; PIN(PW); SBAR(); }while(0)
  #define EX(v) __builtin_amdgcn_exp2f(v)
  #define GAPB(MF,X,B) do{ MF; X[B]=EX(X[B]); X[B+1]=EX(X[B+1]); X[B+2]=EX(X[B+2]); X[B+3]=EX(X[B+3]); PIN(X); SBAR(); }while(0)
  #define VRD(i) do{ vlo[i]=vtr(vp_+(((i)>>2)*4096+((i)&3)*1024)); vhi[i]=vtr(vp_+(((i)>>2)*4096+((i)&3)*1024+512)); }while(0)
  #define KRD(G,j) do{ if(G){ kload2(kf,kp0+sl_next,j); SBAR(); } }while(0)
  #define STEP(C0,C1,P0,P1,t,GK,GV,GL) do{ SBAR(); \
    const lds_cptr vp_=vp0+sl_prev; \
    VRD(0); SBAR(); float sacc=(P0[0]+P0[1]); \
    GAPA(C0=__builtin_amdgcn_mfma_f32_32x32x16_bf16(kf[0],qr[0],zero16,0,0,0), P0[2],P0[3],P0[4],P0[5],     pw0[0]=PKW(P0,0), pw0[1]=PKW(P0,2), pw0); \
    VRD(4); SBAR(); GAPA(C1=__builtin_amdgcn_mfma_f32_32x32x16_bf16(kf[1],qr[0],zero16,0,0,0), P0[6],P0[7],P0[8],P0[9],     pw0[2]=PKW(P0,4), pw0[3]=PKW(P0,6), pw0); \
    VRD(1); SBAR(); GAPA(C0=__builtin_amdgcn_mfma_f32_32x32x16_bf16(kf[2],qr[1],C0,0,0,0),   P0[10],P0[11],P0[12],P0[13], pw1[0]=PKW(P0,8), pw1[1]=PKW(P0,10), pw1); \
    VRD(5); SBAR(); GAPA(C1=__builtin_amdgcn_mfma_f32_32x32x16_bf16(kf[3],qr[1],C1,0,0,0),   P0[14],P0[15],P1[0],P1[1],   pw1[2]=PKW(P0,12),pw1[3]=PKW(P0,14), pw1); \
    VRD(2); SBAR(); GAPA(C0=__builtin_amdgcn_mfma_f32_32x32x16_bf16(kf[4],qr[2],C0,0,0,0),   P1[2],P1[3],P1[4],P1[5],     pw2[0]=PKW(P1,0), pw2[1]=PKW(P1,2), pw2); \
    VRD(6); SBAR(); GAPA(C1=__builtin_amdgcn_mfma_f32_32x32x16_bf16(kf[5],qr[2],C1,0,0,0),   P1[6],P1[7],P1[8],P1[9],     pw2[2]=PKW(P1,4), pw2[3]=PKW(P1,6), pw2); \
    VRD(3); SBAR(); GAPA(C0=__builtin_amdgcn_mfma_f32_32x32x16_bf16(kf[6],qr[3],C0,0,0,0),   P1[10],P1[11],P1[12],P1[13], pw3[0]=PKW(P1,8), pw3[1]=PKW(P1,10), pw3); \
    VRD(7); SBAR(); GAPA(C1=__builtin_amdgcn_mfma_f32_32x32x16_bf16(kf[7],qr[3],C1,0,0,0),   P1[14],P1[15],0.f,0.f,       pw3[2]=PKW(P1,12),pw3[3]=PKW(P1,14), pw3); \
    l_reg+=sacc; \
    if(GK){DMA_K((t)+3,sl_cur);} if(GV){DMA_V((t)+1,sl_next);} \
    BIAS(C0,C1,t); CMASK(C0,C1,t); \
    { float a=MX3(C0[0],C0[1],C1[0]),b=MX3(C0[2],C0[3],C1[1]); a=MX3(a,C1[2],C1[3]); \
      _Pragma("unroll") for(int r=4;r<16;r+=4){a=MX3(a,C0[r],C0[r+1]);b=MX3(b,C0[r+2],C0[r+3]);a=MX3(a,C1[r],C1[r+1]);b=MX3(b,C1[r+2],C1[r+3]);} \
      float rm=__builtin_fmaxf(a,b); { auto rr=__builtin_amdgcn_permlane32_swap(__float_as_uint(rm),__float_as_uint(rm),false,false); rm=__builtin_fmaxf(__uint_as_float(rr[0]),__uint_as_float(rr[1])); } \
      resc=false; \
      if(__builtin_expect(__any(rm>(float)THRL),0)){ const float dl=__builtin_fmaxf(rm,0.f); mhat+=dl; \
        _Pragma("unroll") for(int r=0;r<16;++r){C0[r]-=dl;C1[r]-=dl;} \
        const float f=__builtin_amdgcn_exp2f(-dl); l_reg*=f; if(hi==0)wsf[r32]=f; resc=true; } } \
    SBAR(); \
    GAPB(o[0]=__builtin_amdgcn_mfma_f32_32x32x16_bf16(PAF(0),VFR(0),o[0],0,0,0), C0,0); \
    GAPB(o[1]=__builtin_amdgcn_mfma_f32_32x32x16_bf16(PAF(0),VFR(4),o[1],0,0,0), C0,4); \
    KRD(GL,0); GAPB(o[0]=__builtin_amdgcn_mfma_f32_32x32x16_bf16(PAF(1),VFR(1),o[0],0,0,0), C0,8); \
    KRD(GL,1); GAPB(o[1]=__builtin_amdgcn_mfma_f32_32x32x16_bf16(PAF(1),VFR(5),o[1],0,0,0), C0,12); \
    KRD(GL,2); GAPB(o[0]=__builtin_amdgcn_mfma_f32_32x32x16_bf16(PAF(2),VFR(2),o[0],0,0,0), C1,0); \
    KRD(GL,3); GAPB(o[1]=__builtin_amdgcn_mfma_f32_32x32x16_bf16(PAF(2),VFR(6),o[1],0,0,0), C1,4); \
    GAPB(o[0]=__builtin_amdgcn_mfma_f32_32x32x16_bf16(PAF(3),VFR(3),o[0],0,0,0), C1,8); \
    GAPB(o[1]=__builtin_amdgcn_mfma_f32_32x32x16_bf16(PAF(3),VFR(7),o[1],0,0,0), C1,12); \
    }while(0)
  int t=1;
  #undef CMASK
  #define CMASK(P0,P1,t) do{}while(0)
  for(;t+5<NT;t+=2){
    STEP(pB0,pB1,pA0,pA1,t,true,true,true);     WAIT_BAR(2); RESC(); ROT();
    STEP(pA0,pA1,pB0,pB1,t+1,true,true,true);   WAIT_BAR(2); RESC(); ROT();
  }
  #undef CMASK
  #define CMASK(P0,P1,t) do{int jb_=(t)-(NT-4); if(jb_>=0)cmask(P0,P1,jb_,qrel,hi);}while(0)
  #define ENDW(tt) do{ if((tt)+3<NT){WAIT_BAR(2);} else if((tt)+2<NT){WAIT_BAR(1);} else {WAIT_BAR(0);} }while(0)
  for(;t+1<NT;t+=2){
    STEP(pB0,pB1,pA0,pA1,t,(t+3<NT),(t+1<NT),(t+1<NT));       ENDW(t);   RESC(); ROT();
    STEP(pA0,pA1,pB0,pB1,t+1,(t+4<NT),(t+2<NT),(t+2<NT));     ENDW(t+1); RESC(); ROT();
  }
  STEP(pB0,pB1,pA0,pA1,NT-1,false,false,false); RESC();
  { float sacc=pB0[0]+pB0[1]; _Pragma("unroll") for(int r=2;r<16;++r)sacc+=pB0[r]; _Pragma("unroll") for(int r=0;r<16;++r)sacc+=pB1[r]; l_reg+=sacc;
    pw0=(u32x4){PKW(pB0,0),PKW(pB0,2),PKW(pB0,4),PKW(pB0,6)};pw1=(u32x4){PKW(pB0,8),PKW(pB0,10),PKW(pB0,12),PKW(pB0,14)};pw2=(u32x4){PKW(pB1,0),PKW(pB1,2),PKW(pB1,4),PKW(pB1,6)};pw3=(u32x4){PKW(pB1,8),PKW(pB1,10),PKW(pB1,12),PKW(pB1,14)};
    SBAR(); pv(o,vb0+sl_cur,PAF(0),PAF(1),PAF(2),PAF(3)); }
  #undef PKW
  #undef PAF
  #undef VFR
  #undef PIN
  #undef MX3
  #undef GAPA
  #undef GAPB
  #undef EX
  #undef VRD
  #undef KRD
  #undef STEP
  #undef ENDW
  {auto rr=__builtin_amdgcn_permlane32_swap(__float_as_uint(l_reg),__float_as_uint(l_reg),false,false);l_reg=__uint_as_float(rr[0])+__uint_as_float(rr[1]);}
  if(hi==0)wsf[32+r32]=l_reg;asm volatile("s_waitcnt lgkmcnt(0)":::"memory");
  float rli[16];
  #pragma unroll
  for(int r=0;r<16;++r)rli[r]=__builtin_amdgcn_rcpf(wsf[32+crow(r,hi)]);
  bf16*Ow=O+(rowbase+q0+wid*QBLK)*PO+h*D;
  { bf16*stg=(bf16*)(shm+LDS_OST)+wid*2048;
    #pragma unroll
    for(int r=0;r<16;++r){const int orow=crow(r,hi);
      #pragma unroll
      for(int d0=0;d0<2;++d0)stg[orow*64+d0*32+r32]=__float2bfloat16(o[d0][r]*rli[r]);}
    asm volatile("s_waitcnt lgkmcnt(0)":::"memory");
    const int le_=lane_now();
    #pragma unroll
    for(int i=0;i<4;++i){const int row=i*8+(le_>>3),ch=le_&7; const u32x4 v=*(const u32x4*)(stg+row*64+ch*8); ATTN_STORE16(Ow+(long)row*PO+ch*8,v);} }
  asm volatile("s_waitcnt lgkmcnt(0)\n\ts_barrier":::"memory");
  #undef BIAS
  #undef DMA_K
  #undef DMA_V
  #undef CMASK
  #undef START
  #undef RESC
  #undef ROT
}
constexpr int ATTN_LDS_BYTES=LDS_BYTES;
#undef SBAR
#undef WAIT_BAR
}

#ifndef MK_ONE_LAUNCH
#define MK_ONE_LAUNCH 1
#endif
constexpr int NWAVES = 8, NTHR = NWAVES * 64;
constexpr int Bsz = 4, S = 4096, T = Bsz * S, DM = 1024, NL = 2;
constexpr int NCH = S / 64;
constexpr int C_XA = 0, C_GA = 256, C_Q = 512, C_K = 1024, C_V = 1536, C_FL = 2048, C_P = 2056;
constexpr int C_R = C_P, C_RK = C_P + 256, C_RV = C_P + 512, C_WD = C_P + 768, C_AD = C_P + 800, C_GD = C_P + 832, DIN = C_P + 896, NP = 3072, RCOLS = 896;
constexpr int NE = 16, DE = 256, MAXTILES = 144;
constexpr float L2E = 1.4426950408889634f;
constexpr int NPH = 10;
enum { PH_PRE = 0, PH_GIN, PH_PREP, PH_MIX, PH_POST, PH_GOUT, PH_ROUTE, PH_PLACE, PH_MOE1, PH_MOE2 };
constexpr int PH_FIN = NL * NPH, N_PHASES = PH_FIN + 1;
enum { I_X = 0, I_N1G, I_WIN, I_CONVW, I_CONVB, I_WA, I_BA, I_WX, I_BX, I_LAM, I_LNG, I_FB, I_QNG, I_KNG, I_FNG, I_MU, I_W0, I_W2, I_A0, I_A2, I_G2, I_KK, I_KA, I_RK, I_RLG, I_RLB,
       I_WOUT, I_N2G, I_RGW, I_RGB, I_REW, I_REB, I_EG, I_EU, I_ED, N_IN };

constexpr size_t MiB = 1u << 20;
constexpr size_t WS_CTL = 0, CTL_ZERO_BYTES = 1 * MiB;
constexpr size_t WS_WIN = 2 * MiB, WS_WOUT = 8 * MiB, WS_WGU = 10 * MiB, WS_WD = 26 * MiB;
constexpr size_t WS_H = 34 * MiB;
constexpr size_t WS_PROJ = 66 * MiB;
constexpr size_t WS_Y = 162 * MiB;
constexpr size_t WS_HLOC = 194 * MiB, WS_CUMA = 202 * MiB;
constexpr size_t WS_ORAW = 210 * MiB;
constexpr size_t WS_G = 226 * MiB, WS_VS = 234 * MiB;
constexpr size_t WS_CLOC = 242 * MiB, WS_BON = WS_CLOC + 512 * 1024, WS_AAGG = WS_BON + 256 * 1024, WS_HAGG = WS_AAGG + 256 * 1024, WS_CTOT = WS_HAGG + 256 * 1024;
constexpr size_t WS_TOKE = 244 * MiB, WS_TOKW = WS_TOKE + 128 * 1024, WS_TSLOT = WS_TOKW + 128 * 1024;
constexpr size_t WS_ASORT = 66 * MiB, WS_HID = 138 * MiB, WS_STOK = 156 * MiB, WS_SW = 157 * MiB;
constexpr size_t WS_YE = WS_ASORT;
constexpr size_t WS_END = 256 * MiB;
static_assert(WS_ASORT + (size_t)MAXTILES * 256 * 1024 * 2 <= WS_HID && WS_HID + (size_t)MAXTILES * 256 * 256 * 2 <= WS_STOK && WS_SW + MAXTILES * 256 * 4 <= WS_Y, "MoE overlay");
static_assert(WS_PROJ + (size_t)T * NP * 2 <= WS_Y && WS_CTOT + 4 * 64 * 8 * 4 <= WS_TOKE && WS_TSLOT + 128 * 1024 <= WS_END, "d_ws map");

constexpr int CW_TMO = 0;
constexpr int CW_BAR = 4096;
constexpr int CW_CNT0 = 8192, CW_CUR0 = 8192 + 64, CW_Q0 = 8192 + 128, CW_LSTRIDE = 256;

constexpr int LDS_BYTES = 156 * 1024;
constexpr int MISC_OFF = LDS_BYTES - 256;
constexpr int LDS_TAB = 131072;

#define GAS __attribute__((address_space(1)))
#define LAS __attribute__((address_space(3)))
typedef unsigned short bf16;
typedef unsigned v4u __attribute__((ext_vector_type(4)));
typedef unsigned v2u __attribute__((ext_vector_type(2)));
typedef float f32x4 __attribute__((ext_vector_type(4)));
typedef GAS unsigned gu32;
#define RLX_AGENT __ATOMIC_RELAXED, __HIP_MEMORY_SCOPE_AGENT
typedef float f32x2_ __attribute__((ext_vector_type(2))); typedef __bf16 bf16x2_ __attribute__((ext_vector_type(2)));
__device__ __forceinline__ unsigned pk2(float lo, float hi) { f32x2_ v = {lo, hi}; bf16x2_ b = __builtin_convertvector(v, bf16x2_); return __builtin_bit_cast(unsigned, b); }
__device__ __forceinline__ unsigned f2bf(float f) { return pk2(f, 0.f) & 0xffffu; }
__device__ __forceinline__ float bf2f(bf16 v) { return __builtin_bit_cast(float, (unsigned)v << 16); }
__device__ __forceinline__ float bflo(unsigned w) { return __builtin_bit_cast(float, w << 16); }
__device__ __forceinline__ float bfhi(unsigned w) { return __builtin_bit_cast(float, w & 0xffff0000u); }
__device__ __forceinline__ float sigmoidf_(float x) { return 1.f / (1.f + __expf(-x)); }
__device__ __forceinline__ float softplusf_(float x) { return fmaxf(x, 0.f) + log1pf(__expf(-fabsf(x))); }
__device__ __forceinline__ float wave_sum(float v) {
#pragma unroll
    for (int o = 1; o < 64; o <<= 1) v += __shfl_xor(v, o);
    return v;
}
#define XB_TMO      128
#define XB_XCNT(j)  (256  + 64 * (j))
#define XB_XSUB(j)  (1280 + 64 * (j))
#define XB_XGEN(j)  (2304 + 64 * (j))
#define XB_TOP      3328
#define XB_TOPGEN   3392
#define XCD_BAR_WORDS 3456
#define XB_SPIN_CAP (1u << 21)

__device__ __forceinline__ unsigned xb_ld(unsigned* p)              { return __hip_atomic_load(p, __ATOMIC_RELAXED, __HIP_MEMORY_SCOPE_AGENT); }
__device__ __forceinline__ unsigned xb_add(unsigned* p, unsigned v) { return __hip_atomic_fetch_add(p, v, __ATOMIC_RELAXED, __HIP_MEMORY_SCOPE_AGENT); }
__device__ __forceinline__ unsigned xb_xcc_id() { return (unsigned)__builtin_amdgcn_s_getreg((3 << 11) | 20) & 0xFu; }
#define XB_SPIN(cond, bar) do { unsigned _sp = 0; while (cond) { __builtin_amdgcn_s_sleep(1); \
    if ((++_sp & 255u) == 0u) { if (xb_ld(&(bar)[XB_TMO])) break; if (_sp > XB_SPIN_CAP) { atomicAdd(&(bar)[XB_TMO], 1u); break; } } } } while (0)

struct XcdBarrier {
    unsigned* bar; unsigned x;
    volatile LAS unsigned* st;
};

__device__ __forceinline__ XcdBarrier xcd_barrier_post(unsigned* bar, volatile LAS unsigned* st) {
    XcdBarrier b; b.bar = bar; b.x = xb_xcc_id(); b.st = st;
    if (threadIdx.x == 0) (void)xb_add(&bar[XB_XCNT(b.x)], 1u);
    return b;
}
__device__ __forceinline__ void xcd_barrier_complete(unsigned* bar, unsigned x, unsigned& nloc, unsigned& nx) {
    const unsigned G = gridDim.x * gridDim.y * gridDim.z;
    unsigned sum, cnt, mine, sp = 0u;
    for (;;) {
        sum = 0u; cnt = 0u; mine = 0u;
#pragma unroll
        for (unsigned j = 0; j < 16; ++j) { const unsigned c = xb_ld(&bar[XB_XCNT(j)]); sum += c; cnt += (c > 0u) ? 1u : 0u; mine = (j == x) ? c : mine; }
        if (sum == G) break;
        __builtin_amdgcn_s_sleep(1);
        if ((++sp & 255u) == 0u) { if (xb_ld(&bar[XB_TMO])) break; if (sp > XB_SPIN_CAP) { atomicAdd(&bar[XB_TMO], 1u); break; } }
    }
    nloc = mine > 0u ? mine : 1u; nx = cnt > 0u ? cnt : 1u;
}

__device__ __forceinline__ void xcd_barrier(const XcdBarrier& b) {
    asm volatile("s_waitcnt vmcnt(0)" ::: "memory");
    __syncthreads();
    if (threadIdx.x == 0) {
        unsigned* bar = b.bar;
        __builtin_amdgcn_s_waitcnt(0);
        unsigned nloc = b.st[0], nx = b.st[1];
        if (nloc == 0u) { xcd_barrier_complete(bar, b.x, nloc, nx); b.st[0] = nloc; b.st[1] = nx; }
        const unsigned old = xb_add(&bar[XB_XSUB(b.x)], 1u);
        const unsigned gen = old / nloc;
        if (old + 1u == (gen + 1u) * nloc) {
            __builtin_amdgcn_fence(__ATOMIC_RELEASE, "agent");
            asm volatile("s_waitcnt vmcnt(0)" ::: "memory");
            const unsigned og = xb_add(&bar[XB_TOP], 1u);
            const unsigned tg = og / nx;
            if (og + 1u == (tg + 1u) * nx) xb_add(&bar[XB_TOPGEN], 1u);
            else XB_SPIN(xb_ld(&bar[XB_TOPGEN]) == tg, bar);
            __builtin_amdgcn_fence(__ATOMIC_ACQUIRE, "agent");
            xb_add(&bar[XB_XGEN(b.x)], 1u);
            asm volatile("s_waitcnt vmcnt(0)" ::: "memory");
        } else {
            XB_SPIN(xb_ld(&bar[XB_XGEN(b.x)]) == gen, bar);
            __builtin_amdgcn_fence(__ATOMIC_ACQUIRE, "agent");
            asm volatile("s_waitcnt vmcnt(0)" ::: "memory");
        }
    }
    __syncthreads();
}

struct Args { const float* in[N_IN]; float* out; unsigned char* ws; int ph_lo, ph_hi; };
typedef const __attribute__((address_space(4))) Args* CA;
__device__ __forceinline__ CA args_now() { CA p = (CA)__builtin_amdgcn_kernarg_segment_ptr(); asm volatile("" : "+s"(p)); return p; }

__device__ __forceinline__ void tr_item(const float* W, int K, int N, const float* gk, bf16* WT, int row_off, int row_stride, float* scr, int item, int nblk, int lane) {
    const int kb = item / nblk, nb = item % nblk, k0 = 64 * kb, n0 = 32 * nb;
    const int nn = n0 + (lane & 31);
#pragma unroll 8
    for (int i = 0; i < 32; ++i) { const int kk = 2 * i + (lane >> 5); float v = (nn < N) ? W[(size_t)(k0 + kk) * N + nn] : 0.f; if (gk) v *= gk[k0 + kk]; scr[kk * 33 + (lane & 31)] = v; }
    asm volatile("s_waitcnt lgkmcnt(0)" ::: "memory");
    const int c = lane & 7;
#pragma unroll
    for (int j = 0; j < 4; ++j) { const int n = (lane >> 3) + 8 * j; const float* s = scr + (8 * c) * 33 + n;
        v4u o; o.x = pk2(s[0 * 33], s[1 * 33]); o.y = pk2(s[2 * 33], s[3 * 33]); o.z = pk2(s[4 * 33], s[5 * 33]); o.w = pk2(s[6 * 33], s[7 * 33]);
        *(v4u*)(WT + (size_t)(row_off + row_stride * (n0 + n)) * K + k0 + 8 * c) = o; }
    asm volatile("s_waitcnt lgkmcnt(0)" ::: "memory");
}
__device__ __forceinline__ void rms_row_to_bf16(const float* xrow, bf16* orow, int lane) {
    const f32x4* xr = (const f32x4*)xrow + lane;
    f32x4 v[4]; float s = 0.f;
#pragma unroll
    for (int j = 0; j < 4; ++j) { v[j] = xr[64 * j]; s += (v[j].x * v[j].x + v[j].y * v[j].y) + (v[j].z * v[j].z + v[j].w * v[j].w); }
    const float rstd = rsqrtf(wave_sum(s) * (1.f / DM) + 1e-6f);
    v2u* o8 = (v2u*)orow + lane;
#pragma unroll
    for (int j = 0; j < 4; ++j) { v2u o; o.x = pk2(v[j].x * rstd, v[j].y * rstd); o.y = pk2(v[j].z * rstd, v[j].w * rstd); o8[64 * j] = o; }
}
__device__ __forceinline__ void combine_row(float* xrow, const bf16* y0, const bf16* y1, bf16* orow, int lane) {
    f32x4* xr = (f32x4*)xrow + lane; const v2u* p0 = (const v2u*)y0 + lane; const v2u* p1 = (const v2u*)y1 + lane;
    f32x4 v[4]; float s = 0.f;
#pragma unroll
    for (int j = 0; j < 4; ++j) { v[j] = xr[64 * j]; const v2u q0 = p0[64 * j], q1 = p1[64 * j];
        v[j].x += bflo(q0.x) + bflo(q1.x); v[j].y += bfhi(q0.x) + bfhi(q1.x); v[j].z += bflo(q0.y) + bflo(q1.y); v[j].w += bfhi(q0.y) + bfhi(q1.y);
        xr[64 * j] = v[j]; s += (v[j].x * v[j].x + v[j].y * v[j].y) + (v[j].z * v[j].z + v[j].w * v[j].w); }
    if (orow) { const float rstd = rsqrtf(wave_sum(s) * (1.f / DM) + 1e-6f); v2u* o8 = (v2u*)orow + lane;
#pragma unroll
        for (int j = 0; j < 4; ++j) { v2u o; o.x = pk2(v[j].x * rstd, v[j].y * rstd); o.y = pk2(v[j].z * rstd, v[j].w * rstd); o8[64 * j] = o; } }
}
__device__ __forceinline__ void phase_pre(CA a, int l, unsigned char* lds, int tid) {
    const int lane = tid & 63, wave = tid >> 6;
    float* scr = (float*)lds + wave * (64 * 33);
    const int gw = blockIdx.x * NWAVES + wave, NGW = gridDim.x * NWAVES;
    bf16* WinT = (bf16*)(a->ws + WS_WIN); bf16* WoutT = (bf16*)(a->ws + WS_WOUT); bf16* WguT = (bf16*)(a->ws + WS_WGU); bf16* WdT = (bf16*)(a->ws + WS_WD);
    constexpr int I_IN = 16 * 96, I_OUT = 16 * 32, I_E = 16 * 128;
    constexpr int NITEMS = I_IN + I_OUT + 3 * I_E;
    for (int it = gw; it < NITEMS; it += NGW) {
        int r = it;
        if (r < I_IN) { tr_item(a->in[I_WIN] + (size_t)l * DM * DIN, DM, DIN, a->in[I_N1G] + l * DM, WinT, 0, 1, scr, r, 96, lane); continue; } r -= I_IN;
        if (r < I_OUT) { tr_item(a->in[I_WOUT] + (size_t)l * DM * DM, DM, DM, nullptr, WoutT, 0, 1, scr, r, 32, lane); continue; } r -= I_OUT;
        if (r < I_E) { const int e = r >> 7, rr = r & 127; tr_item(a->in[I_EG] + (size_t)(l * NE + e) * DM * DE, DM, DE, a->in[I_N2G] + l * DM, WguT + (size_t)e * 512 * DM, 0, 2, scr, rr, 8, lane); continue; } r -= I_E;
        if (r < I_E) { const int e = r >> 7, rr = r & 127; tr_item(a->in[I_EU] + (size_t)(l * NE + e) * DM * DE, DM, DE, a->in[I_N2G] + l * DM, WguT + (size_t)e * 512 * DM, 1, 2, scr, rr, 8, lane); continue; } r -= I_E;
        { const int e = r >> 7, rr = r & 127; tr_item(a->in[I_ED] + (size_t)(l * NE + e) * DE * DM, DE, DM, nullptr, WdT + (size_t)e * DM * DE, 0, 1, scr, rr, 32, lane); }
    }
    bf16* H = (bf16*)(a->ws + WS_H);
    if (l == 0) { for (int m = gw; m < T; m += NGW) rms_row_to_bf16(a->in[I_X] + (size_t)m * DM, H + (size_t)m * DM, lane); }
    else { const int* TS = (const int*)(a->ws + WS_TSLOT); const bf16* YE = (const bf16*)(a->ws + WS_YE);
        for (int m = gw; m < T; m += NGW) combine_row(a->out + (size_t)m * DM, YE + (size_t)TS[2 * m] * DM, YE + (size_t)TS[2 * m + 1] * DM, H + (size_t)m * DM, lane); }
}
__device__ __forceinline__ void phase_fin(CA a, int tid) {
    const int lane = tid & 63, wave = tid >> 6; const int gw = blockIdx.x * NWAVES + wave, NGW = gridDim.x * NWAVES;
    const int* TS = (const int*)(a->ws + WS_TSLOT); const bf16* YE = (const bf16*)(a->ws + WS_YE);
    for (int m = gw; m < T; m += NGW) combine_row(a->out + (size_t)m * DM, YE + (size_t)TS[2 * m] * DM, YE + (size_t)TS[2 * m + 1] * DM, nullptr, lane);
}

__device__ __forceinline__ void prep_unit(CA a, int l, int u, unsigned char* lds, int tid, bool fox = true) {
    const int b = u / NCH, c = u % NCH, t0 = c * 64; const size_t row0 = (size_t)b * S + t0;
    bf16* P = (bf16*)(a->ws + WS_PROJ);
    float* xcT = (float*)lds; float* ex = (float*)(lds + 69632); float* lfb = (float*)(lds + 71680);
    const int j = tid & 255, half = tid >> 8, hh = j >> 6, jj = j & 63;
    float xcv[32];
    {
        const float* cw = a->in[I_CONVW] + l * 4 * 256; const float cb = a->in[I_CONVB][l * 256 + j];
        const float w0 = cw[j], w1 = cw[256 + j], w2 = cw[512 + j], w3 = cw[768 + j];
        const int tb = t0 + half * 32;
        const bf16* px = P + ((size_t)b * S) * NP + C_XA + j;
        float x3 = (tb >= 3) ? bf2f(px[(size_t)(tb - 3) * NP]) : 0.f, x2 = (tb >= 2) ? bf2f(px[(size_t)(tb - 2) * NP]) : 0.f, x1 = (tb >= 1) ? bf2f(px[(size_t)(tb - 1) * NP]) : 0.f;
#pragma unroll
        for (int tt = 0; tt < 32; ++tt) { const float x0 = bf2f(px[(size_t)(tb + tt) * NP]); const float v = cb + w0 * x3 + w1 * x2 + w2 * x1 + w3 * x0;
            xcv[tt] = v; xcT[j * 68 + half * 32 + tt] = v; x3 = x2; x2 = x1; x1 = x0; }
    }
    __syncthreads();
    float aR[32], aI[32];
#pragma unroll
    for (int tt = 0; tt < 32; ++tt) { aR[tt] = 0.f; aI[tt] = 0.f; }
    {
        const float* wa = a->in[I_WA] + ((size_t)(l * 4 + hh) * 64) * 64 + jj; const float* wx = a->in[I_WX] + ((size_t)(l * 4 + hh) * 64) * 64 + jj;
#pragma unroll 2
        for (int i = 0; i < 64; ++i) { const float wai = wa[i * 64], wxi = wx[i * 64]; const f32x4* xr = (const f32x4*)(xcT + (hh * 64 + i) * 68 + half * 32);
#pragma unroll
            for (int q = 0; q < 8; ++q) { const f32x4 xv = xr[q];
                aR[4 * q] += xv.x * wai; aR[4 * q + 1] += xv.y * wai; aR[4 * q + 2] += xv.z * wai; aR[4 * q + 3] += xv.w * wai;
                aI[4 * q] += xv.x * wxi; aI[4 * q + 1] += xv.y * wxi; aI[4 * q + 2] += xv.z * wxi; aI[4 * q + 3] += xv.w * wxi; } }
    }
    {
        const float ba = a->in[I_BA][l * 256 + j], bx = a->in[I_BX][l * 256 + j], lam = a->in[I_LAM][l * 256 + j];
        const float sp = softplusf_(-lam);
        float hrun = 0.f, arun = 1.f;
#pragma unroll
        for (int tt = 0; tt < 32; ++tt) { const float r = sigmoidf_(aR[tt] + ba), ig = sigmoidf_(aI[tt] + bx); const float la = -8.f * r * sp; const float av = __expf(la);
            const float bb = sqrtf(fmaxf(-expm1f(2.f * la), 0.f)) * (ig * xcv[tt]); hrun = av * hrun + bb; arun *= av; aR[tt] = hrun; aI[tt] = arun; }
        if (half == 0) { ex[j] = hrun; ex[256 + j] = arun; }
    }
    __syncthreads();
    if (half == 1) { const float h0 = ex[j], a0 = ex[256 + j];
#pragma unroll
        for (int tt = 0; tt < 32; ++tt) { aR[tt] += aI[tt] * h0; aI[tt] *= a0; }
        ((float*)(a->ws + WS_AAGG))[(size_t)(b * NCH + c) * 256 + j] = aI[31]; ((float*)(a->ws + WS_HAGG))[(size_t)(b * NCH + c) * 256 + j] = aR[31]; }
    { bf16* HL = (bf16*)(a->ws + WS_HLOC); bf16* CA = (bf16*)(a->ws + WS_CUMA);
#pragma unroll
        for (int tt = 0; tt < 32; ++tt) { const size_t o = (row0 + half * 32 + tt) * 256 + j; HL[o] = (bf16)f2bf(aR[tt]); CA[o] = (bf16)f2bf(aI[tt]); } }
    if (fox) {
        const float* qg = a->in[I_QNG] + l * 64; const float* kg = a->in[I_KNG] + l * 64;
        for (int pass = 0; pass < 16; ++pass) { const int item = pass * 64 + (tid >> 3), sub = tid & 7; const int which = item >> 9, rem = item & 511, t = rem >> 3, h = rem & 7;
            bf16* p = P + (row0 + t) * NP + (which ? C_K : C_Q) + h * 64 + sub * 8;
            const v4u raw = *(const v4u*)p; float v[8] = {bflo(raw.x), bfhi(raw.x), bflo(raw.y), bfhi(raw.y), bflo(raw.z), bfhi(raw.z), bflo(raw.w), bfhi(raw.w)};
            float ss = 0.f;
#pragma unroll
            for (int e = 0; e < 8; ++e) ss += v[e] * v[e];
            ss += __shfl_xor(ss, 1); ss += __shfl_xor(ss, 2); ss += __shfl_xor(ss, 4);
            const float rstd = rsqrtf(ss * (1.f / 64.f) + 1e-6f) * (which ? 1.f : 0.125f * L2E);
            const float* g = (which ? kg : qg) + sub * 8;
            v4u o; o.x = pk2(v[0] * rstd * g[0], v[1] * rstd * g[1]); o.y = pk2(v[2] * rstd * g[2], v[3] * rstd * g[3]); o.z = pk2(v[4] * rstd * g[4], v[5] * rstd * g[5]); o.w = pk2(v[6] * rstd * g[6], v[7] * rstd * g[7]);
            *(v4u*)p = o; }
    }
    { const int t = tid >> 3, h = tid & 7; const float fl = bf2f(P[(row0 + t) * NP + C_FL + h]) + a->in[I_FB][l * 8 + h]; lfb[t * 8 + h] = fminf(fl, 0.f) - log1pf(__expf(-fabsf(fl))); }
    __syncthreads();
    if (tid < 8) { float run = 0.f; float* CL = (float*)(a->ws + WS_CLOC);
        for (int t = 0; t < 64; ++t) { run += lfb[t * 8 + tid]; CL[(row0 + t) * 8 + tid] = run; }
        ((float*)(a->ws + WS_CTOT))[(size_t)(b * NCH + c) * 8 + tid] = run; }
    __syncthreads();
}

constexpr int ATT_CS_OFF = 86016, ATT_CB_OFF = ATT_CS_OFF + 16384;
static_assert(attn_body::ATTN_LDS_BYTES <= ATT_CS_OFF && ATT_CB_OFF + 512 <= LDS_TAB, "attention LDS map");
__device__ __forceinline__ void attn_run(CA a, int b, int h, int qb, unsigned char* lds) {
    const int lane = attn_body::lane_now(); const int tid = __builtin_amdgcn_readfirstlane(threadIdx.x >> 6) * 64 + lane;
    float* cs = (float*)(lds + ATT_CS_OFF); float* cbase = (float*)(lds + ATT_CB_OFF);
    const float* CT = (const float*)(a->ws + WS_CTOT); const float* CL = (const float*)(a->ws + WS_CLOC);
    if (tid < 64) { const float v = CT[(size_t)(b * NCH + tid) * 8 + h]; float s = v;
#pragma unroll
        for (int o = 1; o < 64; o <<= 1) { const float n = __shfl_up(s, o); if (tid >= o) s += n; }
        cbase[tid] = s - v; }
    __syncthreads();
    const int q0 = qb * 256; const float cref = cbase[q0 >> 6] + CL[((size_t)b * S + q0) * 8 + h];
    for (int jx = tid; jx < q0 + 256; jx += NTHR) cs[jx] = (cref - (cbase[jx >> 6] + CL[((size_t)b * S + jx) * 8 + h])) * L2E;
    __syncthreads();
    int* t0w = (int*)(cbase + 64);
    if (tid < 64) { const int NT = (q0 + 256) / 64; const bool far = (tid < NT) && (cs[tid * 64 + 63] < -80.f); const int cnt = __popcll(__ballot(far)); if (tid == 0) t0w[0] = ((cnt < NT - 4) ? cnt : NT - 4) & ~1; }
    __syncthreads();
    const int t0 = t0w[0];
    const attn_body::bf16* P = (const attn_body::bf16*)(a->ws + WS_PROJ);
    attn_body::attn_unit<8>(b, h, qb, P + C_Q, P + C_K, P + C_V, (attn_body::bf16*)(a->ws + WS_Y) + 256, (char*)lds, (const char*)cs, t0);
}

typedef short bf16x8 __attribute__((ext_vector_type(8)));
constexpr int LDB = 72, MB = 64 * LDB * 2;
__device__ __forceinline__ f32x4 tile16(const unsigned char* X, int xr, const unsigned char* Y, int yr, f32x4 acc, int lane) {
    const int r = lane & 15, q = lane >> 4;
    const bf16x8 x0 = *(const bf16x8*)(X + ((xr + r) * LDB + q * 8) * 2), x1 = *(const bf16x8*)(X + ((xr + r) * LDB + 32 + q * 8) * 2);
    const bf16x8 y0 = *(const bf16x8*)(Y + ((yr + r) * LDB + q * 8) * 2), y1 = *(const bf16x8*)(Y + ((yr + r) * LDB + 32 + q * 8) * 2);
    acc = __builtin_amdgcn_mfma_f32_16x16x32_bf16(y0, x0, acc, 0, 0, 0);
    return __builtin_amdgcn_mfma_f32_16x16x32_bf16(y1, x1, acc, 0, 0, 0);
}
constexpr int R1_LR = 0, R1_W = 32768, R1_G = 65536, R1_M = 81920;
constexpr int R1_KH = R1_M, R1_BH = R1_M + MB, R1_KT = R1_M + 2 * MB, R1_RT = R1_M + 3 * MB, R1_KTT = R1_M + 4 * MB, R1_VT = R1_M + 5 * MB, R1_BGT = R1_M + 6 * MB, R1_KGT = R1_M + 7 * MB;
constexpr int R1_AT32 = 0, R1_AKKT = 16384, R1_W32 = 25600, R1_AKRT = 32768, R1_ABRT = 32768 + MB, R1_GC = 51200, R1_SEG = 51456, R1_T32 = R1_G;
constexpr int R1_NP = R1_KH, R1_VA = R1_BH, R1_TMT = R1_KT, R1_NE0 = R1_AKKT;
static_assert(R1_M + 8 * MB <= MISC_OFF && R1_W32 + 4096 <= 32768 && R1_SEG + 2048 <= 65536, "rw1 LDS map");
constexpr size_t WS_RWM = WS_H, WS_RWN = WS_H + 8 * MiB, WS_RWQ = WS_H + 16 * MiB, WS_RWO = WS_H + 24 * MiB;
constexpr size_t WS_SC = WS_ORAW;

__device__ __forceinline__ void rw1_unit(CA a, int l, int u, unsigned char* lds, int tid) {
    const int bh = u >> 6, c = u & 63, b = bh >> 2, h = bh & 3, lane = tid & 63, wave = tid >> 6;
    const size_t row0 = (size_t)b * S + c * 64;
    float* lr = (float*)(lds + R1_LR); float* w2h = (float*)(lds + R1_W); float* a2h = w2h + 2048; float* g2h = w2h + 4096; float* Gm = (float*)(lds + R1_G);
    const bf16* P = (const bf16*)(a->ws + WS_PROJ);
    const float* mu = a->in[I_MU] + l * RCOLS;
    for (int idx = tid; idx < 32 * 64; idx += NTHR) { const int jx = idx >> 6, n = idx & 63; w2h[idx] = a->in[I_W2][(size_t)(l * 32 + jx) * 256 + h * 64 + n]; a2h[idx] = a->in[I_A2][(size_t)(l * 32 + jx) * 256 + h * 64 + n]; }
    for (int idx = tid; idx < 64 * 64; idx += NTHR) { const int jx = idx >> 6, n = idx & 63; g2h[idx] = a->in[I_G2][(size_t)(l * 64 + jx) * 256 + h * 64 + n]; }
    for (int idx = tid; idx < 64 * 128; idx += NTHR) { const int t = idx >> 7, jx = idx & 127; const size_t o = (row0 + t) * NP + C_WD + jx;
        const float cur = bf2f(P[o]); const float prev = (c * 64 + t > 0) ? bf2f(P[o - NP]) : 0.f; float val = cur + (prev - cur) * mu[768 + jx];
        if (jx < 32) val = tanhf(val); else if (jx >= 64) val = sigmoidf_(val);
        lr[idx] = val; }
    __syncthreads();
    const int t = tid >> 3, n0 = (tid & 7) * 8; const size_t row = row0 + t;
    float av[8], gv[8];
    {
        float accw[8], acca[8], accg[8];
#pragma unroll
        for (int e = 0; e < 8; ++e) { accw[e] = a->in[I_W0][l * 256 + h * 64 + n0 + e]; acca[e] = a->in[I_A0][l * 256 + h * 64 + n0 + e]; accg[e] = 0.f; }
        const float* lrt = lr + t * 128;
#pragma unroll 2
        for (int jx = 0; jx < 32; ++jx) { const float lw = lrt[jx], la = lrt[32 + jx]; const f32x4 wA = *(const f32x4*)(w2h + jx * 64 + n0), wB = *(const f32x4*)(w2h + jx * 64 + n0 + 4), aA = *(const f32x4*)(a2h + jx * 64 + n0), aB = *(const f32x4*)(a2h + jx * 64 + n0 + 4);
            accw[0] += lw * wA.x; accw[1] += lw * wA.y; accw[2] += lw * wA.z; accw[3] += lw * wA.w; accw[4] += lw * wB.x; accw[5] += lw * wB.y; accw[6] += lw * wB.z; accw[7] += lw * wB.w;
            acca[0] += la * aA.x; acca[1] += la * aA.y; acca[2] += la * aA.z; acca[3] += la * aA.w; acca[4] += la * aB.x; acca[5] += la * aB.y; acca[6] += la * aB.z; acca[7] += la * aB.w; }
#pragma unroll 2
        for (int jx = 0; jx < 64; ++jx) { const float lg = lrt[64 + jx]; const f32x4 gA = *(const f32x4*)(g2h + jx * 64 + n0), gB = *(const f32x4*)(g2h + jx * 64 + n0 + 4);
            accg[0] += lg * gA.x; accg[1] += lg * gA.y; accg[2] += lg * gA.z; accg[3] += lg * gA.w; accg[4] += lg * gB.x; accg[5] += lg * gB.y; accg[6] += lg * gB.z; accg[7] += lg * gB.w; }
#pragma unroll
        for (int e = 0; e < 8; ++e) { const float wl = -softplusf_(-accw[e]) - 0.5f; Gm[t * 64 + n0 + e] = __expf(-__expf(wl)); av[e] = sigmoidf_(acca[e]); gv[e] = accg[e]; }
    }
    __syncthreads();
    {
        float* seg = (float*)(lds + R1_SEG); const int n = tid & 63, sg = tid >> 6; float p = 1.f;
#pragma unroll
        for (int i = 0; i < 8; ++i) { p *= Gm[(sg * 8 + i) * 64 + n]; Gm[(sg * 8 + i) * 64 + n] = p; }
        seg[sg * 64 + n] = p;
        __syncthreads();
        float pre = 1.f;
        for (int s2 = 0; s2 < sg; ++s2) pre *= seg[s2 * 64 + n];
#pragma unroll
        for (int i = 0; i < 8; ++i) Gm[(sg * 8 + i) * 64 + n] *= pre;
    }
    __syncthreads();
    {
        const bool hasprev = (c * 64 + t) > 0;
        const bf16* pr = P + row * NP + C_R + h * 64 + n0;
        const v4u rc = *(const v4u*)pr, kc = *(const v4u*)(pr + 256), vc = *(const v4u*)(pr + 512);
        v4u rp = {0u, 0u, 0u, 0u}, kp_ = rp, vp = rp;
        if (hasprev) { rp = *(const v4u*)(pr - NP); kp_ = *(const v4u*)(pr - NP + 256); vp = *(const v4u*)(pr - NP + 512); }
        const unsigned rcw[4] = {rc.x, rc.y, rc.z, rc.w}, kcw[4] = {kc.x, kc.y, kc.z, kc.w}, vcw[4] = {vc.x, vc.y, vc.z, vc.w};
        const unsigned rpw[4] = {rp.x, rp.y, rp.z, rp.w}, kpw[4] = {kp_.x, kp_.y, kp_.z, kp_.w}, vpw[4] = {vp.x, vp.y, vp.z, vp.w};
        float kkv[8], kpv[8], rv[8], vv[8]; float ss = 0.f, bon = 0.f;
#pragma unroll
        for (int e = 0; e < 8; ++e) { const int hn = h * 64 + n0 + e, w_ = e >> 1; const bool hi_ = e & 1;
            const float rcur = hi_ ? bfhi(rcw[w_]) : bflo(rcw[w_]), kcur = hi_ ? bfhi(kcw[w_]) : bflo(kcw[w_]), vcur = hi_ ? bfhi(vcw[w_]) : bflo(vcw[w_]);
            const float rprev = hi_ ? bfhi(rpw[w_]) : bflo(rpw[w_]), kprev = hi_ ? bfhi(kpw[w_]) : bflo(kpw[w_]), vprev = hi_ ? bfhi(vpw[w_]) : bflo(vpw[w_]);
            const float r = rcur + (rprev - rcur) * mu[hn], k = kcur + (kprev - kcur) * mu[256 + hn], v = vcur + (vprev - vcur) * mu[512 + hn];
            kkv[e] = k * a->in[I_KK][l * 256 + hn]; ss += kkv[e] * kkv[e];
            kpv[e] = k * (1.f + (av[e] - 1.f) * a->in[I_KA][l * 256 + hn]); bon += r * kpv[e] * a->in[I_RK][l * 256 + hn];
            rv[e] = r; vv[e] = v; }
        ss += __shfl_xor(ss, 1); ss += __shfl_xor(ss, 2); ss += __shfl_xor(ss, 4);
        bon += __shfl_xor(bon, 1); bon += __shfl_xor(bon, 2); bon += __shfl_xor(bon, 4);
        const float inv = 1.f / fmaxf(sqrtf(ss), 1e-12f);
        float kh[8], bh_[8], kt[8], rt[8], kg[8], bg[8];
#pragma unroll
        for (int e = 0; e < 8; ++e) { const int n = n0 + e; const float Gt = Gm[t * 64 + n], Gp = (t > 0) ? Gm[(t - 1) * 64 + n] : 1.f, GC = Gm[63 * 64 + n]; const float ig = 1.f / Gt;
            const float kkn = kkv[e] * inv; kh[e] = kpv[e] * ig; bh_[e] = kkn * av[e] * ig; kt[e] = kkn * Gp; rt[e] = rv[e] * Gt; kg[e] = kh[e] * GC; bg[e] = bh_[e] * GC; }
        v4u o;
        o.x = pk2(kh[0], kh[1]); o.y = pk2(kh[2], kh[3]); o.z = pk2(kh[4], kh[5]); o.w = pk2(kh[6], kh[7]); *(v4u*)(lds + R1_KH + (t * LDB + n0) * 2) = o;
        o.x = pk2(bh_[0], bh_[1]); o.y = pk2(bh_[2], bh_[3]); o.z = pk2(bh_[4], bh_[5]); o.w = pk2(bh_[6], bh_[7]); *(v4u*)(lds + R1_BH + (t * LDB + n0) * 2) = o;
        o.x = pk2(kt[0], kt[1]); o.y = pk2(kt[2], kt[3]); o.z = pk2(kt[4], kt[5]); o.w = pk2(kt[6], kt[7]); *(v4u*)(lds + R1_KT + (t * LDB + n0) * 2) = o;
        o.x = pk2(rt[0], rt[1]); o.y = pk2(rt[2], rt[3]); o.z = pk2(rt[4], rt[5]); o.w = pk2(rt[6], rt[7]); *(v4u*)(lds + R1_RT + (t * LDB + n0) * 2) = o;
#pragma unroll
        for (int e = 0; e < 8; ++e) { const int n = n0 + e;
            *(bf16*)(lds + R1_KTT + (n * LDB + t) * 2) = (bf16)f2bf(kt[e]); *(bf16*)(lds + R1_VT + (n * LDB + t) * 2) = (bf16)f2bf(vv[e]);
            *(bf16*)(lds + R1_BGT + (n * LDB + t) * 2) = (bf16)f2bf(bg[e]); *(bf16*)(lds + R1_KGT + (n * LDB + t) * 2) = (bf16)f2bf(kg[e]); }
        { v4u go, vo; go.x = pk2(gv[0], gv[1]); go.y = pk2(gv[2], gv[3]); go.z = pk2(gv[4], gv[5]); go.w = pk2(gv[6], gv[7]);
            vo.x = pk2(vv[0], vv[1]); vo.y = pk2(vv[2], vv[3]); vo.z = pk2(vv[4], vv[5]); vo.w = pk2(vv[6], vv[7]);
            *(v4u*)((bf16*)(a->ws + WS_G) + row * 256 + h * 64 + n0) = go; *(v4u*)((bf16*)(a->ws + WS_VS) + row * 256 + h * 64 + n0) = vo;
            if ((tid & 7) == 0) ((float*)(a->ws + WS_BON))[row * 4 + h] = bon; }
    }
    __syncthreads();
    const int mi = wave & 3, nb = (wave >> 2) * 2, r16 = lane & 15, q4 = lane >> 4;
    float* AT32 = (float*)(lds + R1_AT32); float* T32 = (float*)(lds + R1_T32); float* W32 = (float*)(lds + R1_W32); float* GCv = (float*)(lds + R1_GC);
    if (tid < 64) GCv[tid] = Gm[63 * 64 + tid];
#pragma unroll
    for (int k2 = 0; k2 < 2; ++k2) { const int ni = nb + k2; const f32x4 z = {0.f, 0.f, 0.f, 0.f};
        const f32x4 gkk = tile16(lds + R1_KT, mi * 16, lds + R1_KH, ni * 16, z, lane), gbk = tile16(lds + R1_KT, mi * 16, lds + R1_BH, ni * 16, z, lane);
        const f32x4 gkr = tile16(lds + R1_RT, mi * 16, lds + R1_KH, ni * 16, z, lane), gbr = tile16(lds + R1_RT, mi * 16, lds + R1_BH, ni * 16, z, lane);
        const int tt = mi * 16 + r16, i0 = ni * 16 + 4 * q4;
        float s0[4], s1[4], s2[4], s3[4];
#pragma unroll
        for (int j = 0; j < 4; ++j) { const bool st = (i0 + j) < tt, in = (i0 + j) <= tt; s0[j] = st ? gkk[j] : 0.f; s1[j] = st ? gbk[j] : 0.f; s2[j] = in ? gkr[j] : 0.f; s3[j] = in ? gbr[j] : 0.f; }
        v2u o; o.x = pk2(s0[0], s0[1]); o.y = pk2(s0[2], s0[3]); *(v2u*)(lds + R1_AKKT + (tt * LDB + i0) * 2) = o;
        o.x = pk2(s2[0], s2[1]); o.y = pk2(s2[2], s2[3]); *(v2u*)(lds + R1_AKRT + (tt * LDB + i0) * 2) = o;
        o.x = pk2(s3[0], s3[1]); o.y = pk2(s3[2], s3[3]); *(v2u*)(lds + R1_ABRT + (tt * LDB + i0) * 2) = o;
        *(f32x4*)(AT32 + tt * 64 + i0) = (f32x4){s1[0], s1[1], s1[2], s1[3]}; }
    __syncthreads();
    for (int idx = tid; idx < 4096; idx += NTHR) T32[idx] = 0.f;
    __syncthreads();
    if (tid < 64) { const int bk = tid >> 4, cc = tid & 15; const float* Lb = AT32 + (bk * 16) * 64 + bk * 16; float xc[16];
#pragma unroll
        for (int rr = 0; rr < 16; ++rr) { float sacc = 0.f;
#pragma unroll
            for (int j = 0; j < rr; ++j) sacc += Lb[rr * 64 + j] * xc[j];
            xc[rr] = (rr > cc) ? -sacc : ((rr == cc) ? 1.f : 0.f); T32[(bk * 16 + rr) * 64 + bk * 16 + cc] = xc[rr]; } }
    __syncthreads();
    {
        const int p = tid >> 8, rr = (tid >> 4) & 15, cc = tid & 15; const float* Bq = AT32 + ((2 * p + 1) * 16) * 64 + (2 * p) * 16; const float* X0 = T32 + ((2 * p) * 16) * 64 + (2 * p) * 16; const float* X1 = T32 + ((2 * p + 1) * 16) * 64 + (2 * p + 1) * 16;
        float sacc = 0.f;
#pragma unroll
        for (int k = 0; k < 16; ++k) sacc += Bq[rr * 64 + k] * X0[k * 64 + cc];
        W32[p * 256 + rr * 16 + cc] = sacc;
        __syncthreads();
        sacc = 0.f;
#pragma unroll
        for (int k = 0; k < 16; ++k) sacc += X1[rr * 64 + k] * W32[p * 256 + k * 16 + cc];
        T32[((2 * p + 1) * 16 + rr) * 64 + (2 * p) * 16 + cc] = -sacc;
    }
    __syncthreads();
    {
        const int rr = tid >> 4, c0 = (tid & 15) * 2; const float* Bq = AT32 + 32 * 64; const float* X1 = T32 + 32 * 64 + 32;
        float sa = 0.f, sb = 0.f;
#pragma unroll 8
        for (int k = 0; k < 32; ++k) { const float bv_ = Bq[rr * 64 + k]; sa += bv_ * T32[k * 64 + c0]; sb += bv_ * T32[k * 64 + c0 + 1]; }
        W32[rr * 32 + c0] = sa; W32[rr * 32 + c0 + 1] = sb;
        __syncthreads();
        sa = 0.f; sb = 0.f;
#pragma unroll 8
        for (int k = 0; k < 32; ++k) { const float xv = X1[rr * 64 + k]; sa += xv * W32[k * 32 + c0]; sb += xv * W32[k * 32 + c0 + 1]; }
        T32[(32 + rr) * 64 + c0] = -sa; T32[(32 + rr) * 64 + c0 + 1] = -sb;
    }
    __syncthreads();
    { const int tt = tid >> 3, i0 = (tid & 7) * 8; const f32x4 ta = *(const f32x4*)(T32 + tt * 64 + i0), tb = *(const f32x4*)(T32 + tt * 64 + i0 + 4);
        v4u o; o.x = pk2(ta.x, ta.y); o.y = pk2(ta.z, ta.w); o.z = pk2(tb.x, tb.y); o.w = pk2(tb.z, tb.w); *(v4u*)(lds + R1_TMT + (tt * LDB + i0) * 2) = o; }
    __syncthreads();
#pragma unroll
    for (int k2 = 0; k2 < 2; ++k2) { const int ni = nb + k2; const f32x4 z = {0.f, 0.f, 0.f, 0.f};
        const f32x4 gp = tile16(lds + R1_KTT, mi * 16, lds + R1_TMT, ni * 16, z, lane), gva = tile16(lds + R1_VT, mi * 16, lds + R1_AKKT, ni * 16, z, lane);
        const int xr = mi * 16 + r16, y0 = ni * 16 + 4 * q4;
        v2u o; o.x = pk2(-gp[0], -gp[1]); o.y = pk2(-gp[2], -gp[3]); *(v2u*)(lds + R1_NP + (xr * LDB + y0) * 2) = o;
        o.x = pk2(gva[0], gva[1]); o.y = pk2(gva[2], gva[3]); *(v2u*)(lds + R1_VA + (xr * LDB + y0) * 2) = o; }
    __syncthreads();
    {
        const size_t ob = (size_t)u * 4096;
        bf16* MTg = (bf16*)(a->ws + WS_RWM) + ob; bf16* QTg = (bf16*)(a->ws + WS_RWQ) + ob;
#pragma unroll
        for (int k2 = 0; k2 < 2; ++k2) { const int ni = nb + k2; const f32x4 z = {0.f, 0.f, 0.f, 0.f};
            const f32x4 ge = tile16(lds + R1_VA, mi * 16, lds + R1_TMT, ni * 16, z, lane);
            const f32x4 gm = tile16(lds + R1_BGT, mi * 16, lds + R1_NP, ni * 16, z, lane);
            const int xr = mi * 16 + r16, y0 = ni * 16 + 4 * q4;
            const v2u rt2 = *(const v2u*)(lds + R1_RT + (xr * LDB + y0) * 2);
            f32x4 q0 = {bflo(rt2.x), bfhi(rt2.x), bflo(rt2.y), bfhi(rt2.y)};
            q0 = tile16(lds + R1_ABRT, mi * 16, lds + R1_NP, ni * 16, q0, lane);
            v2u o; o.x = pk2(-ge[0], -ge[1]); o.y = pk2(-ge[2], -ge[3]); *(v2u*)(lds + R1_NE0 + (xr * LDB + y0) * 2) = o;
            const float gcx = GCv[xr];
            o.x = pk2(gm[0] + ((y0 == xr) ? gcx : 0.f), gm[1] + ((y0 + 1 == xr) ? gcx : 0.f)); o.y = pk2(gm[2] + ((y0 + 2 == xr) ? gcx : 0.f), gm[3] + ((y0 + 3 == xr) ? gcx : 0.f));
            *(v2u*)(MTg + xr * 64 + y0) = o;
            o.x = pk2(q0[0], q0[1]); o.y = pk2(q0[2], q0[3]); *(v2u*)(QTg + xr * 64 + y0) = o; }
    }
    __syncthreads();
    {
        const size_t ob = (size_t)u * 4096;
        bf16* N0g = (bf16*)(a->ws + WS_RWN) + ob; bf16* O0g = (bf16*)(a->ws + WS_RWO) + ob;
#pragma unroll
        for (int k2 = 0; k2 < 2; ++k2) { const int ni = nb + k2; f32x4 go = {0.f, 0.f, 0.f, 0.f}, gn = {0.f, 0.f, 0.f, 0.f};
            go = tile16(lds + R1_AKRT, mi * 16, lds + R1_VT, ni * 16, go, lane); go = tile16(lds + R1_ABRT, mi * 16, lds + R1_NE0, ni * 16, go, lane);
            gn = tile16(lds + R1_VT, mi * 16, lds + R1_KGT, ni * 16, gn, lane); gn = tile16(lds + R1_NE0, mi * 16, lds + R1_BGT, ni * 16, gn, lane);
            const int xr = mi * 16 + r16, y0 = ni * 16 + 4 * q4;
            v2u o; o.x = pk2(go[0], go[1]); o.y = pk2(go[2], go[3]); *(v2u*)(O0g + xr * 64 + y0) = o;
            o.x = pk2(gn[0], gn[1]); o.y = pk2(gn[2], gn[3]); *(v2u*)(N0g + xr * 64 + y0) = o; }
    }
    __syncthreads();
}

template <int VAR> __device__ __forceinline__ void scan_unit(CA a, int su, unsigned char* lds, int tid) {
    const int bh = su >> 1, half = su & 1, lane = tid & 63, wave = tid >> 6, mi = wave & 1, ni = wave >> 1, r16 = lane & 15, q4 = lane >> 4;
    const bf16* MTg = (const bf16*)(a->ws + WS_RWM) + (size_t)bh * 64 * 4096 + (ni * 16 + r16) * 64 + q4 * 8;
    const bf16* N0g = (const bf16*)(a->ws + WS_RWN) + (size_t)bh * 64 * 4096 + (half * 32 + mi * 16 + r16) * 64 + ni * 16 + 4 * q4;
    bf16* SCg = (bf16*)(a->ws + WS_SC) + (size_t)bh * 64 * 4096 + (half * 32 + mi * 16 + r16) * 64 + ni * 16 + 4 * q4;
    unsigned char* Sb = lds;
    bf16* dump = (bf16*)(a->ws + WS_SC + 8 * MiB) + (size_t)(su * NTHR + tid) * 4;
    const int soff = ((mi * 16 + r16) * LDB + ni * 16 + 4 * q4) * 2, xoff = ((mi * 16 + r16) * LDB + q4 * 8) * 2;
    constexpr int D = 16, SBB = 32 * LDB * 2;
    bf16x8 m0[D], m1[D]; v2u nn[D];
#pragma unroll
    for (int d = 0; d < D; ++d) { m0[d] = *(const bf16x8*)(MTg + (size_t)d * 4096); m1[d] = *(const bf16x8*)(MTg + (size_t)d * 4096 + 32); nn[d] = *(const v2u*)(N0g + (size_t)d * 4096); }
    { const v2u z = {0u, 0u}; *(v2u*)(Sb + soff) = z; if (VAR == 0) *(v2u*)SCg = z; }
#pragma unroll
    for (int cb = 0; cb < 64; cb += D) {
#pragma unroll
        for (int d = 0; d < D; ++d) { const int c = cb + d;
            asm volatile("s_waitcnt lgkmcnt(0)\n\ts_barrier" ::: "memory");
            const unsigned char* Sc = Sb + (c & 1) * SBB;
            const bf16x8 x0 = *(const bf16x8*)(Sc + xoff), x1 = *(const bf16x8*)(Sc + xoff + 64);
            f32x4 acc = {bflo(nn[d].x), bfhi(nn[d].x), bflo(nn[d].y), bfhi(nn[d].y)};
            acc = __builtin_amdgcn_mfma_f32_16x16x32_bf16(m0[d], x0, acc, 0, 0, 0); acc = __builtin_amdgcn_mfma_f32_16x16x32_bf16(m1[d], x1, acc, 0, 0, 0);
            v2u o; o.x = pk2(acc[0], acc[1]); o.y = pk2(acc[2], acc[3]);
            *(v2u*)(Sb + ((c + 1) & 1) * SBB + soff) = o;
            if (VAR == 0) *(v2u*)((c + 1 < 64) ? SCg + (size_t)(c + 1) * 4096 : dump) = o;
            if (VAR < 2 || VAR == 3) { const int cn = (VAR == 3) ? d : ((c + D < 64) ? c + D : 63); m0[d] = *(const bf16x8*)(MTg + (size_t)cn * 4096); m1[d] = *(const bf16x8*)(MTg + (size_t)cn * 4096 + 32); nn[d] = *(const v2u*)(N0g + (size_t)cn * 4096); } }
    }
    __syncthreads();
}

__device__ __forceinline__ float gelu_tanh(float x) { const float u = 0.7978845608028654f * (x + 0.044715f * x * x * x); return 0.5f * x * (1.f + tanhf(u)); }
__device__ __forceinline__ void post_unit(CA a, int l, int u, unsigned char* lds, int tid, bool fox = true) {
    const int b = u / NCH, c = u % NCH, lane = tid & 63, wave = tid >> 6; const size_t row0 = (size_t)b * S + c * 64;
    float* carry = (float*)lds;
    if (tid < 256) { const float* AA = (const float*)(a->ws + WS_AAGG) + (size_t)b * NCH * 256 + tid; const float* HA = (const float*)(a->ws + WS_HAGG) + (size_t)b * NCH * 256 + tid;
        float cr = 0.f; for (int cc = 0; cc < c; ++cc) cr = AA[cc * 256] * cr + HA[cc * 256]; carry[tid] = cr; }
    __syncthreads();
    const bf16* P = (const bf16*)(a->ws + WS_PROJ); bf16* Y = (bf16*)(a->ws + WS_Y);
    const f32x4 cr4 = *(const f32x4*)(carry + 4 * lane);
    const f32x4 lg4 = *(const f32x4*)(a->in[I_LNG] + l * 256 + 4 * lane);
    const f32x4 fgA = *(const f32x4*)(a->in[I_FNG] + l * 512 + 8 * lane), fgB = *(const f32x4*)(a->in[I_FNG] + l * 512 + 8 * lane + 4);
    for (int tt = wave; tt < 64; tt += NWAVES) { const size_t row = row0 + tt;
        {
            const v2u hl = *(const v2u*)((const bf16*)(a->ws + WS_HLOC) + row * 256 + 4 * lane), ca = *(const v2u*)((const bf16*)(a->ws + WS_CUMA) + row * 256 + 4 * lane), ga = *(const v2u*)(P + row * NP + C_GA + 4 * lane);
            const float y0 = gelu_tanh(bflo(ga.x)) * (bflo(hl.x) + bflo(ca.x) * cr4.x), y1 = gelu_tanh(bfhi(ga.x)) * (bfhi(hl.x) + bfhi(ca.x) * cr4.y),
                        y2 = gelu_tanh(bflo(ga.y)) * (bflo(hl.y) + bflo(ca.y) * cr4.z), y3 = gelu_tanh(bfhi(ga.y)) * (bfhi(hl.y) + bfhi(ca.y) * cr4.w);
            const float rstd = rsqrtf(wave_sum((y0 * y0 + y1 * y1) + (y2 * y2 + y3 * y3)) * (1.f / 256.f) + 1e-6f);
            v2u o; o.x = pk2(y0 * rstd * lg4.x, y1 * rstd * lg4.y); o.y = pk2(y2 * rstd * lg4.z, y3 * rstd * lg4.w); *(v2u*)(Y + row * DM + 4 * lane) = o; }
        if (fox) {
            bf16* p = Y + row * DM + 256 + 8 * lane; const v4u raw = *(const v4u*)p;
            const float v0 = bflo(raw.x), v1 = bfhi(raw.x), v2 = bflo(raw.y), v3 = bfhi(raw.y), v4 = bflo(raw.z), v5 = bfhi(raw.z), v6 = bflo(raw.w), v7 = bfhi(raw.w);
            const float rstd = rsqrtf(wave_sum(((v0 * v0 + v1 * v1) + (v2 * v2 + v3 * v3)) + ((v4 * v4 + v5 * v5) + (v6 * v6 + v7 * v7))) * (1.f / 512.f) + 1e-6f);
            v4u o; o.x = pk2(v0 * rstd * fgA.x, v1 * rstd * fgA.y); o.y = pk2(v2 * rstd * fgA.z, v3 * rstd * fgA.w); o.z = pk2(v4 * rstd * fgB.x, v5 * rstd * fgB.y); o.w = pk2(v6 * rstd * fgB.z, v7 * rstd * fgB.w);
            *(v4u*)p = o; }
    }
    {
        const int h = wave >> 1, r16 = lane & 15, q4 = lane >> 4; const size_t ub = ((size_t)((b * 4 + h) * 64 + c)) * 4096;
        const bf16* QTg = (const bf16*)(a->ws + WS_RWQ) + ub; const bf16* SCg = (const bf16*)(a->ws + WS_SC) + ub; const bf16* O0g = (const bf16*)(a->ws + WS_RWO) + ub;
        const float* rlg = a->in[I_RLG] + l * 256 + h * 64; const float* rlb = a->in[I_RLB] + l * 256 + h * 64;
#pragma unroll
        for (int m2 = 0; m2 < 2; ++m2) { const int t = (2 * (wave & 1) + m2) * 16 + r16; const size_t row = row0 + t;
            const bf16x8 x0 = *(const bf16x8*)(QTg + t * 64 + q4 * 8), x1 = *(const bf16x8*)(QTg + t * 64 + 32 + q4 * 8);
            f32x4 o[4]; float s = 0.f;
#pragma unroll
            for (int ni = 0; ni < 4; ++ni) { const bf16x8 y0 = *(const bf16x8*)(SCg + (ni * 16 + r16) * 64 + q4 * 8), y1 = *(const bf16x8*)(SCg + (ni * 16 + r16) * 64 + 32 + q4 * 8);
                const v2u ov = *(const v2u*)(O0g + t * 64 + ni * 16 + 4 * q4); o[ni] = (f32x4){bflo(ov.x), bfhi(ov.x), bflo(ov.y), bfhi(ov.y)};
                o[ni] = __builtin_amdgcn_mfma_f32_16x16x32_bf16(y0, x0, o[ni], 0, 0, 0); o[ni] = __builtin_amdgcn_mfma_f32_16x16x32_bf16(y1, x1, o[ni], 0, 0, 0);
                s += (o[ni][0] + o[ni][1]) + (o[ni][2] + o[ni][3]); }
            s += __shfl_xor(s, 16); s += __shfl_xor(s, 32);
            const float mean = s * (1.f / 64.f); float q = 0.f;
#pragma unroll
            for (int ni = 0; ni < 4; ++ni) { o[ni] = o[ni] - mean; q += (o[ni][0] * o[ni][0] + o[ni][1] * o[ni][1]) + (o[ni][2] * o[ni][2] + o[ni][3] * o[ni][3]); }
            q += __shfl_xor(q, 16); q += __shfl_xor(q, 32);
            const float rstd = rsqrtf(q * (1.f / 64.f) + 64e-5f);
            const float bon = ((const float*)(a->ws + WS_BON))[row * 4 + h];
#pragma unroll
            for (int ni = 0; ni < 4; ++ni) { const int n = ni * 16 + 4 * q4, hn = h * 64 + n;
                const f32x4 lg = *(const f32x4*)(rlg + n), lb = *(const f32x4*)(rlb + n);
                const v2u g2_ = *(const v2u*)((const bf16*)(a->ws + WS_G) + row * 256 + hn), vs = *(const v2u*)((const bf16*)(a->ws + WS_VS) + row * 256 + hn);
                const float z0 = (o[ni][0] * rstd * lg.x + lb.x + bon * bflo(vs.x)) * bflo(g2_.x), z1 = (o[ni][1] * rstd * lg.y + lb.y + bon * bfhi(vs.x)) * bfhi(g2_.x),
                            z2 = (o[ni][2] * rstd * lg.z + lb.z + bon * bflo(vs.y)) * bflo(g2_.y), z3 = (o[ni][3] * rstd * lg.w + lb.w + bon * bfhi(vs.y)) * bfhi(g2_.y);
                v2u ow; ow.x = pk2(z0, z1); ow.y = pk2(z2, z3); *(v2u*)(Y + row * DM + 768 + hn) = ow; } }
    }
    __syncthreads();
}

struct EpiResF32 {
    static constexpr bool PERM = true, AFTER_DRAIN = false;
    const float* X; float* O;
    __device__ __forceinline__ void operator()(const pg8::f32x4 (&acc)[2][2][4][2], const pg8::Unit& u, int wr, int wc, int fr, int fq) const {
        const int row0 = u.pm * 256 + wr * 64 + fr, col0 = u.pn * 256 + wc * 32 + 8 * fq;
#pragma unroll
        for (int ai = 0; ai < 2; ++ai)
#pragma unroll
            for (int m = 0; m < 4; ++m) { const size_t ro = (size_t)(row0 + ai * 128 + m * 16) * DM + col0;
#pragma unroll
                for (int bj = 0; bj < 2; ++bj) { const pg8::f32x4 x0 = *(const pg8::f32x4*)(X + ro + bj * 128), x1 = *(const pg8::f32x4*)(X + ro + bj * 128 + 4);
                    *(pg8::f32x4*)(O + ro + bj * 128) = x0 + acc[ai][bj][m][0]; *(pg8::f32x4*)(O + ro + bj * 128 + 4) = x1 + acc[ai][bj][m][1]; } }
    }
};
struct MoeSched {
    const int* tst; int NJ, nunits, G, c;
    __device__ __forceinline__ bool next(int i, pg8::Unit& u) const {
        const int L = i * G + c; if (L >= nunits) return false;
        const int tile = L / NJ, j = L % NJ; int e = 0;
#pragma unroll
        for (int k = 1; k < NE; ++k) e += (tile >= tst[k]) ? 1 : 0;
        u.pm = tile; u.pn = e * NJ + j; return true;
    }
    __device__ __forceinline__ void a_ready(const pg8::Unit&) const {}
    __device__ __forceinline__ void done(const pg8::Unit&) const {}
};
struct EpiSwiglu {
    static constexpr bool PERM = true, AFTER_DRAIN = false;
    bf16* HID; const float* SW; const int* tst; const int* cnt;
    __device__ __forceinline__ void operator()(const pg8::f32x4 (&acc)[2][2][4][2], const pg8::Unit& u, int wr, int wc, int fr, int fq) const {
        const int e = u.pn >> 1, j = u.pn & 1, seg0 = tst[e] * 256, ce = cnt[e];
        const int row0 = u.pm * 256 + wr * 64 + fr, hc0 = j * 128 + wc * 16 + 4 * fq;
#pragma unroll
        for (int ai = 0; ai < 2; ++ai)
#pragma unroll
            for (int m = 0; m < 4; ++m) { const int row = row0 + ai * 128 + m * 16; const bool valid = (row - seg0) < ce; const float w = valid ? SW[row] : 0.f;
#pragma unroll
                for (int bj = 0; bj < 2; ++bj) { const pg8::f32x4 v0 = acc[ai][bj][m][0], v1 = acc[ai][bj][m][1];
                    float h0 = v0[0] * sigmoidf_(v0[0]) * v0[1] * w, h1 = v0[2] * sigmoidf_(v0[2]) * v0[3] * w, h2 = v1[0] * sigmoidf_(v1[0]) * v1[1] * w, h3 = v1[2] * sigmoidf_(v1[2]) * v1[3] * w;
                    if (!valid) { h0 = 0.f; h1 = 0.f; h2 = 0.f; h3 = 0.f; }
                    v2u o; o.x = pk2(h0, h1); o.y = pk2(h2, h3); *(v2u*)(HID + (size_t)row * DE + hc0 + bj * 64) = o; } }
    }
};
struct EpiYE {
    static constexpr bool PERM = true, AFTER_DRAIN = false;
    bf16* YE;
    __device__ __forceinline__ void operator()(const pg8::f32x4 (&acc)[2][2][4][2], const pg8::Unit& u, int wr, int wc, int fr, int fq) const {
        const int j = u.pn & 3; const int row0 = u.pm * 256 + wr * 64 + fr, col0 = j * 256 + wc * 32 + 8 * fq;
#pragma unroll
        for (int ai = 0; ai < 2; ++ai)
#pragma unroll
            for (int m = 0; m < 4; ++m) { bf16* rowp = YE + (size_t)(row0 + ai * 128 + m * 16) * DM + col0;
#pragma unroll
                for (int bj = 0; bj < 2; ++bj) { const pg8::f32x4 v0 = acc[ai][bj][m][0], v1 = acc[ai][bj][m][1];
                    v4u w; w.x = pk2(v0[0], v0[1]); w.y = pk2(v0[2], v0[3]); w.z = pk2(v1[0], v1[1]); w.w = pk2(v1[2], v1[3]); *(v4u*)(rowp + bj * 128) = w; } }
    }
};

__device__ __forceinline__ void phase_route(CA a, int l, unsigned char* lds, int tid, gu32* ctl, bool first = true) {
    const int lane = tid & 63, wave = tid >> 6; const int gw = blockIdx.x * NWAVES + wave, NGW = gridDim.x * NWAVES;
    float* rw = (float*)lds; int* hist = (int*)(lds + 81920);
    { const float* g2 = a->in[I_N2G] + l * DM; const float* gwp = a->in[I_RGW] + (size_t)l * DM * 4; const float* ewp = a->in[I_REW] + (size_t)l * DM * NE;
        for (int idx = tid; idx < DM * 20; idx += NTHR) { const int d = idx / 20, cx = idx % 20; rw[idx] = g2[d] * (cx < 4 ? gwp[d * 4 + cx] : ewp[d * NE + cx - 4]); } }
    if (tid < NE) hist[tid] = 0;
    __syncthreads();
    bf16* H = (bf16*)(a->ws + WS_H); int* TE = (int*)(a->ws + WS_TOKE); float* TW = (float*)(a->ws + WS_TOKW);
    const float* gb = a->in[I_RGB] + l * 4; const float* eb = a->in[I_REB] + l * NE;
    for (int m = gw; m < T; m += NGW) {
        const f32x4* xr = (const f32x4*)(a->out + (size_t)m * DM) + lane;
        f32x4 v[4]; float s = 0.f;
#pragma unroll
        for (int j = 0; j < 4; ++j) { v[j] = xr[64 * j]; s += (v[j].x * v[j].x + v[j].y * v[j].y) + (v[j].z * v[j].z + v[j].w * v[j].w); }
        const float rstd = rsqrtf(wave_sum(s) * (1.f / DM) + 1e-6f);
        v2u* o8 = (v2u*)(H + (size_t)m * DM) + lane;
        float acc[20];
#pragma unroll
        for (int cx = 0; cx < 20; ++cx) acc[cx] = 0.f;
#pragma unroll
        for (int j = 0; j < 4; ++j) { v[j] = v[j] * rstd; v2u o; o.x = pk2(v[j].x, v[j].y); o.y = pk2(v[j].z, v[j].w); o8[64 * j] = o;
#pragma unroll
            for (int e = 0; e < 4; ++e) { const float xv = v[j][e]; const f32x4* wr = (const f32x4*)(rw + (size_t)(4 * lane + 256 * j + e) * 20);
#pragma unroll
                for (int q = 0; q < 5; ++q) { const f32x4 w4 = wr[q]; acc[4 * q] += xv * w4.x; acc[4 * q + 1] += xv * w4.y; acc[4 * q + 2] += xv * w4.z; acc[4 * q + 3] += xv * w4.w; } } }
#pragma unroll
        for (int cx = 0; cx < 20; ++cx) acc[cx] = wave_sum(acc[cx]);
        const float g0 = acc[0] + gb[0], g1 = acc[1] + gb[1], g2_ = acc[2] + gb[2], g3 = acc[3] + gb[3];
        int gi = 0; float gm = g0; if (g1 > gm) { gm = g1; gi = 1; } if (g2_ > gm) { gm = g2_; gi = 2; } if (g3 > gm) { gm = g3; gi = 3; }
        const float gp = 1.f / (__expf(g0 - gm) + __expf(g1 - gm) + __expf(g2_ - gm) + __expf(g3 - gm));
        float el[4];
#pragma unroll
        for (int k = 0; k < 4; ++k) el[k] = (gi == 0 ? acc[4 + k] : gi == 1 ? acc[8 + k] : gi == 2 ? acc[12 + k] : acc[16 + k]) + eb[gi * 4 + k];
        int i0 = 0; float m0 = el[0]; if (el[1] > m0) { m0 = el[1]; i0 = 1; } if (el[2] > m0) { m0 = el[2]; i0 = 2; } if (el[3] > m0) { m0 = el[3]; i0 = 3; }
        int i1 = -1; float m1 = -INFINITY;
#pragma unroll
        for (int k = 0; k < 4; ++k) { if (k != i0 && el[k] > m1) { m1 = el[k]; i1 = k; } }
        const float p0 = 1.f / (1.f + __expf(m1 - m0)), p1 = 1.f - p0;
        if (lane == 0) { const int e0 = gi * 4 + i0, e1 = gi * 4 + i1; TE[m * 2] = e0; TE[m * 2 + 1] = e1; TW[m * 2] = gp * p0; TW[m * 2 + 1] = gp * p1; atomicAdd(&hist[e0], 1); atomicAdd(&hist[e1], 1); }
    }
    __syncthreads();
    if (first && tid < NE) __hip_atomic_fetch_add((unsigned*)(ctl + CW_CNT0 + l * CW_LSTRIDE + tid), (unsigned)hist[tid], RLX_AGENT);
    __syncthreads();
}

__device__ __forceinline__ void moe_tables(int l, unsigned char* lds, int tid, gu32* ctl) {
    int* tst = (int*)(lds + LDS_TAB); int* cnt = tst + 32;
    if (tid == 0) { int acc = 0; for (int e = 0; e < NE; ++e) { const int ce = (int)__hip_atomic_load(ctl + CW_CNT0 + l * CW_LSTRIDE + e, RLX_AGENT); cnt[e] = ce; tst[e] = acc; acc += (ce + 255) >> 8; } tst[NE] = acc; }
    __syncthreads();
}
__device__ __forceinline__ void phase_place(CA a, int l, unsigned char* lds, int tid, gu32* ctl) {
    const int lane = tid & 63, wave = tid >> 6;
    int* tst = (int*)(lds + LDS_TAB); int* lcnt = (int*)lds; int* lbase = lcnt + 16; int* sslot = lcnt + 32;
    const int* TE = (const int*)(a->ws + WS_TOKE); const float* TW = (const float*)(a->ws + WS_TOKW); float* SW = (float*)(a->ws + WS_SW); int* TSL = (int*)(a->ws + WS_TSLOT);
    const bf16* H = (const bf16*)(a->ws + WS_H); bf16* AS = (bf16*)(a->ws + WS_ASORT);
    for (int u = blockIdx.x; u < T / 64; u += gridDim.x) {
        if (tid < NE) lcnt[tid] = 0;
        __syncthreads();
        int e = 0, lrank = 0, t = 0; float w = 0.f;
        if (tid < 128) { t = u * 64 + (tid >> 1); e = TE[t * 2 + (tid & 1)]; w = TW[t * 2 + (tid & 1)]; lrank = atomicAdd(&lcnt[e], 1); }
        __syncthreads();
        if (tid < NE) lbase[tid] = (int)__hip_atomic_fetch_add((unsigned*)(ctl + CW_CUR0 + l * CW_LSTRIDE + tid), (unsigned)lcnt[tid], RLX_AGENT);
        __syncthreads();
        if (tid < 128) { const int slot = tst[e] * 256 + lbase[e] + lrank; TSL[t * 2 + (tid & 1)] = slot; SW[slot] = w; sslot[tid] = slot; }
        __syncthreads();
#pragma unroll 4
        for (int i = 0; i < 16; ++i) { const int p = wave * 16 + i; const int tk = u * 64 + (p >> 1); const int slot = sslot[p];
            const v4u* src = (const v4u*)(H + (size_t)tk * DM) + lane; v4u* dst = (v4u*)(AS + (size_t)slot * DM) + lane; dst[0] = src[0]; dst[64] = src[64]; }
        __syncthreads();
    }
}

__global__ void __launch_bounds__(NTHR, 2) fwd(Args a_unused) {
    extern __shared__ __attribute__((aligned(16))) unsigned char lds[];
    volatile LAS unsigned* MISC = (volatile LAS unsigned*)((LAS unsigned char*)lds + MISC_OFF);
    if (threadIdx.x < 64) MISC[threadIdx.x] = 0u;
    __syncthreads();
#if MK_ONE_LAUNCH
    XcdBarrier bar = xcd_barrier_post((unsigned*)(args_now()->ws + WS_CTL) + CW_BAR, MISC + 8);
#define SEAM(k) do { if (IN((k) + 1)) xcd_barrier(bar); } while (0)
#else
#define SEAM(k) do { } while (0)
#endif
    const int lo = args_now()->ph_lo, hi = args_now()->ph_hi;
#ifndef REP_GIN
#define REP_GIN 1
#endif
#ifndef REP_LRU
#define REP_LRU 1
#endif
#ifndef REP_RW1
#define REP_RW1 1
#endif
#ifndef REP_SCAN
#define REP_SCAN 1
#endif
#ifndef REP_ATTN
#define REP_ATTN 1
#endif
#ifndef REP_POST
#define REP_POST 1
#endif
#ifndef REP_ROUTE
#define REP_ROUTE 1
#endif
#ifndef REP_MOE1
#define REP_MOE1 1
#endif
#ifndef REP_MOE2
#define REP_MOE2 1
#endif
#ifndef PHASE_MASK
#define PHASE_MASK 0x3ff
#endif
#define IN(k) (((PHASE_MASK >> ((k) % NPH)) & 1) && lo <= (k) && (k) < hi)
    for (int l = 0; l < NL; ++l) {
        const int pb = l * NPH;
        if (IN(pb + PH_PRE)) { phase_pre(args_now(), l, lds, pg8::tid_now()); SEAM(pb + PH_PRE); }
        if (IN(pb + PH_GIN)) { CA a = args_now();
            pg8::Gemm g{(const pg8::bf16_t*)(a->ws + WS_H), (const pg8::bf16_t*)(a->ws + WS_WIN), T, NP, DM}; pg8::StaticOrder So; So.init(T, NP, (int)gridDim.x, (int)blockIdx.x);
            pg8::EpiBf16<0> E{(pg8::bf16_t*)(a->ws + WS_PROJ), NP, nullptr, 0, 0, 1.f};
            for (int rep = 0; rep < REP_GIN; ++rep) pg8::gemm_phase<pg8::EpiBf16<0>, pg8::StaticOrder, true, true>((PG8_LAS unsigned char*)lds, g, So, E);
            SEAM(pb + PH_GIN);
        }
        if (IN(pb + PH_PREP)) {
            for (int rep = 0; rep < REP_LRU; ++rep) for (int u = blockIdx.x; u < Bsz * NCH; u += gridDim.x) prep_unit(args_now(), l, u, lds, pg8::tid_now(), rep == 0);
            for (int rep = 0; rep < REP_RW1; ++rep) for (int u = blockIdx.x; u < Bsz * 4 * NCH; u += gridDim.x) rw1_unit(args_now(), l, u, lds, pg8::tid_now());
            SEAM(pb + PH_PREP);
        }
        if (IN(pb + PH_MIX)) {
            for (int su = blockIdx.x; su < Bsz * 4 * 2; su += gridDim.x) scan_unit<0>(args_now(), su, lds, pg8::tid_now());
#ifdef SCAN_VAR
            for (int rep = 1; rep < REP_SCAN; ++rep) for (int su = blockIdx.x; su < Bsz * 4 * 2; su += gridDim.x) scan_unit<SCAN_VAR>(args_now(), su, lds, pg8::tid_now());
#endif
#if MK_ONE_LAUNCH && defined(SCAN_ALONE)
            xcd_barrier(bar);
#endif
            { CA a = args_now(); gu32* qh = (gu32*)(a->ws + WS_CTL) + CW_Q0 + l * CW_LSTRIDE;
                for (;;) {
                    if (threadIdx.x == 0) MISC[0] = __hip_atomic_fetch_add((unsigned*)qh, 1u, RLX_AGENT);
                    __syncthreads();
                    const int ui = (int)MISC[0];
                    __syncthreads();
                    if (ui >= Bsz * 8 * 16) break;
                    const int bh = ui & 31; attn_run(args_now(), bh >> 3, bh & 7, 15 - (ui >> 5), lds);
                } }
            SEAM(pb + PH_MIX);
        }
        if (IN(pb + PH_POST)) { for (int rep = 0; rep < REP_POST; ++rep) for (int u = blockIdx.x; u < Bsz * NCH; u += gridDim.x) post_unit(args_now(), l, u, lds, pg8::tid_now(), rep == 0); SEAM(pb + PH_POST); }
        if (IN(pb + PH_GOUT)) { CA a = args_now();
            pg8::Gemm g{(const pg8::bf16_t*)(a->ws + WS_Y), (const pg8::bf16_t*)(a->ws + WS_WOUT), T, DM, DM}; pg8::StaticOrder So; So.init(T, DM, (int)gridDim.x, (int)blockIdx.x);
            EpiResF32 E{(l == 0) ? a->in[I_X] : a->out, a->out};
            pg8::gemm_phase<EpiResF32, pg8::StaticOrder, true, true>((PG8_LAS unsigned char*)lds, g, So, E);
            SEAM(pb + PH_GOUT);
        }
        if (IN(pb + PH_ROUTE)) { CA a = args_now(); for (int rep = 0; rep < REP_ROUTE; ++rep) phase_route(a, l, lds, pg8::tid_now(), (gu32*)(a->ws + WS_CTL), rep == 0); SEAM(pb + PH_ROUTE); }
        if (IN(pb + PH_PLACE)) { CA a = args_now(); const int tid = pg8::tid_now(); gu32* ctl = (gu32*)(a->ws + WS_CTL); moe_tables(l, lds, tid, ctl); phase_place(a, l, lds, tid, ctl); SEAM(pb + PH_PLACE); }
        if (IN(pb + PH_MOE1)) { CA a = args_now();
            moe_tables(l, lds, pg8::tid_now(), (gu32*)(a->ws + WS_CTL));
            const int* tst = (const int*)(lds + LDS_TAB); const int* cnt = tst + 32;
            pg8::Gemm g{(const pg8::bf16_t*)(a->ws + WS_ASORT), (const pg8::bf16_t*)(a->ws + WS_WGU), MAXTILES * 256, NE * 512, DM};
            MoeSched Sm{tst, 2, tst[NE] * 2, (int)gridDim.x, (int)blockIdx.x};
            EpiSwiglu E{(bf16*)(a->ws + WS_HID), (const float*)(a->ws + WS_SW), tst, cnt};
            for (int rep = 0; rep < REP_MOE1; ++rep) pg8::gemm_phase<EpiSwiglu, MoeSched, true, true>((PG8_LAS unsigned char*)lds, g, Sm, E);
            SEAM(pb + PH_MOE1);
        }
        if (IN(pb + PH_MOE2)) { CA a = args_now();
            moe_tables(l, lds, pg8::tid_now(), (gu32*)(a->ws + WS_CTL));
            const int* tst = (const int*)(lds + LDS_TAB);
            int Kd = DE; asm volatile("" : "+s"(Kd));
            pg8::Gemm g{(const pg8::bf16_t*)(a->ws + WS_HID), (const pg8::bf16_t*)(a->ws + WS_WD), MAXTILES * 256, NE * DM, Kd};
            MoeSched Sm{tst, 4, tst[NE] * 4, (int)gridDim.x, (int)blockIdx.x};
            EpiYE E{(bf16*)(a->ws + WS_YE)};
            for (int rep = 0; rep < REP_MOE2; ++rep) pg8::gemm_phase<EpiYE, MoeSched, true, true>((PG8_LAS unsigned char*)lds, g, Sm, E);
            SEAM(pb + PH_MOE2);
        }
    }
    if (IN(PH_FIN)) phase_fin(args_now(), pg8::tid_now());
#undef IN
#undef SEAM
}

extern "C" void kernel_launch(void* const* d_in, const int* in_sizes, int n_in, void* d_out, int out_size, void* d_ws, size_t ws_size, hipStream_t stream) {
    static int grid = 0;
    if (grid == 0) {
        if (n_in != N_IN || in_sizes[0] != T * DM || out_size != T * DM || ws_size < WS_END) { fprintf(stderr, "kernel_launch: unexpected problem shape (n_in %d, in0 %d, out %d, ws %zu); nothing launched\n", n_in, n_in > 0 ? in_sizes[0] : -1, out_size, ws_size); grid = -1; return; }
        int dev = 0, cus = 0, per_cu = 0;
        if (hipGetDevice(&dev) != hipSuccess || hipDeviceGetAttribute(&cus, hipDeviceAttributeMultiprocessorCount, dev) != hipSuccess) { grid = -1; return; }
        if (hipFuncSetAttribute((const void*)fwd, hipFuncAttributeMaxDynamicSharedMemorySize, LDS_BYTES) != hipSuccess) { fprintf(stderr, "kernel_launch: hipFuncSetAttribute failed\n"); grid = -1; return; }
        if (hipOccupancyMaxActiveBlocksPerMultiprocessor(&per_cu, (const void*)fwd, NTHR, LDS_BYTES) != hipSuccess || per_cu < 1) { fprintf(stderr, "kernel_launch: occupancy query reports %d workgroups per CU\n", per_cu); }
        (void)hipGetLastError();
        grid = cus;
    }
    if (grid < 0) return;
    if (hipMemsetAsync((char*)d_ws + WS_CTL, 0, CTL_ZERO_BYTES, stream) != hipSuccess) return;
    Args a{};
    for (int i = 0; i < N_IN; ++i) a.in[i] = (const float*)d_in[i];
    a.out = (float*)d_out; a.ws = (unsigned char*)d_ws;
#if MK_ONE_LAUNCH
    a.ph_lo = 0; a.ph_hi = N_PHASES;
    hipLaunchKernelGGL(fwd, dim3(grid), dim3(NTHR), LDS_BYTES, stream, a);
#else
    for (int p = 0; p < N_PHASES; ++p) { a.ph_lo = p; a.ph_hi = p + 1; hipLaunchKernelGGL(fwd, dim3(grid), dim3(NTHR), LDS_BYTES, stream, a); }
#endif
}
```

```cpp
#include <hip/hip_runtime.h>
#include <hip/hip_bf16.h>
#include <cstdio>
#include <cstdint>
#include <cmath>
namespace pg8 {
#define PG8_LAS __attribute__((address_space(3)))
typedef unsigned short bf16_t;
typedef short bf16x8 __attribute__((ext_vector_type(8)));
typedef float f32x4 __attribute__((ext_vector_type(4)));
typedef unsigned u32x4 __attribute__((ext_vector_type(4)));
__device__ __forceinline__ int tid_now() { int t = threadIdx.x; asm volatile("" : "+v"(t)); return t; }
constexpr int BM = 256, BK = 64, HALF = 128, HTB = HALF * BK * 2  , STAGE_BYTES = 8 * HTB, NXCD = 8, WGM = 8;

__host__ __device__ __forceinline__ int lds_byte(int r, int c) { const int st = (r >> 4) * 2 + (c >> 5), rr = r & 15, cc = c & 31, ob = rr * 64 + cc * 2; return st * 1024 + (ob ^ (((ob >> 9) & 1) << 5)); }
__host__ __device__ __forceinline__ void stage_rc(int b, int& R, int& C) { const int st = b / 1024, sb = b % 1024, swz = sb ^ (((sb >> 9) & 1) << 5); R = (st >> 1) * 16 + swz / 64; C = (st & 1) * 32 + (swz % 64) / 2; }
__host__ __device__ __forceinline__ int perm32(int rho) { const int n = rho >> 4, i = rho & 15; return 8 * (i >> 2) + 4 * n + (i & 3); }

struct Unit { int pm, pn; };
struct Gemm { const bf16_t* A; const bf16_t* Bt; int M, N, K; };

struct StaticOrder {
    int nM, nN, nwg, G, c;
    __host__ __device__ void init(int M, int N, int G_, int c_) { nM = M / BM; nN = N / BM; nwg = nM * nN; G = G_; c = c_; }
    __host__ __device__ bool next(int i, Unit& u) const {
        const long L = (long)i * G + c; if (L >= nwg) return false;
        int wgid = (int)L; { const int q = nwg / NXCD, r = nwg % NXCD, xcd = wgid % NXCD, off = wgid / NXCD; wgid = (xcd < r ? xcd * (q + 1) : r * (q + 1) + (xcd - r) * q) + off; }
        const int nig = WGM * nN, gid = wgid / nig, fm = gid * WGM, gsz = (nM - fm) < WGM ? (nM - fm) : WGM;
        u.pm = fm + ((wgid % nig) % gsz); u.pn = (wgid % nig) / gsz; return true;
    }
    __device__ __forceinline__ void a_ready(const Unit&) const {}
    __device__ __forceinline__ void done(const Unit&) const {}
};

__device__ __forceinline__ unsigned cvt_pk_bf16(float lo, float hi) { unsigned r; asm volatile("v_cvt_pk_bf16_f32 %0, %1, %2" : "=v"(r) : "v"(lo), "v"(hi)); return r; }
typedef float f32x2 __attribute__((ext_vector_type(2)));
__device__ __forceinline__ f32x2 gelu_pk(f32x2 v) {
    const f32x2 av = __builtin_elementwise_abs(v), d = av * 0.2316418882f + 1.0f;
    f32x2 t; t.x = __builtin_amdgcn_rcpf(d.x); t.y = __builtin_amdgcn_rcpf(d.y);
    f32x2 q = t * 0.5307027145f + (-0.7265760135f); q = q * t + 0.7107068705f; q = q * t + (-0.142248368f); q = q * t + 0.127414796f; q = q * t;
    const f32x2 s = (v * v) * (-0.72134752044f);
    f32x2 e; e.x = __builtin_amdgcn_exp2f(s.x); e.y = __builtin_amdgcn_exp2f(s.y);
    const f32x2 m = v * (q * e), r = v - m;
    f32x2 o; o.x = v.x < 0.f ? m.x : r.x; o.y = v.y < 0.f ? m.y : r.y; return o;
}

template <int ACT  > struct EpiBf16 {
    static constexpr bool PERM = true, AFTER_DRAIN = false; static_assert(ACT == 0 || ACT == 1, "EpiBf16: ACT is 0 (none) or 1 (gelu_pk)");
    bf16_t* O; int ldc; const float* bias; int split_cols; size_t split_stride; float scale0;
    __device__ __forceinline__ void operator()(const f32x4 (&acc)[2][2][4][2], const Unit& u, int wr, int wc, int fr, int fq) const {
        const int row0 = u.pm * BM + wr * 64 + fr; int colt = u.pn * BM; bf16_t* base = O;
        float sc = 1.f; if (split_cols) { const int t = colt / split_cols; base += (size_t)t * split_stride; colt -= t * split_cols; if (t == 0) sc = scale0; }
        const int col0 = colt + wc * 32 + 8 * fq, bcol0 = u.pn * BM + wc * 32 + 8 * fq;
        f32x4 bv[2][2];
#pragma unroll
        for (int bj = 0; bj < 2; ++bj)
#pragma unroll
            for (int n = 0; n < 2; ++n) bv[bj][n] = bias ? *(const f32x4*)(bias + bcol0 + bj * HALF + 4 * n) : (f32x4){0.f, 0.f, 0.f, 0.f};
#pragma unroll
        for (int ai = 0; ai < 2; ++ai)
#pragma unroll
            for (int m = 0; m < 4; ++m) { bf16_t* rowp = base + (size_t)(row0 + ai * HALF + m * 16) * ldc + col0;
#pragma unroll
                for (int bj = 0; bj < 2; ++bj) { f32x4 v0 = acc[ai][bj][m][0] + bv[bj][0], v1 = acc[ai][bj][m][1] + bv[bj][1];
                    if (ACT == 1) { f32x2 a = gelu_pk((f32x2){v0[0], v0[1]}), b = gelu_pk((f32x2){v0[2], v0[3]}), c = gelu_pk((f32x2){v1[0], v1[1]}), d = gelu_pk((f32x2){v1[2], v1[3]});
                        v0 = (f32x4){a.x, a.y, b.x, b.y}; v1 = (f32x4){c.x, c.y, d.x, d.y}; }
                    v0 = v0 * sc; v1 = v1 * sc; u32x4 w; w.x = cvt_pk_bf16(v0[0], v0[1]); w.y = cvt_pk_bf16(v0[2], v0[3]); w.z = cvt_pk_bf16(v1[0], v1[1]); w.w = cvt_pk_bf16(v1[2], v1[3]);
                    *(u32x4*)(rowp + bj * HALF) = w; } }
    }
};
template <class Epi, class Sched, bool ALIGN_EPI = false, bool SP2 = false>
__device__ __forceinline__ void gemm_phase(PG8_LAS unsigned char* lds, const Gemm g, const Sched& S, const Epi& E) {
    const int tid = tid_now(), wid = __builtin_amdgcn_readfirstlane(tid >> 6), lane = tid & 63, wr = wid >> 2, wc = wid & 3, fr = lane & 15, fq = lane >> 4;
    const int K = g.K, nt = K / BK;
    unsigned voffA[2], voffB[2];
#pragma unroll
    for (int i = 0; i < 2; ++i) { int R, C; stage_rc(tid * 16 + i * 8192, R, C); const int Rb = Epi::PERM ? ((R & ~31) + perm32(R & 31)) : R;
        voffA[i] = (unsigned)(R * K + C) * 2u; voffB[i] = (unsigned)(Rb * K + C) * 2u; }
    const size_t kstep = (size_t)(BK * 2);
    const size_t hstep = (size_t)HALF * K * 2;
    const size_t tstep = 2 * hstep;
    const unsigned ldsw = (unsigned)wid * 1024u;
    const int aoff = lds_byte(wr * 64 + fr, fq * 8), boff = lds_byte(wc * 32 + fr, fq * 8);
#define PG8_SA(b, h) (((b) * 2 + (h)) * HTB)
#define PG8_SB(b, h) ((4 + (b) * 2 + (h)) * HTB)
#define PG8_STAGE(bufoff, gbase, voff) do { _Pragma("unroll") for (int _i = 0; _i < 2; ++_i) \
        __builtin_amdgcn_global_load_lds((const unsigned*)((const char*)(gbase) + (voff)[_i]), (PG8_LAS unsigned*)(lds + (bufoff) + ldsw + _i * 8192), 16, 0, 0); } while (0)
#define PG8_LDA(dst, b, h) do { _Pragma("unroll") for (int m = 0; m < 4; ++m) _Pragma("unroll") for (int k = 0; k < 2; ++k) dst[m][k] = *(const PG8_LAS bf16x8*)(lds + PG8_SA(b, h) + aoff + m * 2048 + k * 1024); } while (0)
#define PG8_LDB(dst, b, h) do { _Pragma("unroll") for (int n = 0; n < 2; ++n) _Pragma("unroll") for (int k = 0; k < 2; ++k) dst[n][k] = *(const PG8_LAS bf16x8*)(lds + PG8_SB(b, h) + boff + n * 2048 + k * 1024); } while (0)
#define PG8_MMA(ai, bj, At, Bt) do { __builtin_amdgcn_s_setprio(1); _Pragma("unroll") for (int m = 0; m < 4; ++m) _Pragma("unroll") for (int n = 0; n < 2; ++n) _Pragma("unroll") for (int k = 0; k < 2; ++k) \
        acc[ai][bj][m][n] = __builtin_amdgcn_mfma_f32_16x16x32_bf16(Bt[n][k], At[m][k], acc[ai][bj][m][n], 0, 0, 0); __builtin_amdgcn_s_setprio(0); } while (0)
#define PG8_WAIT_V(n) asm volatile("s_waitcnt vmcnt(" #n ")" ::: "memory")
#define PG8_WAIT_L(n) asm volatile("s_waitcnt lgkmcnt(" #n ")" ::: "memory")
#define PG8_BAR __builtin_amdgcn_s_barrier()
#define PG8_SCHED __builtin_amdgcn_sched_barrier(0)
    Unit cur, nxt; int ui = 0;
    if (!S.next(0, cur)) return;
    f32x4 acc[2][2][4][2];
#pragma unroll
    for (int a = 0; a < 2; ++a)
#pragma unroll
        for (int b = 0; b < 2; ++b)
#pragma unroll
            for (int m = 0; m < 4; ++m)
#pragma unroll
                for (int n = 0; n < 2; ++n) acc[a][b][m][n] = (f32x4){0.f, 0.f, 0.f, 0.f};
    bf16x8 At[4][2], B0[2][2], B1[2][2];
    const char* cA = (const char*)g.A + (size_t)cur.pm * tstep; const char* cB = (const char*)g.Bt + (size_t)cur.pn * tstep;
    S.a_ready(cur);
    if constexpr (SP2) {
        PG8_STAGE(PG8_SB(0, 0), cB, voffB); PG8_STAGE(PG8_SB(0, 1), cB + hstep, voffB); PG8_STAGE(PG8_SA(0, 0), cA, voffA); PG8_STAGE(PG8_SA(0, 1), cA + hstep, voffA);
        if (wr == 1) PG8_BAR;
        PG8_WAIT_V(2); PG8_BAR;
        PG8_STAGE(PG8_SB(1, 0), cB + kstep, voffB); PG8_STAGE(PG8_SA(1, 0), cA + kstep, voffA); PG8_STAGE(PG8_SB(1, 1), cB + hstep + kstep, voffB);
        PG8_WAIT_V(6); PG8_BAR;
    } else {
        PG8_STAGE(PG8_SB(0, 0), cB, voffB); PG8_STAGE(PG8_SA(0, 0), cA, voffA); PG8_STAGE(PG8_SB(0, 1), cB + hstep, voffB); PG8_STAGE(PG8_SA(0, 1), cA + hstep, voffA);
        if (wr == 1) PG8_BAR;
        PG8_WAIT_V(4); PG8_BAR;
        PG8_STAGE(PG8_SB(1, 0), cB + kstep, voffB); PG8_STAGE(PG8_SA(1, 0), cA + kstep, voffA); PG8_STAGE(PG8_SB(1, 1), cB + hstep + kstep, voffB);
        PG8_WAIT_V(6); PG8_BAR;
    }
    for (;;) {
        const bool has_next = S.next(ui + 1, nxt);
        const char* nA = has_next ? (const char*)g.A + (size_t)nxt.pm * tstep : cA; const char* nB = has_next ? (const char*)g.Bt + (size_t)nxt.pn * tstep : cB;
        for (int t = 0; t < nt; t += 2) {
            const bool last = (t == nt - 2);
            const char* a1 = cA + (size_t)(t + 1) * kstep;
            const char* a2 = last ? nA : cA + (size_t)(t + 2) * kstep; const char* b2 = last ? nB : cB + (size_t)(t + 2) * kstep;
            const char* a3 = a2 + kstep; const char* b3 = b2 + kstep;
            if (last && has_next) S.a_ready(nxt);
            if constexpr (SP2) {
            PG8_LDB(B0, 0, 0); PG8_LDB(B1, 0, 1); PG8_SCHED; PG8_LDA(At, 0, 0); PG8_STAGE(PG8_SA(1, 1), a1 + hstep, voffA);
            PG8_WAIT_V(8); PG8_WAIT_L(0); PG8_BAR; PG8_MMA(0, 0, At, B0); PG8_MMA(0, 1, At, B1); PG8_BAR; PG8_SCHED;
            PG8_LDA(At, 0, 1); PG8_STAGE(PG8_SB(0, 0), b2, voffB); PG8_STAGE(PG8_SB(0, 1), b2 + hstep, voffB); PG8_STAGE(PG8_SA(0, 0), a2, voffA);
            PG8_WAIT_V(8); PG8_WAIT_L(0); PG8_BAR; PG8_MMA(1, 0, At, B0); PG8_MMA(1, 1, At, B1); PG8_BAR; PG8_SCHED;
            PG8_LDB(B0, 1, 0); PG8_LDB(B1, 1, 1); PG8_SCHED; PG8_LDA(At, 1, 0); PG8_STAGE(PG8_SA(0, 1), a2 + hstep, voffA);
            PG8_WAIT_V(8); PG8_WAIT_L(0); PG8_BAR; PG8_MMA(0, 0, At, B0); PG8_MMA(0, 1, At, B1); PG8_BAR; PG8_SCHED;
            PG8_LDA(At, 1, 1); PG8_STAGE(PG8_SB(1, 0), b3, voffB); PG8_STAGE(PG8_SB(1, 1), b3 + hstep, voffB); PG8_STAGE(PG8_SA(1, 0), a3, voffA);
            PG8_WAIT_V(8); PG8_WAIT_L(0); PG8_BAR; PG8_MMA(1, 0, At, B0); PG8_MMA(1, 1, At, B1); PG8_BAR; PG8_SCHED;
            } else {
            PG8_LDB(B0, 0, 0); PG8_SCHED; PG8_LDA(At, 0, 0); PG8_STAGE(PG8_SA(1, 1), a1 + hstep, voffA);
            PG8_WAIT_L(8); PG8_BAR; PG8_WAIT_L(0); PG8_MMA(0, 0, At, B0); PG8_BAR; PG8_SCHED;
            PG8_LDB(B1, 0, 1); PG8_STAGE(PG8_SB(0, 0), b2, voffB);
            PG8_BAR; PG8_WAIT_L(0); PG8_MMA(0, 1, At, B1); PG8_BAR;
            PG8_LDA(At, 0, 1); PG8_STAGE(PG8_SA(0, 0), a2, voffA);
            PG8_BAR; PG8_WAIT_L(0); PG8_MMA(1, 0, At, B0); PG8_BAR; PG8_SCHED;
            PG8_STAGE(PG8_SB(0, 1), b2 + hstep, voffB);
            PG8_WAIT_V(6); PG8_BAR; PG8_MMA(1, 1, At, B1); PG8_BAR;
            PG8_LDB(B0, 1, 0); PG8_SCHED; PG8_LDA(At, 1, 0); PG8_STAGE(PG8_SA(0, 1), a2 + hstep, voffA);
            PG8_WAIT_L(8); PG8_BAR; PG8_WAIT_L(0); PG8_MMA(0, 0, At, B0); PG8_BAR; PG8_SCHED;
            PG8_LDB(B1, 1, 1); PG8_STAGE(PG8_SB(1, 0), b3, voffB);
            PG8_BAR; PG8_WAIT_L(0); PG8_MMA(0, 1, At, B1); PG8_BAR;
            PG8_LDA(At, 1, 1); PG8_STAGE(PG8_SA(1, 0), a3, voffA);
            PG8_BAR; PG8_WAIT_L(0); PG8_MMA(1, 0, At, B0); PG8_BAR; PG8_SCHED;
            PG8_STAGE(PG8_SB(1, 1), b3 + hstep, voffB);
            PG8_WAIT_V(6); PG8_BAR; PG8_MMA(1, 1, At, B1); PG8_BAR;
            }
        }
        if constexpr (ALIGN_EPI) { if (wr == 0) PG8_BAR; }
        if constexpr (!Epi::AFTER_DRAIN) { E(acc, cur, wr, wc, fr, fq); S.done(cur); }
        if (!has_next) break;
#pragma unroll
        for (int a = 0; a < 2; ++a)
#pragma unroll
            for (int b = 0; b < 2; ++b)
#pragma unroll
                for (int m = 0; m < 4; ++m)
#pragma unroll
                    for (int n = 0; n < 2; ++n) acc[a][b][m][n] = (f32x4){0.f, 0.f, 0.f, 0.f};
        cur = nxt; cA = nA; cB = nB; ++ui;
        if constexpr (ALIGN_EPI) { if (wr == 1) PG8_BAR; }
    }
    PG8_WAIT_V(0);
    if constexpr (!ALIGN_EPI) { if (wr == 0) PG8_BAR; }
    PG8_BAR;
    if constexpr (Epi::AFTER_DRAIN) { E.fused(acc, cur, wr, wc, fr, fq, lds, wid, lane); S.done(cur); }
#undef PG8_SA
#undef PG8_SB
#undef PG8_STAGE
#undef PG8_LDA
#undef PG8_LDB
#undef PG8_MMA
#undef PG8_WAIT_V
#undef PG8_WAIT_L
#undef PG8_BAR
#undef PG8_SCHED
}
}
namespace attn_body {
using bf16=__hip_bfloat16;
using bf16x8=__attribute__((ext_vector_type(8)))short;
using s16x4=__attribute__((ext_vector_type(4)))short;
using f32x16=__attribute__((ext_vector_type(16)))float;
using u32x4=__attribute__((ext_vector_type(4)))unsigned;
constexpr int BATCH=4,NHEAD=8,SEQ=4096,D=64,PQ=3072,PO=1024;
typedef float f32x4_t __attribute__((ext_vector_type(4)));
__device__ __forceinline__ int lane_now(){int l;asm volatile("v_mbcnt_lo_u32_b32 %0, -1, 0\n\tv_mbcnt_hi_u32_b32 %0, -1, %0":"=v"(l));return l;}
constexpr int NW=8,QBLK=32,QB=QBLK*NW,KVBLK=64,NQB=SEQ/QB;
constexpr int ATTN_UNIT_ROWS=QB;
__device__ __forceinline__ int crow(int r,int hi){return (r&3)+8*(r>>2)+4*hi;}
#define SBAR() __builtin_amdgcn_sched_barrier(0)
__device__ __forceinline__ void cmask(f32x16&p0,f32x16&p1,int jb,int qrel,int hi){
  const float NEG=-INFINITY; int kb=64*jb+4*hi;
  #pragma unroll
  for(int r=0;r<16;++r){int kv=kb+(r&3)+8*(r>>2); if(kv>qrel)p0[r]=NEG; if(kv+32>qrel)p1[r]=NEG;}
}

constexpr int NSLOT=3, SLOTB=8192;
constexpr int LDS_K=0, LDS_V=NSLOT*SLOTB, LDS_WS=2*NSLOT*SLOTB, LDS_OST=LDS_WS+NW*64*4, LDS_BYTES=LDS_OST+NW*4096;
constexpr float C2=0.125f*1.4426950408889634f;
__device__ __forceinline__ void glds16(const void*gsrc,unsigned lds_dst){unsigned keep;
  asm volatile("s_mov_b32 %0, m0\n\ts_mov_b32 m0, %2\n\ts_nop 0\n\tglobal_load_lds_dwordx4 %1, off\n\ts_mov_b32 m0, %0":"=&s"(keep):"v"(gsrc),"s"(lds_dst):"memory");}
__device__ __forceinline__ float max3f(float a,float b,float c){float r;asm("v_max3_f32 %0, %1, %2, %3":"=v"(r):"v"(a),"v"(b),"v"(c));return r;}
__device__ __forceinline__ float max2f(float a,float b){float r;asm("v_max_f32_e32 %0, %1, %2":"=v"(r):"v"(a),"v"(b));return r;}
__device__ __forceinline__ float fadd_s(float a,float b){float r;asm("v_add_f32_e32 %0, %1, %2":"=v"(r):"v"(a),"v"(b));return r;}
__device__ __forceinline__ float fsub_s(float a,float b){float r;asm("v_sub_f32_e32 %0, %1, %2":"=v"(r):"v"(a),"v"(b));return r;}
typedef float f32x2_t __attribute__((ext_vector_type(2))); typedef __bf16 bf16x2_t __attribute__((ext_vector_type(2)));
__device__ __forceinline__ unsigned cvtpk_s(float lo,float hi){f32x2_t v={lo,hi};bf16x2_t b=__builtin_convertvector(v,bf16x2_t);return __builtin_bit_cast(unsigned,b);}
#define WAIT_BAR(N) asm volatile("s_waitcnt vmcnt(" #N ") lgkmcnt(0)\n\ts_barrier":::"memory")

__device__ __forceinline__ void qkt(f32x16&p0,f32x16&p1,const char*Kslot,const bf16x8*qr,int r32,int hi){ const f32x16 negm=f32x16{};
  const char*kb=Kslot+hi*1024+r32*16;
  #pragma unroll
  for(int d0=0;d0<4;++d0){
    const bf16x8 b0=*reinterpret_cast<const bf16x8*>(kb+d0*2048);
    const bf16x8 b1=*reinterpret_cast<const bf16x8*>(kb+d0*2048+512);
    if(d0==0){p0=__builtin_amdgcn_mfma_f32_32x32x16_bf16(b0,qr[0],negm,0,0,0);p1=__builtin_amdgcn_mfma_f32_32x32x16_bf16(b1,qr[0],negm,0,0,0);}
    else{p0=__builtin_amdgcn_mfma_f32_32x32x16_bf16(b0,qr[d0],p0,0,0,0);p1=__builtin_amdgcn_mfma_f32_32x32x16_bf16(b1,qr[d0],p1,0,0,0);}}
}
typedef __attribute__((address_space(3))) const char* lds_cptr;
typedef short v4i16_t __attribute__((ext_vector_type(4)));
__device__ __forceinline__ void kload8(bf16x8*kf,lds_cptr kp){
  kf[0]=*(const __attribute__((address_space(3))) bf16x8*)(kp);      kf[1]=*(const __attribute__((address_space(3))) bf16x8*)(kp+512);
  kf[2]=*(const __attribute__((address_space(3))) bf16x8*)(kp+2048); kf[3]=*(const __attribute__((address_space(3))) bf16x8*)(kp+2560);
  kf[4]=*(const __attribute__((address_space(3))) bf16x8*)(kp+4096); kf[5]=*(const __attribute__((address_space(3))) bf16x8*)(kp+4608);
  kf[6]=*(const __attribute__((address_space(3))) bf16x8*)(kp+6144); kf[7]=*(const __attribute__((address_space(3))) bf16x8*)(kp+6656);
}
__device__ __forceinline__ void kload2(bf16x8*kf,lds_cptr kp,int j){ kf[2*j]=*(const __attribute__((address_space(3))) bf16x8*)(kp+j*2048); kf[2*j+1]=*(const __attribute__((address_space(3))) bf16x8*)(kp+j*2048+512); }
__device__ __forceinline__ s16x4 vtr(lds_cptr p){ return __builtin_bit_cast(s16x4,__builtin_amdgcn_ds_read_tr16_b64_v4i16((__attribute__((address_space(3))) v4i16_t*)p)); }
__device__ __forceinline__ float rowmax(const f32x16&p0,const f32x16&p1){
  float a=max3f(p0[0],p0[1],p1[0]),b=max3f(p0[2],p0[3],p1[1]);a=max3f(a,p1[2],p1[3]);
  #pragma unroll
  for(int r=4;r<16;r+=4){a=max3f(a,p0[r],p0[r+1]);b=max3f(b,p0[r+2],p0[r+3]);a=max3f(a,p1[r],p1[r+1]);b=max3f(b,p1[r+2],p1[r+3]);}
  const float m=max2f(a,b);
  auto rr=__builtin_amdgcn_permlane32_swap(__float_as_uint(m),__float_as_uint(m),false,false);
  return max2f(__uint_as_float(rr[0]),__uint_as_float(rr[1]));
}
__device__ __forceinline__ void pv(f32x16*o,int vb,bf16x8 pa0,bf16x8 pa1,bf16x8 pa2,bf16x8 pa3){
  #pragma unroll
  for(int d0=0;d0<2;++d0){s16x4 lo[4],hi[4];
    #pragma unroll
    for(int ks=0;ks<4;++ks){
      asm volatile("ds_read_b64_tr_b16 %0,%1 offset:%c2":"=&v"(lo[ks]):"v"(vb),"i"(d0*4096+ks*1024):"memory");
      asm volatile("ds_read_b64_tr_b16 %0,%1 offset:%c2":"=&v"(hi[ks]):"v"(vb),"i"(d0*4096+ks*1024+512):"memory");}
    asm volatile("s_waitcnt lgkmcnt(0)":::"memory");SBAR();
    #define PK(k) (bf16x8){lo[k][0],lo[k][1],lo[k][2],lo[k][3],hi[k][0],hi[k][1],hi[k][2],hi[k][3]}
    o[d0]=__builtin_amdgcn_mfma_f32_32x32x16_bf16(pa0,PK(0),o[d0],0,0,0);
    o[d0]=__builtin_amdgcn_mfma_f32_32x32x16_bf16(pa1,PK(1),o[d0],0,0,0);
    o[d0]=__builtin_amdgcn_mfma_f32_32x32x16_bf16(pa2,PK(2),o[d0],0,0,0);
    o[d0]=__builtin_amdgcn_mfma_f32_32x32x16_bf16(pa3,PK(3),o[d0],0,0,0);
    #undef PK
  }
}

#ifndef ATTN_STORE16
#define ATTN_STORE16(p,v) (*(u32x4*)(p)=(v))
#endif
template<int THRL> __device__ __forceinline__ void attn_unit(int b,int h,int qb,const bf16*Q,const bf16*__restrict__ K,const bf16*__restrict__ V,bf16*O,char*shm,const char*cs,int t0){
  const int tid=pg8::tid_now(),lane=tid&63,r32=lane&31,hi=lane>>5; const int wid=__builtin_amdgcn_readfirstlane(tid>>6);
  const long rowbase=(long)b*SEQ; const int q0=qb*QB;
  const bf16*Qw=Q+(rowbase+q0+wid*QBLK)*PQ+h*D;
  const bf16*Kh=K+(rowbase+(long)t0*KVBLK)*PQ+h*D,*Vh=V+(rowbase+(long)t0*KVBLK)*PQ+h*D;
  const unsigned lds0=(unsigned)(uintptr_t)shm;
  float*wsf=(float*)(shm+LDS_WS)+wid*64;
  const bf16*ksrc=Kh+(long)lane*PQ+wid*8;
  const bf16*vsrc=Vh+(long)(16*(wid&3)+(lane>>2))*PQ+(wid>>2)*32+(lane&3)*8;
  const unsigned kdst=lds0+LDS_K+wid*1024, vdst=lds0+LDS_V+wid*1024;
  #define DMA_K(t,slot) glds16(ksrc+(long)(t)*KVBLK*PQ,(unsigned)__builtin_amdgcn_readfirstlane(kdst+(slot)))
  #define DMA_V(t,slot) glds16(vsrc+(long)(t)*KVBLK*PQ,(unsigned)__builtin_amdgcn_readfirstlane(vdst+(slot)))
  const int vb0=(int)(lds0+LDS_V)+((lane>>4)&1)*32+(lane&3)*8+(4*hi+((lane&15)>>2))*64;
  const char*Kbase=shm+LDS_K; bf16x8 kf[8];
  const lds_cptr shm3=(lds_cptr)shm; const lds_cptr kp0=shm3+LDS_K+hi*1024+r32*16; const lds_cptr vp0=shm3+LDS_V+((lane>>4)&1)*32+(lane&3)*8+(4*hi+((lane&15)>>2))*64;
  const int NT=(q0+QB)/KVBLK-t0;
  DMA_K(0,0);DMA_V(0,0);DMA_K(1,SLOTB);
  bf16x8 qr[4];
  #pragma unroll
  for(int d0=0;d0<4;++d0)qr[d0]=*reinterpret_cast<const bf16x8*>(&Qw[(long)r32*PQ+d0*16+hi*8]);
  float mhat=0.f,l_reg=0.f;f32x16 o[2];o[0]=f32x16{};o[1]=f32x16{};const f32x16 zero16=f32x16{};
  const int qrel=wid*QBLK+r32;
  #define CMASK(P0,P1,t) do{int jb_=(t)-(NT-4); if(jb_>=0)cmask(P0,P1,jb_,qrel,hi);}while(0)
  const lds_cptr csb=(lds_cptr)cs+hi*16+t0*256;
  #define BIAS(P0,P1,t) do{ const __attribute__((address_space(3))) f32x4_t* cb_=(const __attribute__((address_space(3))) f32x4_t*)(csb+(t)*256); const float nm_=-mhat; \
    _Pragma("unroll") for(int g_=0;g_<4;++g_){ const f32x4_t v0_=cb_[2*g_]+nm_; \
      P0[4*g_]+=v0_[0];P0[4*g_+1]+=v0_[1];P0[4*g_+2]+=v0_[2];P0[4*g_+3]+=v0_[3]; if(g_&1)SBAR(); } \
    _Pragma("unroll") for(int g_=0;g_<4;++g_){ const f32x4_t v1_=cb_[8+2*g_]+nm_; \
      P1[4*g_]+=v1_[0];P1[4*g_+1]+=v1_[1];P1[4*g_+2]+=v1_[2];P1[4*g_+3]+=v1_[3]; if(g_&1)SBAR(); } }while(0)
  bool resc=false;
  #define START(P0,P1) do{ const float rm=rowmax(P0,P1); resc=false; \
    { const float dl=rm; mhat=fadd_s(mhat,dl); \
      _Pragma("unroll") for(int r=0;r<16;++r){P0[r]=fsub_s(P0[r],dl);P1[r]=fsub_s(P1[r],dl);} \
    } \
    _Pragma("unroll") for(int r=0;r<16;++r)P0[r]=__builtin_amdgcn_exp2f(P0[r]); }while(0)
  #define RESC() do{ if(resc){ asm volatile("s_waitcnt lgkmcnt(0)":::"memory"); \
      _Pragma("unroll") for(int d_=0;d_<2;++d_) _Pragma("unroll") for(int r=0;r<16;++r)o[d_][r]*=wsf[crow(r,hi)]; } }while(0)
  f32x16 pA0,pA1,pB0,pB1;
  int sl_prev=0,sl_cur=0,sl_next=SLOTB;
  #define ROT() do{sl_prev=sl_cur;sl_cur=sl_next;sl_next=(sl_next==(NSLOT-1)*SLOTB)?0:sl_next+SLOTB;}while(0)
  DMA_K(2,2*SLOTB);
  WAIT_BAR(3);
  qkt(pA0,pA1,Kbase,qr,r32,hi);asm volatile("s_nop 15\n\ts_nop 7":"+v"(pA0),"+v"(pA1));BIAS(pA0,pA1,0);CMASK(pA0,pA1,0);
  START(pA0,pA1);
  _Pragma("unroll") for(int r=0;r<16;++r)pA1[r]=__builtin_amdgcn_exp2f(pA1[r]);
  WAIT_BAR(0);
  DMA_K(3,0);DMA_V(1,SLOTB);
  ROT();
  kload8(kf,kp0+sl_cur);
  WAIT_BAR(2);
  s16x4 vlo[8],vhi[8]; u32x4 pw0,pw1,pw2,pw3;
  #define PKW(P,B) cvtpk_s(P[B],P[B+1])
  #define PAF(k) __builtin_bit_cast(bf16x8,pw##k)
  #define VFR(i) (bf16x8){vlo[i][0],vlo[i][1],vlo[i][2],vlo[i][3],vhi[i][0],vhi[i][1],vhi[i][2],vhi[i][3]}
  #define PIN(x) asm volatile("":"+v"(x))
  #define MX3(a,b,c) __builtin_fmaxf(__builtin_fmaxf((a),(b)),(c))
  #define GAPA(MF,A0,A1,A2,A3,W0,W1,PW) do{ MF; sacc+=A0; sacc+=A1; sacc+=A2; sacc+=A3; PIN(sacc); W0; W1; PIN(PW); SBAR(); }while(0)
  #define EX(v) __builtin_amdgcn_exp2f(v)
  #define GAPB(MF,X,B) do{ MF; X[B]=EX(X[B]); X[B+1]=EX(X[B+1]); X[B+2]=EX(X[B+2]); X[B+3]=EX(X[B+3]); PIN(X); SBAR(); }while(0)
  #define VRD(i) do{ vlo[i]=vtr(vp_+(((i)>>2)*4096+((i)&3)*1024)); vhi[i]=vtr(vp_+(((i)>>2)*4096+((i)&3)*1024+512)); }while(0)
  #define KRD(G,j) do{ if(G){ kload2(kf,kp0+sl_next,j); SBAR(); } }while(0)
  #define STEP(C0,C1,P0,P1,t,GK,GV,GL) do{ SBAR(); \
    const lds_cptr vp_=vp0+sl_prev; \
    VRD(0); SBAR(); float sacc=(P0[0]+P0[1]); \
    GAPA(C0=__builtin_amdgcn_mfma_f32_32x32x16_bf16(kf[0],qr[0],zero16,0,0,0), P0[2],P0[3],P0[4],P0[5],     pw0[0]=PKW(P0,0), pw0[1]=PKW(P0,2), pw0); \
    VRD(4); SBAR(); GAPA(C1=__builtin_amdgcn_mfma_f32_32x32x16_bf16(kf[1],qr[0],zero16,0,0,0), P0[6],P0[7],P0[8],P0[9],     pw0[2]=PKW(P0,4), pw0[3]=PKW(P0,6), pw0); \
    VRD(1); SBAR(); GAPA(C0=__builtin_amdgcn_mfma_f32_32x32x16_bf16(kf[2],qr[1],C0,0,0,0),   P0[10],P0[11],P0[12],P0[13], pw1[0]=PKW(P0,8), pw1[1]=PKW(P0,10), pw1); \
    VRD(5); SBAR(); GAPA(C1=__builtin_amdgcn_mfma_f32_32x32x16_bf16(kf[3],qr[1],C1,0,0,0),   P0[14],P0[15],P1[0],P1[1],   pw1[2]=PKW(P0,12),pw1[3]=PKW(P0,14), pw1); \
    VRD(2); SBAR(); GAPA(C0=__builtin_amdgcn_mfma_f32_32x32x16_bf16(kf[4],qr[2],C0,0,0,0),   P1[2],P1[3],P1[4],P1[5],     pw2[0]=PKW(P1,0), pw2[1]=PKW(P1,2), pw2); \
    VRD(6); SBAR(); GAPA(C1=__builtin_amdgcn_mfma_f32_32x32x16_bf16(kf[5],qr[2],C1,0,0,0),   P1[6],P1[7],P1[8],P1[9],     pw2[2]=PKW(P1,4), pw2[3]=PKW(P1,6), pw2); \
    VRD(3); SBAR(); GAPA(C0=__builtin_amdgcn_mfma_f32_32x32x16_bf16(kf[6],qr[3],C0,0,0,0),   P1[10],P1[11],P1[12],P1[13], pw3[0]=PKW(P1,8), pw3[1]=PKW(P1,10), pw3); \
    VRD(7); SBAR(); GAPA(C1=__builtin_amdgcn_mfma_f32_32x32x16_bf16(kf[7],qr[3],C1,0,0,0),   P1[14],P1[15],0.f,0.f,       pw3[2]=PKW(P1,12),pw3[3]=PKW(P1,14), pw3); \
    l_reg+=sacc; \
    if(GK){DMA_K((t)+3,sl_cur);} if(GV){DMA_V((t)+1,sl_next);} \
    BIAS(C0,C1,t); CMASK(C0,C1,t); \
    { float a=MX3(C0[0],C0[1],C1[0]),b=MX3(C0[2],C0[3],C1[1]); a=MX3(a,C1[2],C1[3]); \
      _Pragma("unroll") for(int r=4;r<16;r+=4){a=MX3(a,C0[r],C0[r+1]);b=MX3(b,C0[r+2],C0[r+3]);a=MX3(a,C1[r],C1[r+1]);b=MX3(b,C1[r+2],C1[r+3]);} \
      float rm=__builtin_fmaxf(a,b); { auto rr=__builtin_amdgcn_permlane32_swap(__float_as_uint(rm),__float_as_uint(rm),false,false); rm=__builtin_fmaxf(__uint_as_float(rr[0]),__uint_as_float(rr[1])); } \
      resc=false; \
      if(__builtin_expect(__any(rm>(float)THRL),0)){ const float dl=__builtin_fmaxf(rm,0.f); mhat+=dl; \
        _Pragma("unroll") for(int r=0;r<16;++r){C0[r]-=dl;C1[r]-=dl;} \
        const float f=__builtin_amdgcn_exp2f(-dl); l_reg*=f; if(hi==0)wsf[r32]=f; resc=true; } } \
    SBAR(); \
    GAPB(o[0]=__builtin_amdgcn_mfma_f32_32x32x16_bf16(PAF(0),VFR(0),o[0],0,0,0), C0,0); \
    GAPB(o[1]=__builtin_amdgcn_mfma_f32_32x32x16_bf16(PAF(0),VFR(4),o[1],0,0,0), C0,4); \
    KRD(GL,0); GAPB(o[0]=__builtin_amdgcn_mfma_f32_32x32x16_bf16(PAF(1),VFR(1),o[0],0,0,0), C0,8); \
    KRD(GL,1); GAPB(o[1]=__builtin_amdgcn_mfma_f32_32x32x16_bf16(PAF(1),VFR(5),o[1],0,0,0), C0,12); \
    KRD(GL,2); GAPB(o[0]=__builtin_amdgcn_mfma_f32_32x32x16_bf16(PAF(2),VFR(2),o[0],0,0,0), C1,0); \
    KRD(GL,3); GAPB(o[1]=__builtin_amdgcn_mfma_f32_32x32x16_bf16(PAF(2),VFR(6),o[1],0,0,0), C1,4); \
    GAPB(o[0]=__builtin_amdgcn_mfma_f32_32x32x16_bf16(PAF(3),VFR(3),o[0],0,0,0), C1,8); \
    GAPB(o[1]=__builtin_amdgcn_mfma_f32_32x32x16_bf16(PAF(3),VFR(7),o[1],0,0,0), C1,12); \
    }while(0)
  int t=1;
  #undef CMASK
  #define CMASK(P0,P1,t) do{}while(0)
  for(;t+5<NT;t+=2){
    STEP(pB0,pB1,pA0,pA1,t,true,true,true);     WAIT_BAR(2); RESC(); ROT();
    STEP(pA0,pA1,pB0,pB1,t+1,true,true,true);   WAIT_BAR(2); RESC(); ROT();
  }
  #undef CMASK
  #define CMASK(P0,P1,t) do{int jb_=(t)-(NT-4); if(jb_>=0)cmask(P0,P1,jb_,qrel,hi);}while(0)
  #define ENDW(tt) do{ if((tt)+3<NT){WAIT_BAR(2);} else if((tt)+2<NT){WAIT_BAR(1);} else {WAIT_BAR(0);} }while(0)
  for(;t+1<NT;t+=2){
    STEP(pB0,pB1,pA0,pA1,t,(t+3<NT),(t+1<NT),(t+1<NT));       ENDW(t);   RESC(); ROT();
    STEP(pA0,pA1,pB0,pB1,t+1,(t+4<NT),(t+2<NT),(t+2<NT));     ENDW(t+1); RESC(); ROT();
  }
  STEP(pB0,pB1,pA0,pA1,NT-1,false,false,false); RESC();
  { float sacc=pB0[0]+pB0[1]; _Pragma("unroll") for(int r=2;r<16;++r)sacc+=pB0[r]; _Pragma("unroll") for(int r=0;r<16;++r)sacc+=pB1[r]; l_reg+=sacc;
    pw0=(u32x4){PKW(pB0,0),PKW(pB0,2),PKW(pB0,4),PKW(pB0,6)};pw1=(u32x4){PKW(pB0,8),PKW(pB0,10),PKW(pB0,12),PKW(pB0,14)};pw2=(u32x4){PKW(pB1,0),PKW(pB1,2),PKW(pB1,4),PKW(pB1,6)};pw3=(u32x4){PKW(pB1,8),PKW(pB1,10),PKW(pB1,12),PKW(pB1,14)};
    SBAR(); pv(o,vb0+sl_cur,PAF(0),PAF(1),PAF(2),PAF(3)); }
  #undef PKW
  #undef PAF
  #undef VFR
  #undef PIN
  #undef MX3
  #undef GAPA
  #undef GAPB
  #undef EX
  #undef VRD
  #undef KRD
  #undef STEP
  #undef ENDW
  {auto rr=__builtin_amdgcn_permlane32_swap(__float_as_uint(l_reg),__float_as_uint(l_reg),false,false);l_reg=__uint_as_float(rr[0])+__uint_as_float(rr[1]);}
  if(hi==0)wsf[32+r32]=l_reg;asm volatile("s_waitcnt lgkmcnt(0)":::"memory");
  float rli[16];
  #pragma unroll
  for(int r=0;r<16;++r)rli[r]=__builtin_amdgcn_rcpf(wsf[32+crow(r,hi)]);
  bf16*Ow=O+(rowbase+q0+wid*QBLK)*PO+h*D;
  { bf16*stg=(bf16*)(shm+LDS_OST)+wid*2048;
    #pragma unroll
    for(int r=0;r<16;++r){const int orow=crow(r,hi);
      #pragma unroll
      for(int d0=0;d0<2;++d0)stg[orow*64+d0*32+r32]=__float2bfloat16(o[d0][r]*rli[r]);}
    asm volatile("s_waitcnt lgkmcnt(0)":::"memory");
    const int le_=lane_now();
    #pragma unroll
    for(int i=0;i<4;++i){const int row=i*8+(le_>>3),ch=le_&7; const u32x4 v=*(const u32x4*)(stg+row*64+ch*8); ATTN_STORE16(Ow+(long)row*PO+ch*8,v);} }
  asm volatile("s_waitcnt lgkmcnt(0)\n\ts_barrier":::"memory");
  #undef BIAS
  #undef DMA_K
  #undef DMA_V
  #undef CMASK
  #undef START
  #undef RESC
  #undef ROT
}
constexpr int ATTN_LDS_BYTES=LDS_BYTES;
#undef SBAR
#undef WAIT_BAR
}

#ifndef MK_ONE_LAUNCH
#define MK_ONE_LAUNCH 1
#endif
constexpr int NWAVES = 8, NTHR = NWAVES * 64;
constexpr int Bsz = 4, S = 4096, T = Bsz * S, DM = 1024, NL = 2;
constexpr int NCH = S / 64;
constexpr int C_XA = 0, C_GA = 256, C_Q = 512, C_K = 1024, C_V = 1536, C_FL = 2048, C_P = 2056;
constexpr int C_R = C_P, C_RK = C_P + 256, C_RV = C_P + 512, C_WD = C_P + 768, C_AD = C_P + 800, C_GD = C_P + 832, DIN = C_P + 896, NP = 3072, RCOLS = 896;
constexpr int NE = 16, DE = 256, MAXTILES = 144;
constexpr float L2E = 1.4426950408889634f;
constexpr int NPH = 10;
enum { PH_PRE = 0, PH_GIN, PH_PREP, PH_MIX, PH_POST, PH_GOUT, PH_ROUTE, PH_PLACE, PH_MOE1, PH_MOE2 };
constexpr int PH_FIN = NL * NPH, N_PHASES = PH_FIN + 1;
enum { I_X = 0, I_N1G, I_WIN, I_CONVW, I_CONVB, I_WA, I_BA, I_WX, I_BX, I_LAM, I_LNG, I_FB, I_QNG, I_KNG, I_FNG, I_MU, I_W0, I_W2, I_A0, I_A2, I_G2, I_KK, I_KA, I_RK, I_RLG, I_RLB,
       I_WOUT, I_N2G, I_RGW, I_RGB, I_REW, I_REB, I_EG, I_EU, I_ED, N_IN };

constexpr size_t MiB = 1u << 20;
constexpr size_t WS_CTL = 0, CTL_ZERO_BYTES = 1 * MiB;
constexpr size_t WS_WRH = 1 * MiB, WS_WRL = WS_WRH + 64 * 1024;
constexpr size_t WS_WIN = 2 * MiB, WS_WOUT = 8 * MiB, WS_WGU = 10 * MiB, WS_WD = 26 * MiB;
constexpr size_t WS_H = 34 * MiB;
constexpr size_t WS_PROJ = 66 * MiB;
constexpr size_t WS_Y = 162 * MiB;
constexpr size_t WS_HLOC = 194 * MiB, WS_CUMA = 202 * MiB;
constexpr size_t WS_ORAW = 210 * MiB;
constexpr size_t WS_G = 226 * MiB, WS_VS = 234 * MiB;
constexpr size_t WS_CLOC = 242 * MiB, WS_BON = WS_CLOC + 512 * 1024, WS_AAGG = WS_BON + 256 * 1024, WS_HAGG = WS_AAGG + 256 * 1024, WS_CTOT = WS_HAGG + 256 * 1024;
constexpr size_t WS_TOKE = 244 * MiB, WS_TOKW = WS_TOKE + 128 * 1024, WS_TSLOT = WS_TOKW + 128 * 1024;
constexpr size_t WS_ASORT = 66 * MiB, WS_HID = 138 * MiB, WS_STOK = 156 * MiB, WS_SW = 157 * MiB;
constexpr size_t WS_TR = WS_TSLOT + 128 * 1024, WS_SR = WS_SW + 512 * 1024;
constexpr size_t WS_YE = WS_ASORT;
constexpr size_t WS_END = 256 * MiB;
static_assert(WS_ASORT + (size_t)MAXTILES * 256 * 1024 * 2 <= WS_HID && WS_HID + (size_t)MAXTILES * 256 * 256 * 2 <= WS_STOK && WS_SW + MAXTILES * 256 * 4 <= WS_Y, "MoE overlay");
static_assert(WS_PROJ + (size_t)T * NP * 2 <= WS_Y && WS_CTOT + 4 * 64 * 8 * 4 <= WS_TOKE && WS_TR + 64 * 1024 <= WS_END && WS_SR + MAXTILES * 256 * 4 <= WS_Y, "d_ws map");

constexpr int CW_TMO = 0;
constexpr int CW_BAR = 4096;
constexpr int CW_CNT0 = 8192, CW_CUR0 = 8192 + 64, CW_Q0 = 8192 + 128, CW_LSTRIDE = 256;

constexpr int LDS_BYTES = 160 * 1024;
constexpr int MISC_OFF = LDS_BYTES - 256;
constexpr int LDS_TAB = 131072;

#define GAS __attribute__((address_space(1)))
#define LAS __attribute__((address_space(3)))
typedef unsigned short bf16;
typedef unsigned v4u __attribute__((ext_vector_type(4)));
typedef unsigned v2u __attribute__((ext_vector_type(2)));
typedef float f32x4 __attribute__((ext_vector_type(4)));
typedef GAS unsigned gu32;
#define RLX_AGENT __ATOMIC_RELAXED, __HIP_MEMORY_SCOPE_AGENT
typedef float f32x2_ __attribute__((ext_vector_type(2))); typedef __bf16 bf16x2_ __attribute__((ext_vector_type(2)));
__device__ __forceinline__ unsigned pk2(float lo, float hi) { f32x2_ v = {lo, hi}; bf16x2_ b = __builtin_convertvector(v, bf16x2_); return __builtin_bit_cast(unsigned, b); }
__device__ __forceinline__ unsigned f2bf(float f) { return pk2(f, 0.f) & 0xffffu; }
__device__ __forceinline__ float bf2f(bf16 v) { return __builtin_bit_cast(float, (unsigned)v << 16); }
__device__ __forceinline__ float bflo(unsigned w) { return __builtin_bit_cast(float, w << 16); }
__device__ __forceinline__ float bfhi(unsigned w) { return __builtin_bit_cast(float, w & 0xffff0000u); }
__device__ __forceinline__ float sigmoidf_(float x) { return 1.f / (1.f + __expf(-x)); }
__device__ __forceinline__ float softplusf_(float x) { return fmaxf(x, 0.f) + log1pf(__expf(-fabsf(x))); }
__device__ __forceinline__ float wave_sum(float v) {
#pragma unroll
    for (int o = 1; o < 64; o <<= 1) v += __shfl_xor(v, o);
    return v;
}
#define XB_TMO      128
#define XB_XCNT(j)  (256  + 64 * (j))
#define XB_XSUB(j)  (1280 + 64 * (j))
#define XB_XGEN(j)  (2304 + 64 * (j))
#define XB_TOP      3328
#define XB_TOPGEN   3392
#define XCD_BAR_WORDS 3456
#define XB_SPIN_CAP (1u << 21)

__device__ __forceinline__ unsigned xb_ld(unsigned* p)              { return __hip_atomic_load(p, __ATOMIC_RELAXED, __HIP_MEMORY_SCOPE_AGENT); }
__device__ __forceinline__ unsigned xb_add(unsigned* p, unsigned v) { return __hip_atomic_fetch_add(p, v, __ATOMIC_RELAXED, __HIP_MEMORY_SCOPE_AGENT); }
__device__ __forceinline__ unsigned xb_xcc_id() { return (unsigned)__builtin_amdgcn_s_getreg((3 << 11) | 20) & 0xFu; }
#define XB_SPIN(cond, bar) do { unsigned _sp = 0; while (cond) { __builtin_amdgcn_s_sleep(1); \
    if ((++_sp & 255u) == 0u) { if (xb_ld(&(bar)[XB_TMO])) break; if (_sp > XB_SPIN_CAP) { atomicAdd(&(bar)[XB_TMO], 1u); break; } } } } while (0)

struct XcdBarrier {
    unsigned* bar; unsigned x;
    volatile LAS unsigned* st;
};

__device__ __forceinline__ XcdBarrier xcd_barrier_post(unsigned* bar, volatile LAS unsigned* st) {
    XcdBarrier b; b.bar = bar; b.x = xb_xcc_id(); b.st = st;
    if (threadIdx.x == 0) (void)xb_add(&bar[XB_XCNT(b.x)], 1u);
    return b;
}
__device__ __forceinline__ void xcd_barrier_complete(unsigned* bar, unsigned x, unsigned& nloc, unsigned& nx) {
    const unsigned G = gridDim.x * gridDim.y * gridDim.z;
    unsigned sum, cnt, mine, sp = 0u;
    for (;;) {
        sum = 0u; cnt = 0u; mine = 0u;
#pragma unroll
        for (unsigned j = 0; j < 16; ++j) { const unsigned c = xb_ld(&bar[XB_XCNT(j)]); sum += c; cnt += (c > 0u) ? 1u : 0u; mine = (j == x) ? c : mine; }
        if (sum == G) break;
        __builtin_amdgcn_s_sleep(1);
        if ((++sp & 255u) == 0u) { if (xb_ld(&bar[XB_TMO])) break; if (sp > XB_SPIN_CAP) { atomicAdd(&bar[XB_TMO], 1u); break; } }
    }
    nloc = mine > 0u ? mine : 1u; nx = cnt > 0u ? cnt : 1u;
}

__device__ __forceinline__ void xcd_barrier(const XcdBarrier& b) {
    asm volatile("s_waitcnt vmcnt(0)" ::: "memory");
    __syncthreads();
    if (threadIdx.x == 0) {
        unsigned* bar = b.bar;
        __builtin_amdgcn_s_waitcnt(0);
        unsigned nloc = b.st[0], nx = b.st[1];
        if (nloc == 0u) { xcd_barrier_complete(bar, b.x, nloc, nx); b.st[0] = nloc; b.st[1] = nx; }
        const unsigned old = xb_add(&bar[XB_XSUB(b.x)], 1u);
        const unsigned gen = old / nloc;
        if (old + 1u == (gen + 1u) * nloc) {
            __builtin_amdgcn_fence(__ATOMIC_RELEASE, "agent");
            asm volatile("s_waitcnt vmcnt(0)" ::: "memory");
            const unsigned og = xb_add(&bar[XB_TOP], 1u);
            const unsigned tg = og / nx;
            if (og + 1u == (tg + 1u) * nx) xb_add(&bar[XB_TOPGEN], 1u);
            else XB_SPIN(xb_ld(&bar[XB_TOPGEN]) == tg, bar);
            __builtin_amdgcn_fence(__ATOMIC_ACQUIRE, "agent");
            xb_add(&bar[XB_XGEN(b.x)], 1u);
            asm volatile("s_waitcnt vmcnt(0)" ::: "memory");
        } else {
            XB_SPIN(xb_ld(&bar[XB_XGEN(b.x)]) == gen, bar);
            __builtin_amdgcn_fence(__ATOMIC_ACQUIRE, "agent");
            asm volatile("s_waitcnt vmcnt(0)" ::: "memory");
        }
    }
    __syncthreads();
}

struct Args { const float* in[N_IN]; float* out; unsigned char* ws; int ph_lo, ph_hi; };
typedef const __attribute__((address_space(4))) Args* CA;
__device__ __forceinline__ CA args_now() { CA p = (CA)__builtin_amdgcn_kernarg_segment_ptr(); asm volatile("" : "+s"(p)); return p; }

__device__ __forceinline__ void tr_item(const float* W, int K, int N, const float* gk, bf16* WT, int row_off, int row_stride, float* scr, int item, int nblk, int lane) {
    const int kb = item / nblk, nb = item % nblk, k0 = 64 * kb, n0 = 32 * nb;
    const int nn = n0 + (lane & 31);
#pragma unroll 8
    for (int i = 0; i < 32; ++i) { const int kk = 2 * i + (lane >> 5); float v = (nn < N) ? W[(size_t)(k0 + kk) * N + nn] : 0.f; if (gk) v *= gk[k0 + kk]; scr[kk * 33 + (lane & 31)] = v; }
    asm volatile("s_waitcnt lgkmcnt(0)" ::: "memory");
    const int c = lane & 7;
#pragma unroll
    for (int j = 0; j < 4; ++j) { const int n = (lane >> 3) + 8 * j; const float* s = scr + (8 * c) * 33 + n;
        v4u o; o.x = pk2(s[0 * 33], s[1 * 33]); o.y = pk2(s[2 * 33], s[3 * 33]); o.z = pk2(s[4 * 33], s[5 * 33]); o.w = pk2(s[6 * 33], s[7 * 33]);
        *(v4u*)(WT + (size_t)(row_off + row_stride * (n0 + n)) * K + k0 + 8 * c) = o; }
    asm volatile("s_waitcnt lgkmcnt(0)" ::: "memory");
}
__device__ __forceinline__ void rms_row_to_bf16(const float* xrow, bf16* orow, int lane) {
    const f32x4* xr = (const f32x4*)xrow + lane;
    f32x4 v[4]; float s = 0.f;
#pragma unroll
    for (int j = 0; j < 4; ++j) { v[j] = xr[64 * j]; s += (v[j].x * v[j].x + v[j].y * v[j].y) + (v[j].z * v[j].z + v[j].w * v[j].w); }
    const float rstd = rsqrtf(wave_sum(s) * (1.f / DM) + 1e-6f);
    v2u* o8 = (v2u*)orow + lane;
#pragma unroll
    for (int j = 0; j < 4; ++j) { v2u o; o.x = pk2(v[j].x * rstd, v[j].y * rstd); o.y = pk2(v[j].z * rstd, v[j].w * rstd); o8[64 * j] = o; }
}
__device__ __forceinline__ void combine_row(float* xrow, const bf16* y0, const bf16* y1, bf16* orow, int lane) {
    f32x4* xr = (f32x4*)xrow + lane; const v2u* p0 = (const v2u*)y0 + lane; const v2u* p1 = (const v2u*)y1 + lane;
    f32x4 v[4]; float s = 0.f;
#pragma unroll
    for (int j = 0; j < 4; ++j) { v[j] = xr[64 * j]; const v2u q0 = p0[64 * j], q1 = p1[64 * j];
        v[j].x += bflo(q0.x) + bflo(q1.x); v[j].y += bfhi(q0.x) + bfhi(q1.x); v[j].z += bflo(q0.y) + bflo(q1.y); v[j].w += bfhi(q0.y) + bfhi(q1.y);
        xr[64 * j] = v[j]; s += (v[j].x * v[j].x + v[j].y * v[j].y) + (v[j].z * v[j].z + v[j].w * v[j].w); }
    if (orow) { const float rstd = rsqrtf(wave_sum(s) * (1.f / DM) + 1e-6f); v2u* o8 = (v2u*)orow + lane;
#pragma unroll
        for (int j = 0; j < 4; ++j) { v2u o; o.x = pk2(v[j].x * rstd, v[j].y * rstd); o.y = pk2(v[j].z * rstd, v[j].w * rstd); o8[64 * j] = o; } }
}
__device__ __forceinline__ void phase_pre(CA a, int l, unsigned char* lds, int tid) {
    const int lane = tid & 63, wave = tid >> 6;
    float* scr = (float*)lds + wave * (64 * 33);
    const int gw = blockIdx.x * NWAVES + wave, NGW = gridDim.x * NWAVES;
    bf16* WinT = (bf16*)(a->ws + WS_WIN); bf16* WoutT = (bf16*)(a->ws + WS_WOUT); bf16* WguT = (bf16*)(a->ws + WS_WGU); bf16* WdT = (bf16*)(a->ws + WS_WD);
    constexpr int I_IN = 16 * 96, I_OUT = 16 * 32, I_E = 16 * 128;
    constexpr int NITEMS = I_IN + I_OUT + 3 * I_E;
    for (int it = gw; it < NITEMS; it += NGW) {
        int r = it;
        if (r < I_IN) { tr_item(a->in[I_WIN] + (size_t)l * DM * DIN, DM, DIN, a->in[I_N1G] + l * DM, WinT, 0, 1, scr, r, 96, lane); continue; } r -= I_IN;
        if (r < I_OUT) { tr_item(a->in[I_WOUT] + (size_t)l * DM * DM, DM, DM, nullptr, WoutT, 0, 1, scr, r, 32, lane); continue; } r -= I_OUT;
        if (r < I_E) { const int e = r >> 7, rr = r & 127; tr_item(a->in[I_EG] + (size_t)(l * NE + e) * DM * DE, DM, DE, a->in[I_N2G] + l * DM, WguT + (size_t)e * 512 * DM, 0, 2, scr, rr, 8, lane); continue; } r -= I_E;
        if (r < I_E) { const int e = r >> 7, rr = r & 127; tr_item(a->in[I_EU] + (size_t)(l * NE + e) * DM * DE, DM, DE, a->in[I_N2G] + l * DM, WguT + (size_t)e * 512 * DM, 1, 2, scr, rr, 8, lane); continue; } r -= I_E;
        { const int e = r >> 7, rr = r & 127; tr_item(a->in[I_ED] + (size_t)(l * NE + e) * DE * DM, DE, DM, nullptr, WdT + (size_t)e * DM * DE, 0, 1, scr, rr, 32, lane); }
    }
    { bf16* WRH = (bf16*)(a->ws + WS_WRH); bf16* WRL = (bf16*)(a->ws + WS_WRL); const float* g2 = a->in[I_N2G] + l * DM; const float* gwp = a->in[I_RGW] + (size_t)l * DM * 4; const float* ewp = a->in[I_REW] + (size_t)l * DM * NE;
        for (int i = blockIdx.x * NTHR + tid; i < 32 * DM; i += gridDim.x * NTHR) { const int n = i >> 10, k = i & 1023;
            const float v = (n < 4) ? g2[k] * gwp[k * 4 + n] : ((n < 20) ? g2[k] * ewp[k * NE + n - 4] : 0.f); const unsigned hb = f2bf(v); WRH[i] = (bf16)hb; WRL[i] = (bf16)f2bf(v - bf2f((bf16)hb)); } }
    bf16* H = (bf16*)(a->ws + WS_H);
    if (l == 0) { for (int m = gw; m < T; m += NGW) rms_row_to_bf16(a->in[I_X] + (size_t)m * DM, H + (size_t)m * DM, lane); }
    else { const int* TS = (const int*)(a->ws + WS_TSLOT); const bf16* YE = (const bf16*)(a->ws + WS_YE);
        for (int m = gw; m < T; m += NGW) combine_row(a->out + (size_t)m * DM, YE + (size_t)TS[2 * m] * DM, YE + (size_t)TS[2 * m + 1] * DM, H + (size_t)m * DM, lane); }
}
__device__ __forceinline__ void phase_fin(CA a, int tid) {
    const int lane = tid & 63, wave = tid >> 6; const int gw = blockIdx.x * NWAVES + wave, NGW = gridDim.x * NWAVES;
    const int* TS = (const int*)(a->ws + WS_TSLOT); const bf16* YE = (const bf16*)(a->ws + WS_YE);
    for (int m = gw; m < T; m += NGW) combine_row(a->out + (size_t)m * DM, YE + (size_t)TS[2 * m] * DM, YE + (size_t)TS[2 * m + 1] * DM, nullptr, lane);
}

__device__ __forceinline__ void prep_unit(CA a, int l, int u, unsigned char* lds, int tid, bool fox = true) {
    const int b = u / NCH, c = u % NCH, t0 = c * 64; const size_t row0 = (size_t)b * S + t0;
    bf16* P = (bf16*)(a->ws + WS_PROJ);
    float* xcT = (float*)lds; float* ex = (float*)(lds + 69632); float* lfb = (float*)(lds + 71680);
    const int j = tid & 255, half = tid >> 8, hh = j >> 6, jj = j & 63;
    float xcv[32];
    {
        const float* cw = a->in[I_CONVW] + l * 4 * 256; const float cb = a->in[I_CONVB][l * 256 + j];
        const float w0 = cw[j], w1 = cw[256 + j], w2 = cw[512 + j], w3 = cw[768 + j];
        const int tb = t0 + half * 32;
        const bf16* px = P + ((size_t)b * S) * NP + C_XA + j;
        float x3 = (tb >= 3) ? bf2f(px[(size_t)(tb - 3) * NP]) : 0.f, x2 = (tb >= 2) ? bf2f(px[(size_t)(tb - 2) * NP]) : 0.f, x1 = (tb >= 1) ? bf2f(px[(size_t)(tb - 1) * NP]) : 0.f;
#pragma unroll
        for (int tt = 0; tt < 32; ++tt) { const float x0 = bf2f(px[(size_t)(tb + tt) * NP]); const float v = cb + w0 * x3 + w1 * x2 + w2 * x1 + w3 * x0;
            xcv[tt] = v; xcT[j * 68 + half * 32 + tt] = v; x3 = x2; x2 = x1; x1 = x0; }
    }
    __syncthreads();
    float aR[32], aI[32];
#pragma unroll
    for (int tt = 0; tt < 32; ++tt) { aR[tt] = 0.f; aI[tt] = 0.f; }
    {
        const float* wa = a->in[I_WA] + ((size_t)(l * 4 + hh) * 64) * 64 + jj; const float* wx = a->in[I_WX] + ((size_t)(l * 4 + hh) * 64) * 64 + jj;
#pragma unroll 2
        for (int i = 0; i < 64; ++i) { const float wai = wa[i * 64], wxi = wx[i * 64]; const f32x4* xr = (const f32x4*)(xcT + (hh * 64 + i) * 68 + half * 32);
#pragma unroll
            for (int q = 0; q < 8; ++q) { const f32x4 xv = xr[q];
                aR[4 * q] += xv.x * wai; aR[4 * q + 1] += xv.y * wai; aR[4 * q + 2] += xv.z * wai; aR[4 * q + 3] += xv.w * wai;
                aI[4 * q] += xv.x * wxi; aI[4 * q + 1] += xv.y * wxi; aI[4 * q + 2] += xv.z * wxi; aI[4 * q + 3] += xv.w * wxi; } }
    }
    {
        const float ba = a->in[I_BA][l * 256 + j], bx = a->in[I_BX][l * 256 + j], lam = a->in[I_LAM][l * 256 + j];
        const float sp = softplusf_(-lam);
        float hrun = 0.f, arun = 1.f;
#pragma unroll
        for (int tt = 0; tt < 32; ++tt) { const float r = sigmoidf_(aR[tt] + ba), ig = sigmoidf_(aI[tt] + bx); const float la = -8.f * r * sp; const float av = __expf(la);
            const float bb = sqrtf(fmaxf(-expm1f(2.f * la), 0.f)) * (ig * xcv[tt]); hrun = av * hrun + bb; arun *= av; aR[tt] = hrun; aI[tt] = arun; }
        if (half == 0) { ex[j] = hrun; ex[256 + j] = arun; }
    }
    __syncthreads();
    if (half == 1) { const float h0 = ex[j], a0 = ex[256 + j];
#pragma unroll
        for (int tt = 0; tt < 32; ++tt) { aR[tt] += aI[tt] * h0; aI[tt] *= a0; }
        ((float*)(a->ws + WS_AAGG))[(size_t)(b * NCH + c) * 256 + j] = aI[31]; ((float*)(a->ws + WS_HAGG))[(size_t)(b * NCH + c) * 256 + j] = aR[31]; }
    { bf16* HL = (bf16*)(a->ws + WS_HLOC); bf16* CA = (bf16*)(a->ws + WS_CUMA);
#pragma unroll
        for (int tt = 0; tt < 32; ++tt) { const size_t o = (row0 + half * 32 + tt) * 256 + j; HL[o] = (bf16)f2bf(aR[tt]); CA[o] = (bf16)f2bf(aI[tt]); } }
    if (fox) {
        const float* qg = a->in[I_QNG] + l * 64; const float* kg = a->in[I_KNG] + l * 64;
        for (int pass = 0; pass < 16; ++pass) { const int item = pass * 64 + (tid >> 3), sub = tid & 7; const int which = item >> 9, rem = item & 511, t = rem >> 3, h = rem & 7;
            bf16* p = P + (row0 + t) * NP + (which ? C_K : C_Q) + h * 64 + sub * 8;
            const v4u raw = *(const v4u*)p; float v[8] = {bflo(raw.x), bfhi(raw.x), bflo(raw.y), bfhi(raw.y), bflo(raw.z), bfhi(raw.z), bflo(raw.w), bfhi(raw.w)};
            float ss = 0.f;
#pragma unroll
            for (int e = 0; e < 8; ++e) ss += v[e] * v[e];
            ss += __shfl_xor(ss, 1); ss += __shfl_xor(ss, 2); ss += __shfl_xor(ss, 4);
            const float rstd = rsqrtf(ss * (1.f / 64.f) + 1e-6f) * (which ? 1.f : 0.125f * L2E);
            const float* g = (which ? kg : qg) + sub * 8;
            v4u o; o.x = pk2(v[0] * rstd * g[0], v[1] * rstd * g[1]); o.y = pk2(v[2] * rstd * g[2], v[3] * rstd * g[3]); o.z = pk2(v[4] * rstd * g[4], v[5] * rstd * g[5]); o.w = pk2(v[6] * rstd * g[6], v[7] * rstd * g[7]);
            *(v4u*)p = o; }
    }
    { const int t = tid >> 3, h = tid & 7; const float fl = bf2f(P[(row0 + t) * NP + C_FL + h]) + a->in[I_FB][l * 8 + h]; lfb[t * 8 + h] = fminf(fl, 0.f) - log1pf(__expf(-fabsf(fl))); }
    __syncthreads();
    if (tid < 8) { float run = 0.f; float* CL = (float*)(a->ws + WS_CLOC);
        for (int t = 0; t < 64; ++t) { run += lfb[t * 8 + tid]; CL[(row0 + t) * 8 + tid] = run; }
        ((float*)(a->ws + WS_CTOT))[(size_t)(b * NCH + c) * 8 + tid] = run; }
    __syncthreads();
}

constexpr int ATT_CS_OFF = 86016, ATT_CB_OFF = ATT_CS_OFF + 16384;
static_assert(attn_body::ATTN_LDS_BYTES <= ATT_CS_OFF && ATT_CB_OFF + 512 <= LDS_TAB, "attention LDS map");
__device__ __forceinline__ void attn_run(CA a, int b, int h, int qb, unsigned char* lds) {
    const int lane = attn_body::lane_now(); const int tid = __builtin_amdgcn_readfirstlane(threadIdx.x >> 6) * 64 + lane;
    float* cs = (float*)(lds + ATT_CS_OFF); float* cbase = (float*)(lds + ATT_CB_OFF);
    const float* CT = (const float*)(a->ws + WS_CTOT); const float* CL = (const float*)(a->ws + WS_CLOC);
    if (tid < 64) { const float v = CT[(size_t)(b * NCH + tid) * 8 + h]; float s = v;
#pragma unroll
        for (int o = 1; o < 64; o <<= 1) { const float n = __shfl_up(s, o); if (tid >= o) s += n; }
        cbase[tid] = s - v; }
    __syncthreads();
    const int q0 = qb * 256; const float cref = cbase[q0 >> 6] + CL[((size_t)b * S + q0) * 8 + h];
    for (int jx = tid; jx < q0 + 256; jx += NTHR) cs[jx] = (cref - (cbase[jx >> 6] + CL[((size_t)b * S + jx) * 8 + h])) * L2E;
    __syncthreads();
    int* t0w = (int*)(cbase + 64);
    if (tid < 64) { const int NT = (q0 + 256) / 64; const bool far = (tid < NT) && (cs[tid * 64 + 63] < -80.f); const int cnt = __popcll(__ballot(far)); if (tid == 0) t0w[0] = ((cnt < NT - 4) ? cnt : NT - 4) & ~1; }
    __syncthreads();
    const int t0 = t0w[0];
    const attn_body::bf16* P = (const attn_body::bf16*)(a->ws + WS_PROJ);
    attn_body::attn_unit<8>(b, h, qb, P + C_Q, P + C_K, P + C_V, (attn_body::bf16*)(a->ws + WS_Y) + 256, (char*)lds, (const char*)cs, t0);
}

typedef short bf16x8 __attribute__((ext_vector_type(8)));
constexpr int LDB = 72, MB = 64 * LDB * 2;
__device__ __forceinline__ f32x4 tile16(const unsigned char* X, int xr, const unsigned char* Y, int yr, f32x4 acc, int lane) {
    const int r = lane & 15, q = lane >> 4;
    const bf16x8 x0 = *(const bf16x8*)(X + ((xr + r) * LDB + q * 8) * 2), x1 = *(const bf16x8*)(X + ((xr + r) * LDB + 32 + q * 8) * 2);
    const bf16x8 y0 = *(const bf16x8*)(Y + ((yr + r) * LDB + q * 8) * 2), y1 = *(const bf16x8*)(Y + ((yr + r) * LDB + 32 + q * 8) * 2);
    acc = __builtin_amdgcn_mfma_f32_16x16x32_bf16(y0, x0, acc, 0, 0, 0);
    return __builtin_amdgcn_mfma_f32_16x16x32_bf16(y1, x1, acc, 0, 0, 0);
}
constexpr int R1_LRB = 0, R1_A32 = 16384, R1_WT = 32768, R1_AKRT = 52224, R1_ABRT = R1_AKRT + MB, R1_G = 70656, R1_M = 87040;
constexpr int R1_W2T = R1_WT, R1_A2T = R1_WT + 5120, R1_G2T = R1_WT + 10240;
constexpr int R1_KH = R1_M, R1_BH = R1_M + MB, R1_KT = R1_M + 2 * MB, R1_RT = R1_M + 3 * MB, R1_KTT = R1_M + 4 * MB, R1_VT = R1_M + 5 * MB, R1_BGT = R1_M + 6 * MB, R1_KGT = R1_M + 7 * MB;
constexpr int R1_AT32 = R1_A32, R1_AKKT = R1_WT, R1_W32 = R1_WT + MB, R1_GC = R1_W32 + 4096, R1_PRM = R1_GC + 256, R1_SEG = R1_PRM + 1536, R1_T32 = R1_G;
constexpr int R1_NP = R1_KH, R1_VA = R1_BH, R1_TMT = R1_KT, R1_NE0 = R1_AKKT;
static_assert(R1_M + 8 * MB <= MISC_OFF && R1_SEG + 2048 <= R1_AKRT && R1_G2T + 9216 <= R1_AKRT && R1_PRM >= R1_G2T, "rw1 LDS map");
constexpr size_t WS_RWM = WS_H, WS_RWN = WS_H + 8 * MiB, WS_RWQ = WS_H + 16 * MiB, WS_RWO = WS_H + 24 * MiB;
constexpr size_t WS_SC = WS_ORAW;

#ifndef RW1_RS
#define RW1_RS 0
#endif
#ifndef RW1_RN
#define RW1_RN 1
#endif
#define RW1_REPEAT(k) for (int rp_ = 0; rp_ < ((RW1_RS == (k)) ? RW1_RN : 1); ++rp_)
__device__ __forceinline__ void rw1_unit(CA a, int l, int ub, unsigned char* lds, int tid) {
    const int b = ub >> 6, c = ub & 63, lane = tid & 63, wave = tid >> 6;
    const size_t row0 = (size_t)b * S + c * 64;
    bf16* lrb = (bf16*)(lds + R1_LRB); float* A32 = (float*)(lds + R1_A32); float* Gm = (float*)(lds + R1_G); float* PRM = (float*)(lds + R1_PRM);
    const bf16* P = (const bf16*)(a->ws + WS_PROJ);
    const float* mu = a->in[I_MU] + l * RCOLS;
    const int mi = wave & 3, nb = (wave >> 2) * 2, r16 = lane & 15, q4 = lane >> 4;
    const int t = tid >> 3, n0 = (tid & 7) * 8; const size_t row = row0 + t;
    for (int idx = tid; idx < 64 * 128; idx += NTHR) { const int tt = idx >> 7, jx = idx & 127; const size_t o = (row0 + tt) * NP + C_WD + jx;
        const float cur = bf2f(P[o]); const float prev = (c * 64 + tt > 0) ? bf2f(P[o - NP]) : 0.f; float val = cur + (prev - cur) * mu[768 + jx];
        if (jx < 32) val = 1.f - 2.f / (1.f + __expf(2.f * val)); else if (jx >= 64) val = sigmoidf_(val);
        lrb[idx] = (bf16)f2bf(val); }
#pragma unroll 1
    for (int h = 0; h < 4; ++h) {
    const int u = (b * 4 + h) * 64 + c;
    const bool hasprev = (c * 64 + t) > 0;
    const bf16* pr = P + row * NP + C_R + h * 64 + n0;
    const v4u rc = *(const v4u*)pr, kc = *(const v4u*)(pr + 256), vc = *(const v4u*)(pr + 512);
    v4u rp = {0u, 0u, 0u, 0u}, kp_ = rp, vp = rp;
    if (hasprev) { rp = *(const v4u*)(pr - NP); kp_ = *(const v4u*)(pr - NP + 256); vp = *(const v4u*)(pr - NP + 512); }
    { bf16* w2T = (bf16*)(lds + R1_W2T); bf16* a2T = (bf16*)(lds + R1_A2T); bf16* g2T = (bf16*)(lds + R1_G2T);
        for (int idx = tid; idx < 32 * 64; idx += NTHR) { const int k = idx >> 6, n = idx & 63; w2T[n * 40 + k] = (bf16)f2bf(a->in[I_W2][(size_t)(l * 32 + k) * 256 + h * 64 + n]); a2T[n * 40 + k] = (bf16)f2bf(a->in[I_A2][(size_t)(l * 32 + k) * 256 + h * 64 + n]); }
        for (int idx = tid; idx < 64 * 64; idx += NTHR) { const int k = idx >> 6, n = idx & 63; g2T[n * 72 + k] = (bf16)f2bf(a->in[I_G2][(size_t)(l * 64 + k) * 256 + h * 64 + n]); } }
    __syncthreads();
    RW1_REPEAT(1) {
        const int tt = mi * 16 + r16;
        const bf16x8 xw = *(const bf16x8*)(lrb + tt * 128 + q4 * 8), xa = *(const bf16x8*)(lrb + tt * 128 + 32 + q4 * 8), xg0 = *(const bf16x8*)(lrb + tt * 128 + 64 + q4 * 8), xg1 = *(const bf16x8*)(lrb + tt * 128 + 96 + q4 * 8);
#pragma unroll
        for (int k2 = 0; k2 < 2; ++k2) { const int ni = nb + k2, n = ni * 16 + 4 * q4;
            const bf16x8 yw = *(const bf16x8*)(lds + R1_W2T + ((ni * 16 + r16) * 40 + q4 * 8) * 2), ya = *(const bf16x8*)(lds + R1_A2T + ((ni * 16 + r16) * 40 + q4 * 8) * 2);
            const bf16x8 yg0 = *(const bf16x8*)(lds + R1_G2T + ((ni * 16 + r16) * 72 + q4 * 8) * 2), yg1 = *(const bf16x8*)(lds + R1_G2T + ((ni * 16 + r16) * 72 + 32 + q4 * 8) * 2);
            f32x4 accw = *(const f32x4*)(a->in[I_W0] + l * 256 + h * 64 + n), acca = *(const f32x4*)(a->in[I_A0] + l * 256 + h * 64 + n), accg = {0.f, 0.f, 0.f, 0.f};
            accw = __builtin_amdgcn_mfma_f32_16x16x32_bf16(yw, xw, accw, 0, 0, 0); acca = __builtin_amdgcn_mfma_f32_16x16x32_bf16(ya, xa, acca, 0, 0, 0);
            accg = __builtin_amdgcn_mfma_f32_16x16x32_bf16(yg0, xg0, accg, 0, 0, 0); accg = __builtin_amdgcn_mfma_f32_16x16x32_bf16(yg1, xg1, accg, 0, 0, 0);
            f32x4 dec, av4;
#pragma unroll
            for (int jx = 0; jx < 4; ++jx) { dec[jx] = __expf(-__expf(-softplusf_(-accw[jx]) - 0.5f)); av4[jx] = sigmoidf_(acca[jx]); }
            *(f32x4*)(Gm + tt * 64 + n) = dec; *(f32x4*)(A32 + tt * 64 + n) = av4;
            v2u go; go.x = pk2(accg[0], accg[1]); go.y = pk2(accg[2], accg[3]); *(v2u*)((bf16*)(a->ws + WS_G) + (row0 + tt) * 256 + h * 64 + n) = go; }
    }
    __syncthreads();
    if (tid < 384) { const int q = tid >> 6, n = tid & 63, hn = h * 64 + n;
        PRM[tid] = (q == 0) ? mu[hn] : (q == 1) ? mu[256 + hn] : (q == 2) ? mu[512 + hn] : (q == 3) ? a->in[I_KK][l * 256 + hn] : (q == 4) ? a->in[I_KA][l * 256 + hn] : a->in[I_RK][l * 256 + hn]; }
    {
        float* seg = (float*)(lds + R1_SEG); const int n = tid & 63, sg = tid >> 6; float p = 1.f;
#pragma unroll
        for (int i = 0; i < 8; ++i) { p *= Gm[(sg * 8 + i) * 64 + n]; Gm[(sg * 8 + i) * 64 + n] = p; }
        seg[sg * 64 + n] = p;
        __syncthreads();
        float pre = 1.f;
        for (int s2 = 0; s2 < sg; ++s2) pre *= seg[s2 * 64 + n];
#pragma unroll
        for (int i = 0; i < 8; ++i) Gm[(sg * 8 + i) * 64 + n] *= pre;
    }
    __syncthreads();
    RW1_REPEAT(2) {
        const unsigned rcw[4] = {rc.x, rc.y, rc.z, rc.w}, kcw[4] = {kc.x, kc.y, kc.z, kc.w}, vcw[4] = {vc.x, vc.y, vc.z, vc.w};
        const unsigned rpw[4] = {rp.x, rp.y, rp.z, rp.w}, kpw[4] = {kp_.x, kp_.y, kp_.z, kp_.w}, vpw[4] = {vp.x, vp.y, vp.z, vp.w};
        float pm[6][8];
#pragma unroll
        for (int q = 0; q < 6; ++q) { const f32x4 pa = *(const f32x4*)(PRM + q * 64 + n0), pb = *(const f32x4*)(PRM + q * 64 + n0 + 4); pm[q][0] = pa.x; pm[q][1] = pa.y; pm[q][2] = pa.z; pm[q][3] = pa.w; pm[q][4] = pb.x; pm[q][5] = pb.y; pm[q][6] = pb.z; pm[q][7] = pb.w; }
        float av[8]; { const f32x4 aa = *(const f32x4*)(A32 + t * 64 + n0), ab = *(const f32x4*)(A32 + t * 64 + n0 + 4); av[0] = aa.x; av[1] = aa.y; av[2] = aa.z; av[3] = aa.w; av[4] = ab.x; av[5] = ab.y; av[6] = ab.z; av[7] = ab.w; }
        float kkv[8], kpv[8], rv[8], vv[8]; float ss = 0.f, bon = 0.f;
#pragma unroll
        for (int e = 0; e < 8; ++e) { const int w_ = e >> 1; const bool hi_ = e & 1;
            const float rcur = hi_ ? bfhi(rcw[w_]) : bflo(rcw[w_]), kcur = hi_ ? bfhi(kcw[w_]) : bflo(kcw[w_]), vcur = hi_ ? bfhi(vcw[w_]) : bflo(vcw[w_]);
            const float rprev = hi_ ? bfhi(rpw[w_]) : bflo(rpw[w_]), kprev = hi_ ? bfhi(kpw[w_]) : bflo(kpw[w_]), vprev = hi_ ? bfhi(vpw[w_]) : bflo(vpw[w_]);
            const float r = rcur + (rprev - rcur) * pm[0][e], k = kcur + (kprev - kcur) * pm[1][e], v = vcur + (vprev - vcur) * pm[2][e];
            kkv[e] = k * pm[3][e]; ss += kkv[e] * kkv[e];
            kpv[e] = k * (1.f + (av[e] - 1.f) * pm[4][e]); bon += r * kpv[e] * pm[5][e];
            rv[e] = r; vv[e] = v; }
        ss += __shfl_xor(ss, 1); ss += __shfl_xor(ss, 2); ss += __shfl_xor(ss, 4);
        bon += __shfl_xor(bon, 1); bon += __shfl_xor(bon, 2); bon += __shfl_xor(bon, 4);
        const float inv = 1.f / fmaxf(sqrtf(ss), 1e-12f);
        float kh[8], bh_[8], kt[8], rt[8], kg[8], bg[8];
#pragma unroll
        for (int e = 0; e < 8; ++e) { const int n = n0 + e; const float Gt = Gm[t * 64 + n], Gp = (t > 0) ? Gm[(t - 1) * 64 + n] : 1.f, GC = Gm[63 * 64 + n]; const float ig = 1.f / Gt;
            const float kkn = kkv[e] * inv; kh[e] = kpv[e] * ig; bh_[e] = kkn * av[e] * ig; kt[e] = kkn * Gp; rt[e] = rv[e] * Gt; kg[e] = kh[e] * GC; bg[e] = bh_[e] * GC; }
        v4u o;
        o.x = pk2(kh[0], kh[1]); o.y = pk2(kh[2], kh[3]); o.z = pk2(kh[4], kh[5]); o.w = pk2(kh[6], kh[7]); *(v4u*)(lds + R1_KH + (t * LDB + n0) * 2) = o;
        o.x = pk2(bh_[0], bh_[1]); o.y = pk2(bh_[2], bh_[3]); o.z = pk2(bh_[4], bh_[5]); o.w = pk2(bh_[6], bh_[7]); *(v4u*)(lds + R1_BH + (t * LDB + n0) * 2) = o;
        o.x = pk2(kt[0], kt[1]); o.y = pk2(kt[2], kt[3]); o.z = pk2(kt[4], kt[5]); o.w = pk2(kt[6], kt[7]); *(v4u*)(lds + R1_KT + (t * LDB + n0) * 2) = o;
        o.x = pk2(rt[0], rt[1]); o.y = pk2(rt[2], rt[3]); o.z = pk2(rt[4], rt[5]); o.w = pk2(rt[6], rt[7]); *(v4u*)(lds + R1_RT + (t * LDB + n0) * 2) = o;
#pragma unroll
        for (int e = 0; e < 8; ++e) { const int n = n0 + e;
            *(bf16*)(lds + R1_KTT + (n * LDB + t) * 2) = (bf16)f2bf(kt[e]); *(bf16*)(lds + R1_VT + (n * LDB + t) * 2) = (bf16)f2bf(vv[e]);
            *(bf16*)(lds + R1_BGT + (n * LDB + t) * 2) = (bf16)f2bf(bg[e]); *(bf16*)(lds + R1_KGT + (n * LDB + t) * 2) = (bf16)f2bf(kg[e]); }
        { v4u vo; vo.x = pk2(vv[0], vv[1]); vo.y = pk2(vv[2], vv[3]); vo.z = pk2(vv[4], vv[5]); vo.w = pk2(vv[6], vv[7]);
            *(v4u*)((bf16*)(a->ws + WS_VS) + row * 256 + h * 64 + n0) = vo;
            if ((tid & 7) == 0) ((float*)(a->ws + WS_BON))[row * 4 + h] = bon; }
    }
    __syncthreads();
    float* AT32 = (float*)(lds + R1_AT32); float* T32 = (float*)(lds + R1_T32); float* W32 = (float*)(lds + R1_W32); float* GCv = (float*)(lds + R1_GC);
    if (tid < 64) GCv[tid] = Gm[63 * 64 + tid];
    RW1_REPEAT(3)
#pragma unroll
    for (int k2 = 0; k2 < 2; ++k2) { const int ni = nb + k2; const f32x4 z = {0.f, 0.f, 0.f, 0.f};
        const f32x4 gkk = tile16(lds + R1_KT, mi * 16, lds + R1_KH, ni * 16, z, lane), gbk = tile16(lds + R1_KT, mi * 16, lds + R1_BH, ni * 16, z, lane);
        const f32x4 gkr = tile16(lds + R1_RT, mi * 16, lds + R1_KH, ni * 16, z, lane), gbr = tile16(lds + R1_RT, mi * 16, lds + R1_BH, ni * 16, z, lane);
        const int tt = mi * 16 + r16, i0 = ni * 16 + 4 * q4;
        float s0[4], s1[4], s2[4], s3[4];
#pragma unroll
        for (int j = 0; j < 4; ++j) { const bool st = (i0 + j) < tt, in = (i0 + j) <= tt; s0[j] = st ? gkk[j] : 0.f; s1[j] = st ? gbk[j] : 0.f; s2[j] = in ? gkr[j] : 0.f; s3[j] = in ? gbr[j] : 0.f; }
        v2u o; o.x = pk2(s0[0], s0[1]); o.y = pk2(s0[2], s0[3]); *(v2u*)(lds + R1_AKKT + (tt * LDB + i0) * 2) = o;
        o.x = pk2(s2[0], s2[1]); o.y = pk2(s2[2], s2[3]); *(v2u*)(lds + R1_AKRT + (tt * LDB + i0) * 2) = o;
        o.x = pk2(s3[0], s3[1]); o.y = pk2(s3[2], s3[3]); *(v2u*)(lds + R1_ABRT + (tt * LDB + i0) * 2) = o;
        *(f32x4*)(AT32 + tt * 64 + i0) = (f32x4){s1[0], s1[1], s1[2], s1[3]}; }
    __syncthreads();
    RW1_REPEAT(4) {
    for (int idx = tid; idx < 4096; idx += NTHR) T32[idx] = 0.f;
    __syncthreads();
    if (tid < 64) { const int bk = tid >> 4, cc = tid & 15; const float* Lb = AT32 + (bk * 16) * 64 + bk * 16; float xc[16];
#pragma unroll
        for (int rr = 0; rr < 16; ++rr) { float sacc = 0.f;
#pragma unroll
            for (int j = 0; j < rr; ++j) sacc += Lb[rr * 64 + j] * xc[j];
            xc[rr] = (rr > cc) ? -sacc : ((rr == cc) ? 1.f : 0.f); T32[(bk * 16 + rr) * 64 + bk * 16 + cc] = xc[rr]; } }
    __syncthreads();
    {
        const int p = tid >> 8, rr = (tid >> 4) & 15, cc = tid & 15; const float* Bq = AT32 + ((2 * p + 1) * 16) * 64 + (2 * p) * 16; const float* X0 = T32 + ((2 * p) * 16) * 64 + (2 * p) * 16; const float* X1 = T32 + ((2 * p + 1) * 16) * 64 + (2 * p + 1) * 16;
        float sacc = 0.f;
#pragma unroll
        for (int k = 0; k < 16; ++k) sacc += Bq[rr * 64 + k] * X0[k * 64 + cc];
        W32[p * 256 + rr * 16 + cc] = sacc;
        __syncthreads();
        sacc = 0.f;
#pragma unroll
        for (int k = 0; k < 16; ++k) sacc += X1[rr * 64 + k] * W32[p * 256 + k * 16 + cc];
        T32[((2 * p + 1) * 16 + rr) * 64 + (2 * p) * 16 + cc] = -sacc;
    }
    __syncthreads();
    {
        const int rr = tid >> 4, c0 = (tid & 15) * 2; const float* Bq = AT32 + 32 * 64; const float* X1 = T32 + 32 * 64 + 32;
        float sa = 0.f, sb = 0.f;
#pragma unroll 8
        for (int k = 0; k < 32; ++k) { const float bv_ = Bq[rr * 64 + k]; sa += bv_ * T32[k * 64 + c0]; sb += bv_ * T32[k * 64 + c0 + 1]; }
        W32[rr * 32 + c0] = sa; W32[rr * 32 + c0 + 1] = sb;
        __syncthreads();
        sa = 0.f; sb = 0.f;
#pragma unroll 8
        for (int k = 0; k < 32; ++k) { const float xv = X1[rr * 64 + k]; sa += xv * W32[k * 32 + c0]; sb += xv * W32[k * 32 + c0 + 1]; }
        T32[(32 + rr) * 64 + c0] = -sa; T32[(32 + rr) * 64 + c0 + 1] = -sb;
    }
    __syncthreads();
    { const int tt = tid >> 3, i0 = (tid & 7) * 8; const f32x4 ta = *(const f32x4*)(T32 + tt * 64 + i0), tb = *(const f32x4*)(T32 + tt * 64 + i0 + 4);
        v4u o; o.x = pk2(ta.x, ta.y); o.y = pk2(ta.z, ta.w); o.z = pk2(tb.x, tb.y); o.w = pk2(tb.z, tb.w); *(v4u*)(lds + R1_TMT + (tt * LDB + i0) * 2) = o; }
    __syncthreads();
    }
    RW1_REPEAT(5) {
#pragma unroll
    for (int k2 = 0; k2 < 2; ++k2) { const int ni = nb + k2; const f32x4 z = {0.f, 0.f, 0.f, 0.f};
        const f32x4 gp = tile16(lds + R1_KTT, mi * 16, lds + R1_TMT, ni * 16, z, lane), gva = tile16(lds + R1_VT, mi * 16, lds + R1_AKKT, ni * 16, z, lane);
        const int xr = mi * 16 + r16, y0 = ni * 16 + 4 * q4;
        v2u o; o.x = pk2(-gp[0], -gp[1]); o.y = pk2(-gp[2], -gp[3]); *(v2u*)(lds + R1_NP + (xr * LDB + y0) * 2) = o;
        o.x = pk2(gva[0], gva[1]); o.y = pk2(gva[2], gva[3]); *(v2u*)(lds + R1_VA + (xr * LDB + y0) * 2) = o; }
    __syncthreads();
    {
        const size_t ob = (size_t)u * 4096;
        bf16* MTg = (bf16*)(a->ws + WS_RWM) + ob; bf16* QTg = (bf16*)(a->ws + WS_RWQ) + ob;
#pragma unroll
        for (int k2 = 0; k2 < 2; ++k2) { const int ni = nb + k2; const f32x4 z = {0.f, 0.f, 0.f, 0.f};
            const f32x4 ge = tile16(lds + R1_VA, mi * 16, lds + R1_TMT, ni * 16, z, lane);
            const f32x4 gm = tile16(lds + R1_BGT, mi * 16, lds + R1_NP, ni * 16, z, lane);
            const int xr = mi * 16 + r16, y0 = ni * 16 + 4 * q4;
            const v2u rt2 = *(const v2u*)(lds + R1_RT + (xr * LDB + y0) * 2);
            f32x4 q0 = {bflo(rt2.x), bfhi(rt2.x), bflo(rt2.y), bfhi(rt2.y)};
            q0 = tile16(lds + R1_ABRT, mi * 16, lds + R1_NP, ni * 16, q0, lane);
            v2u o; o.x = pk2(-ge[0], -ge[1]); o.y = pk2(-ge[2], -ge[3]); *(v2u*)(lds + R1_NE0 + (xr * LDB + y0) * 2) = o;
            const float gcx = GCv[xr];
            o.x = pk2(gm[0] + ((y0 == xr) ? gcx : 0.f), gm[1] + ((y0 + 1 == xr) ? gcx : 0.f)); o.y = pk2(gm[2] + ((y0 + 2 == xr) ? gcx : 0.f), gm[3] + ((y0 + 3 == xr) ? gcx : 0.f));
            *(v2u*)(MTg + xr * 64 + y0) = o;
            o.x = pk2(q0[0], q0[1]); o.y = pk2(q0[2], q0[3]); *(v2u*)(QTg + xr * 64 + y0) = o; }
    }
    __syncthreads();
    {
        const size_t ob = (size_t)u * 4096;
        bf16* N0g = (bf16*)(a->ws + WS_RWN) + ob; bf16* O0g = (bf16*)(a->ws + WS_RWO) + ob;
#pragma unroll
        for (int k2 = 0; k2 < 2; ++k2) { const int ni = nb + k2; f32x4 go = {0.f, 0.f, 0.f, 0.f}, gn = {0.f, 0.f, 0.f, 0.f};
            go = tile16(lds + R1_AKRT, mi * 16, lds + R1_VT, ni * 16, go, lane); go = tile16(lds + R1_ABRT, mi * 16, lds + R1_NE0, ni * 16, go, lane);
            gn = tile16(lds + R1_VT, mi * 16, lds + R1_KGT, ni * 16, gn, lane); gn = tile16(lds + R1_NE0, mi * 16, lds + R1_BGT, ni * 16, gn, lane);
            const int xr = mi * 16 + r16, y0 = ni * 16 + 4 * q4;
            v2u o; o.x = pk2(go[0], go[1]); o.y = pk2(go[2], go[3]); *(v2u*)(O0g + xr * 64 + y0) = o;
            o.x = pk2(gn[0], gn[1]); o.y = pk2(gn[2], gn[3]); *(v2u*)(N0g + xr * 64 + y0) = o; }
    }
    __syncthreads();
    }
    }
}

template <int VAR> __device__ __forceinline__ void scan_unit(CA a, int su, unsigned char* lds, int tid) {
    const int bh = su >> 1, half = su & 1, lane = tid & 63, wave = tid >> 6, mi = wave & 1, ni = wave >> 1, r16 = lane & 15, q4 = lane >> 4;
    const bf16* MTg = (const bf16*)(a->ws + WS_RWM) + (size_t)bh * 64 * 4096 + (ni * 16 + r16) * 64 + q4 * 8;
    const bf16* N0g = (const bf16*)(a->ws + WS_RWN) + (size_t)bh * 64 * 4096 + (half * 32 + mi * 16 + r16) * 64 + ni * 16 + 4 * q4;
    bf16* SCg = (bf16*)(a->ws + WS_SC) + (size_t)bh * 64 * 4096 + (half * 32 + mi * 16 + r16) * 64 + ni * 16 + 4 * q4;
    unsigned char* Sb = lds;
    bf16* dump = (bf16*)(a->ws + WS_SC + 8 * MiB) + (size_t)(su * NTHR + tid) * 4;
    const int soff = ((mi * 16 + r16) * LDB + ni * 16 + 4 * q4) * 2, xoff = ((mi * 16 + r16) * LDB + q4 * 8) * 2;
    constexpr int D = 16, SBB = 32 * LDB * 2;
    bf16x8 m0[D], m1[D]; v2u nn[D];
#pragma unroll
    for (int d = 0; d < D; ++d) { m0[d] = *(const bf16x8*)(MTg + (size_t)d * 4096); m1[d] = *(const bf16x8*)(MTg + (size_t)d * 4096 + 32); nn[d] = *(const v2u*)(N0g + (size_t)d * 4096); }
    { const v2u z = {0u, 0u}; *(v2u*)(Sb + soff) = z; if (VAR == 0) *(v2u*)SCg = z; }
#pragma unroll
    for (int cb = 0; cb < 64; cb += D) {
#pragma unroll
        for (int d = 0; d < D; ++d) { const int c = cb + d;
            asm volatile("s_waitcnt lgkmcnt(0)\n\ts_barrier" ::: "memory");
            const unsigned char* Sc = Sb + (c & 1) * SBB;
            const bf16x8 x0 = *(const bf16x8*)(Sc + xoff), x1 = *(const bf16x8*)(Sc + xoff + 64);
            f32x4 acc = {bflo(nn[d].x), bfhi(nn[d].x), bflo(nn[d].y), bfhi(nn[d].y)};
            acc = __builtin_amdgcn_mfma_f32_16x16x32_bf16(m0[d], x0, acc, 0, 0, 0); acc = __builtin_amdgcn_mfma_f32_16x16x32_bf16(m1[d], x1, acc, 0, 0, 0);
            v2u o; o.x = pk2(acc[0], acc[1]); o.y = pk2(acc[2], acc[3]);
            *(v2u*)(Sb + ((c + 1) & 1) * SBB + soff) = o;
            if (VAR == 0) *(v2u*)((c + 1 < 64) ? SCg + (size_t)(c + 1) * 4096 : dump) = o;
            if (VAR < 2 || VAR == 3) { const int cn = (VAR == 3) ? d : ((c + D < 64) ? c + D : 63); m0[d] = *(const bf16x8*)(MTg + (size_t)cn * 4096); m1[d] = *(const bf16x8*)(MTg + (size_t)cn * 4096 + 32); nn[d] = *(const v2u*)(N0g + (size_t)cn * 4096); } }
    }
    __syncthreads();
}

__device__ __forceinline__ float gelu_tanh(float x) { const float u = 0.7978845608028654f * (x + 0.044715f * x * x * x); return 0.5f * x * (1.f + tanhf(u)); }
__device__ __forceinline__ void post_unit(CA a, int l, int u, unsigned char* lds, int tid, bool fox = true) {
    const int b = u / NCH, c = u % NCH, lane = tid & 63, wave = tid >> 6; const size_t row0 = (size_t)b * S + c * 64;
    float* carry = (float*)lds;
    if (tid < 256) { const float* AA = (const float*)(a->ws + WS_AAGG) + (size_t)b * NCH * 256 + tid; const float* HA = (const float*)(a->ws + WS_HAGG) + (size_t)b * NCH * 256 + tid;
        float cr = 0.f; for (int cc = 0; cc < c; ++cc) cr = AA[cc * 256] * cr + HA[cc * 256]; carry[tid] = cr; }
    __syncthreads();
    const bf16* P = (const bf16*)(a->ws + WS_PROJ); bf16* Y = (bf16*)(a->ws + WS_Y);
    const f32x4 cr4 = *(const f32x4*)(carry + 4 * lane);
    const f32x4 lg4 = *(const f32x4*)(a->in[I_LNG] + l * 256 + 4 * lane);
    const f32x4 fgA = *(const f32x4*)(a->in[I_FNG] + l * 512 + 8 * lane), fgB = *(const f32x4*)(a->in[I_FNG] + l * 512 + 8 * lane + 4);
    for (int tt = wave; tt < 64; tt += NWAVES) { const size_t row = row0 + tt;
        {
            const v2u hl = *(const v2u*)((const bf16*)(a->ws + WS_HLOC) + row * 256 + 4 * lane), ca = *(const v2u*)((const bf16*)(a->ws + WS_CUMA) + row * 256 + 4 * lane), ga = *(const v2u*)(P + row * NP + C_GA + 4 * lane);
            const float y0 = gelu_tanh(bflo(ga.x)) * (bflo(hl.x) + bflo(ca.x) * cr4.x), y1 = gelu_tanh(bfhi(ga.x)) * (bfhi(hl.x) + bfhi(ca.x) * cr4.y),
                        y2 = gelu_tanh(bflo(ga.y)) * (bflo(hl.y) + bflo(ca.y) * cr4.z), y3 = gelu_tanh(bfhi(ga.y)) * (bfhi(hl.y) + bfhi(ca.y) * cr4.w);
            const float rstd = rsqrtf(wave_sum((y0 * y0 + y1 * y1) + (y2 * y2 + y3 * y3)) * (1.f / 256.f) + 1e-6f);
            v2u o; o.x = pk2(y0 * rstd * lg4.x, y1 * rstd * lg4.y); o.y = pk2(y2 * rstd * lg4.z, y3 * rstd * lg4.w); *(v2u*)(Y + row * DM + 4 * lane) = o; }
        if (fox) {
            bf16* p = Y + row * DM + 256 + 8 * lane; const v4u raw = *(const v4u*)p;
            const float v0 = bflo(raw.x), v1 = bfhi(raw.x), v2 = bflo(raw.y), v3 = bfhi(raw.y), v4 = bflo(raw.z), v5 = bfhi(raw.z), v6 = bflo(raw.w), v7 = bfhi(raw.w);
            const float rstd = rsqrtf(wave_sum(((v0 * v0 + v1 * v1) + (v2 * v2 + v3 * v3)) + ((v4 * v4 + v5 * v5) + (v6 * v6 + v7 * v7))) * (1.f / 512.f) + 1e-6f);
            v4u o; o.x = pk2(v0 * rstd * fgA.x, v1 * rstd * fgA.y); o.y = pk2(v2 * rstd * fgA.z, v3 * rstd * fgA.w); o.z = pk2(v4 * rstd * fgB.x, v5 * rstd * fgB.y); o.w = pk2(v6 * rstd * fgB.z, v7 * rstd * fgB.w);
            *(v4u*)p = o; }
    }
    {
        const int h = wave >> 1, r16 = lane & 15, q4 = lane >> 4; const size_t ub = ((size_t)((b * 4 + h) * 64 + c)) * 4096;
        const bf16* QTg = (const bf16*)(a->ws + WS_RWQ) + ub; const bf16* SCg = (const bf16*)(a->ws + WS_SC) + ub; const bf16* O0g = (const bf16*)(a->ws + WS_RWO) + ub;
        const float* rlg = a->in[I_RLG] + l * 256 + h * 64; const float* rlb = a->in[I_RLB] + l * 256 + h * 64;
#pragma unroll
        for (int m2 = 0; m2 < 2; ++m2) { const int t = (2 * (wave & 1) + m2) * 16 + r16; const size_t row = row0 + t;
            const bf16x8 x0 = *(const bf16x8*)(QTg + t * 64 + q4 * 8), x1 = *(const bf16x8*)(QTg + t * 64 + 32 + q4 * 8);
            f32x4 o[4]; float s = 0.f;
#pragma unroll
            for (int ni = 0; ni < 4; ++ni) { const bf16x8 y0 = *(const bf16x8*)(SCg + (ni * 16 + r16) * 64 + q4 * 8), y1 = *(const bf16x8*)(SCg + (ni * 16 + r16) * 64 + 32 + q4 * 8);
                const v2u ov = *(const v2u*)(O0g + t * 64 + ni * 16 + 4 * q4); o[ni] = (f32x4){bflo(ov.x), bfhi(ov.x), bflo(ov.y), bfhi(ov.y)};
                o[ni] = __builtin_amdgcn_mfma_f32_16x16x32_bf16(y0, x0, o[ni], 0, 0, 0); o[ni] = __builtin_amdgcn_mfma_f32_16x16x32_bf16(y1, x1, o[ni], 0, 0, 0);
                s += (o[ni][0] + o[ni][1]) + (o[ni][2] + o[ni][3]); }
            s += __shfl_xor(s, 16); s += __shfl_xor(s, 32);
            const float mean = s * (1.f / 64.f); float q = 0.f;
#pragma unroll
            for (int ni = 0; ni < 4; ++ni) { o[ni] = o[ni] - mean; q += (o[ni][0] * o[ni][0] + o[ni][1] * o[ni][1]) + (o[ni][2] * o[ni][2] + o[ni][3] * o[ni][3]); }
            q += __shfl_xor(q, 16); q += __shfl_xor(q, 32);
            const float rstd = rsqrtf(q * (1.f / 64.f) + 64e-5f);
            const float bon = ((const float*)(a->ws + WS_BON))[row * 4 + h];
#pragma unroll
            for (int ni = 0; ni < 4; ++ni) { const int n = ni * 16 + 4 * q4, hn = h * 64 + n;
                const f32x4 lg = *(const f32x4*)(rlg + n), lb = *(const f32x4*)(rlb + n);
                const v2u g2_ = *(const v2u*)((const bf16*)(a->ws + WS_G) + row * 256 + hn), vs = *(const v2u*)((const bf16*)(a->ws + WS_VS) + row * 256 + hn);
                const float z0 = (o[ni][0] * rstd * lg.x + lb.x + bon * bflo(vs.x)) * bflo(g2_.x), z1 = (o[ni][1] * rstd * lg.y + lb.y + bon * bfhi(vs.x)) * bfhi(g2_.x),
                            z2 = (o[ni][2] * rstd * lg.z + lb.z + bon * bflo(vs.y)) * bflo(g2_.y), z3 = (o[ni][3] * rstd * lg.w + lb.w + bon * bfhi(vs.y)) * bfhi(g2_.y);
                v2u ow; ow.x = pk2(z0, z1); ow.y = pk2(z2, z3); *(v2u*)(Y + row * DM + 768 + hn) = ow; } }
    }
    __syncthreads();
}

struct EpiResF32 {
    static constexpr bool PERM = true, AFTER_DRAIN = false;
    const float* X; float* O; bf16* Hb;
    __device__ __forceinline__ void operator()(const pg8::f32x4 (&acc)[2][2][4][2], const pg8::Unit& u, int wr, int wc, int fr, int fq) const {
        const int row0 = u.pm * 256 + wr * 64 + fr, col0 = u.pn * 256 + wc * 32 + 8 * fq;
#pragma unroll
        for (int ai = 0; ai < 2; ++ai)
#pragma unroll
            for (int m = 0; m < 4; ++m) { const size_t ro = (size_t)(row0 + ai * 128 + m * 16) * DM + col0;
#pragma unroll
                for (int bj = 0; bj < 2; ++bj) { const pg8::f32x4 x0 = *(const pg8::f32x4*)(X + ro + bj * 128), x1 = *(const pg8::f32x4*)(X + ro + bj * 128 + 4);
                    const pg8::f32x4 y0 = x0 + acc[ai][bj][m][0], y1 = x1 + acc[ai][bj][m][1];
                    *(pg8::f32x4*)(O + ro + bj * 128) = y0; *(pg8::f32x4*)(O + ro + bj * 128 + 4) = y1;
                    v4u hb; hb.x = pk2(y0[0], y0[1]); hb.y = pk2(y0[2], y0[3]); hb.z = pk2(y1[0], y1[1]); hb.w = pk2(y1[2], y1[3]); *(v4u*)(Hb + ro + bj * 128) = hb; } }
    }
};
struct MoeSched {
    const int* tst; int NJ, nunits, G, c;
    __device__ __forceinline__ bool next(int i, pg8::Unit& u) const {
        const int L = i * G + c; if (L >= nunits) return false;
        const int tile = L / NJ, j = L % NJ; int e = 0;
#pragma unroll
        for (int k = 1; k < NE; ++k) e += (tile >= tst[k]) ? 1 : 0;
        u.pm = tile; u.pn = e * NJ + j; return true;
    }
    __device__ __forceinline__ void a_ready(const pg8::Unit&) const {}
    __device__ __forceinline__ void done(const pg8::Unit&) const {}
};
struct EpiSwiglu {
    static constexpr bool PERM = true, AFTER_DRAIN = false;
    bf16* HID; const float* SW; const float* SR; const int* tst; const int* cnt;
    __device__ __forceinline__ void operator()(const pg8::f32x4 (&acc)[2][2][4][2], const pg8::Unit& u, int wr, int wc, int fr, int fq) const {
        const int e = u.pn >> 1, j = u.pn & 1, seg0 = tst[e] * 256, ce = cnt[e];
        const int row0 = u.pm * 256 + wr * 64 + fr, hc0 = j * 128 + wc * 16 + 4 * fq;
#pragma unroll
        for (int ai = 0; ai < 2; ++ai)
#pragma unroll
            for (int m = 0; m < 4; ++m) { const int row = row0 + ai * 128 + m * 16; const bool valid = (row - seg0) < ce; const float w = valid ? SW[row] : 0.f, rs = valid ? SR[row] : 0.f;
#pragma unroll
                for (int bj = 0; bj < 2; ++bj) { const pg8::f32x4 v0 = acc[ai][bj][m][0] * rs, v1 = acc[ai][bj][m][1] * rs;
                    float h0 = v0[0] * sigmoidf_(v0[0]) * v0[1] * w, h1 = v0[2] * sigmoidf_(v0[2]) * v0[3] * w, h2 = v1[0] * sigmoidf_(v1[0]) * v1[1] * w, h3 = v1[2] * sigmoidf_(v1[2]) * v1[3] * w;
                    if (!valid) { h0 = 0.f; h1 = 0.f; h2 = 0.f; h3 = 0.f; }
                    v2u o; o.x = pk2(h0, h1); o.y = pk2(h2, h3); *(v2u*)(HID + (size_t)row * DE + hc0 + bj * 64) = o; } }
    }
};
struct EpiYE {
    static constexpr bool PERM = true, AFTER_DRAIN = false;
    bf16* YE;
    __device__ __forceinline__ void operator()(const pg8::f32x4 (&acc)[2][2][4][2], const pg8::Unit& u, int wr, int wc, int fr, int fq) const {
        const int j = u.pn & 3; const int row0 = u.pm * 256 + wr * 64 + fr, col0 = j * 256 + wc * 32 + 8 * fq;
#pragma unroll
        for (int ai = 0; ai < 2; ++ai)
#pragma unroll
            for (int m = 0; m < 4; ++m) { bf16* rowp = YE + (size_t)(row0 + ai * 128 + m * 16) * DM + col0;
#pragma unroll
                for (int bj = 0; bj < 2; ++bj) { const pg8::f32x4 v0 = acc[ai][bj][m][0], v1 = acc[ai][bj][m][1];
                    v4u w; w.x = pk2(v0[0], v0[1]); w.y = pk2(v0[2], v0[3]); w.z = pk2(v1[0], v1[1]); w.w = pk2(v1[2], v1[3]); *(v4u*)(rowp + bj * 128) = w; } }
    }
};

__device__ __forceinline__ void route_unit(CA a, int l, int u, unsigned char* lds, int tid, int* hist) {
    const int lane = tid & 63, wave = tid >> 6, r16 = lane & 15, q4 = lane >> 4;
    const float* xb = a->out + ((size_t)u * 64 + r16) * DM + wave * 128 + q4 * 8;
    const bf16* wh = (const bf16*)(a->ws + WS_WRH) + (size_t)r16 * DM + wave * 128 + q4 * 8; const bf16* wl = (const bf16*)(a->ws + WS_WRL) + (size_t)r16 * DM + wave * 128 + q4 * 8;
    float* part = (float*)lds;
    bf16x8 bh_[2][4], bl_[2][4];
#pragma unroll
    for (int ni = 0; ni < 2; ++ni)
#pragma unroll
        for (int kk = 0; kk < 4; ++kk) { bh_[ni][kk] = *(const bf16x8*)(wh + (size_t)ni * 16 * DM + kk * 32); bl_[ni][kk] = *(const bf16x8*)(wl + (size_t)ni * 16 * DM + kk * 32); }
#pragma unroll
    for (int mi = 0; mi < 4; ++mi) {
        f32x4 xa[4][2];
#pragma unroll
        for (int kk = 0; kk < 4; ++kk) { xa[kk][0] = *(const f32x4*)(xb + (size_t)mi * 16 * DM + kk * 32); xa[kk][1] = *(const f32x4*)(xb + (size_t)mi * 16 * DM + kk * 32 + 4); }
        f32x4 acc0 = {0.f, 0.f, 0.f, 0.f}, acc1 = acc0; float ssq = 0.f;
#pragma unroll
        for (int kk = 0; kk < 4; ++kk) { const f32x4 v0 = xa[kk][0], v1 = xa[kk][1];
            ssq += ((v0.x * v0.x + v0.y * v0.y) + (v0.z * v0.z + v0.w * v0.w)) + ((v1.x * v1.x + v1.y * v1.y) + (v1.z * v1.z + v1.w * v1.w));
            const unsigned h0 = pk2(v0.x, v0.y), h1 = pk2(v0.z, v0.w), h2 = pk2(v1.x, v1.y), h3 = pk2(v1.z, v1.w);
            const v4u hv = {h0, h1, h2, h3};
            const v4u lv = {pk2(v0.x - bflo(h0), v0.y - bfhi(h0)), pk2(v0.z - bflo(h1), v0.w - bfhi(h1)), pk2(v1.x - bflo(h2), v1.y - bfhi(h2)), pk2(v1.z - bflo(h3), v1.w - bfhi(h3))};
            const bf16x8 ah = __builtin_bit_cast(bf16x8, hv), al = __builtin_bit_cast(bf16x8, lv);
            acc0 = __builtin_amdgcn_mfma_f32_16x16x32_bf16(bh_[0][kk], ah, acc0, 0, 0, 0); acc0 = __builtin_amdgcn_mfma_f32_16x16x32_bf16(bl_[0][kk], ah, acc0, 0, 0, 0); acc0 = __builtin_amdgcn_mfma_f32_16x16x32_bf16(bh_[0][kk], al, acc0, 0, 0, 0);
            acc1 = __builtin_amdgcn_mfma_f32_16x16x32_bf16(bh_[1][kk], ah, acc1, 0, 0, 0); acc1 = __builtin_amdgcn_mfma_f32_16x16x32_bf16(bl_[1][kk], ah, acc1, 0, 0, 0); acc1 = __builtin_amdgcn_mfma_f32_16x16x32_bf16(bh_[1][kk], al, acc1, 0, 0, 0); }
        ssq += __shfl_xor(ssq, 16); ssq += __shfl_xor(ssq, 32);
        float* pr = part + (wave * 64 + mi * 16 + r16) * 33;
        pr[4 * q4] = acc0[0]; pr[4 * q4 + 1] = acc0[1]; pr[4 * q4 + 2] = acc0[2]; pr[4 * q4 + 3] = acc0[3];
        pr[16 + 4 * q4] = acc1[0]; pr[16 + 4 * q4 + 1] = acc1[1]; pr[16 + 4 * q4 + 2] = acc1[2]; pr[16 + 4 * q4 + 3] = acc1[3];
        if (q4 == 0) pr[32] = ssq;
    }
    __syncthreads();
    if (tid < 64) {
        float lt[20]; float ssq = 0.f;
#pragma unroll
        for (int n = 0; n < 20; ++n) lt[n] = 0.f;
#pragma unroll
        for (int w = 0; w < 8; ++w) { const float* pr = part + (w * 64 + tid) * 33; ssq += pr[32];
#pragma unroll
            for (int n = 0; n < 20; ++n) lt[n] += pr[n]; }
        const float rstd = rsqrtf(ssq * (1.f / DM) + 1e-6f); const float* gb = a->in[I_RGB] + l * 4; const float* eb = a->in[I_REB] + l * NE;
        const float g0 = lt[0] * rstd + gb[0], g1 = lt[1] * rstd + gb[1], g2_ = lt[2] * rstd + gb[2], g3 = lt[3] * rstd + gb[3];
        int gi = 0; float gm = g0; if (g1 > gm) { gm = g1; gi = 1; } if (g2_ > gm) { gm = g2_; gi = 2; } if (g3 > gm) { gm = g3; gi = 3; }
        const float gp = 1.f / (__expf(g0 - gm) + __expf(g1 - gm) + __expf(g2_ - gm) + __expf(g3 - gm));
        float el[4];
#pragma unroll
        for (int k = 0; k < 4; ++k) el[k] = (gi == 0 ? lt[4 + k] : gi == 1 ? lt[8 + k] : gi == 2 ? lt[12 + k] : lt[16 + k]) * rstd + eb[gi * 4 + k];
        int i0 = 0; float m0 = el[0]; if (el[1] > m0) { m0 = el[1]; i0 = 1; } if (el[2] > m0) { m0 = el[2]; i0 = 2; } if (el[3] > m0) { m0 = el[3]; i0 = 3; }
        int i1 = -1; float m1 = -INFINITY;
#pragma unroll
        for (int k = 0; k < 4; ++k) { if (k != i0 && el[k] > m1) { m1 = el[k]; i1 = k; } }
        const float p0 = 1.f / (1.f + __expf(m1 - m0)), p1 = 1.f - p0; const int m = u * 64 + tid, e0 = gi * 4 + i0, e1 = gi * 4 + i1;
        int* TE = (int*)(a->ws + WS_TOKE); float* TW = (float*)(a->ws + WS_TOKW);
        TE[m * 2] = e0; TE[m * 2 + 1] = e1; TW[m * 2] = gp * p0; TW[m * 2 + 1] = gp * p1; ((float*)(a->ws + WS_TR))[m] = rstd; atomicAdd(&hist[e0], 1); atomicAdd(&hist[e1], 1);
    }
    __syncthreads();
}
__device__ __forceinline__ void phase_route(CA a, int l, unsigned char* lds, int tid, gu32* ctl, bool first = true) {
    int* hist = (int*)(lds + 8 * 64 * 33 * 4);
    if (tid < NE) hist[tid] = 0;
    __syncthreads();
    for (int u = blockIdx.x; u < T / 64; u += gridDim.x) route_unit(a, l, u, lds, tid, hist);
    if (first && tid < NE) __hip_atomic_fetch_add((unsigned*)(ctl + CW_CNT0 + l * CW_LSTRIDE + tid), (unsigned)hist[tid], RLX_AGENT);
    __syncthreads();
}

__device__ __forceinline__ void moe_tables(int l, unsigned char* lds, int tid, gu32* ctl) {
    int* tst = (int*)(lds + LDS_TAB); int* cnt = tst + 32;
    if (tid == 0) { int acc = 0; for (int e = 0; e < NE; ++e) { const int ce = (int)__hip_atomic_load(ctl + CW_CNT0 + l * CW_LSTRIDE + e, RLX_AGENT); cnt[e] = ce; tst[e] = acc; acc += (ce + 255) >> 8; } tst[NE] = acc; }
    __syncthreads();
}
__device__ __forceinline__ void phase_place(CA a, int l, unsigned char* lds, int tid, gu32* ctl) {
    const int lane = tid & 63, wave = tid >> 6;
    int* tst = (int*)(lds + LDS_TAB); int* lcnt = (int*)lds; int* lbase = lcnt + 16; int* sslot = lcnt + 32;
    const int* TE = (const int*)(a->ws + WS_TOKE); const float* TW = (const float*)(a->ws + WS_TOKW); float* SW = (float*)(a->ws + WS_SW); int* TSL = (int*)(a->ws + WS_TSLOT);
    const bf16* H = (const bf16*)(a->ws + WS_H); bf16* AS = (bf16*)(a->ws + WS_ASORT);
    for (int u = blockIdx.x; u < T / 64; u += gridDim.x) {
        if (tid < NE) lcnt[tid] = 0;
        __syncthreads();
        int e = 0, lrank = 0, t = 0; float w = 0.f;
        if (tid < 128) { t = u * 64 + (tid >> 1); e = TE[t * 2 + (tid & 1)]; w = TW[t * 2 + (tid & 1)]; lrank = atomicAdd(&lcnt[e], 1); }
        __syncthreads();
        if (tid < NE) lbase[tid] = (int)__hip_atomic_fetch_add((unsigned*)(ctl + CW_CUR0 + l * CW_LSTRIDE + tid), (unsigned)lcnt[tid], RLX_AGENT);
        __syncthreads();
        if (tid < 128) { const int slot = tst[e] * 256 + lbase[e] + lrank; TSL[t * 2 + (tid & 1)] = slot; SW[slot] = w; ((float*)(a->ws + WS_SR))[slot] = ((const float*)(a->ws + WS_TR))[t]; sslot[tid] = slot; }
        __syncthreads();
#pragma unroll 4
        for (int i = 0; i < 16; ++i) { const int p = wave * 16 + i; const int tk = u * 64 + (p >> 1); const int slot = sslot[p];
            const v4u* src = (const v4u*)(H + (size_t)tk * DM) + lane; v4u* dst = (v4u*)(AS + (size_t)slot * DM) + lane; dst[0] = src[0]; dst[64] = src[64]; }
        __syncthreads();
    }
}

__global__ void __launch_bounds__(NTHR, 2) fwd(Args a_unused) {
    extern __shared__ __attribute__((aligned(16))) unsigned char lds[];
    volatile LAS unsigned* MISC = (volatile LAS unsigned*)((LAS unsigned char*)lds + MISC_OFF);
    if (threadIdx.x < 64) MISC[threadIdx.x] = 0u;
    __syncthreads();
#if MK_ONE_LAUNCH
    XcdBarrier bar = xcd_barrier_post((unsigned*)(args_now()->ws + WS_CTL) + CW_BAR, MISC + 8);
#define SEAM(k) do { if (IN((k) + 1)) xcd_barrier(bar); } while (0)
#else
#define SEAM(k) do { } while (0)
#endif
    const int lo = args_now()->ph_lo, hi = args_now()->ph_hi;
#ifndef REP_GIN
#define REP_GIN 1
#endif
#ifndef REP_LRU
#define REP_LRU 1
#endif
#ifndef REP_RW1
#define REP_RW1 1
#endif
#ifndef REP_SCAN
#define REP_SCAN 1
#endif
#ifndef REP_ATTN
#define REP_ATTN 1
#endif
#ifndef REP_POST
#define REP_POST 1
#endif
#ifndef REP_ROUTE
#define REP_ROUTE 1
#endif
#ifndef REP_MOE1
#define REP_MOE1 1
#endif
#ifndef REP_MOE2
#define REP_MOE2 1
#endif
#ifndef PHASE_MASK
#define PHASE_MASK 0x3ff
#endif
#define IN(k) (((PHASE_MASK >> ((k) % NPH)) & 1) && lo <= (k) && (k) < hi)
    for (int l = 0; l < NL; ++l) {
        const int pb = l * NPH;
        if (IN(pb + PH_PRE)) { phase_pre(args_now(), l, lds, pg8::tid_now()); SEAM(pb + PH_PRE); }
        if (IN(pb + PH_GIN)) { CA a = args_now();
            pg8::Gemm g{(const pg8::bf16_t*)(a->ws + WS_H), (const pg8::bf16_t*)(a->ws + WS_WIN), T, NP, DM}; pg8::StaticOrder So; So.init(T, NP, (int)gridDim.x, (int)blockIdx.x);
            pg8::EpiBf16<0> E{(pg8::bf16_t*)(a->ws + WS_PROJ), NP, nullptr, 0, 0, 1.f};
            for (int rep = 0; rep < REP_GIN; ++rep) pg8::gemm_phase<pg8::EpiBf16<0>, pg8::StaticOrder, true, true>((PG8_LAS unsigned char*)lds, g, So, E);
            SEAM(pb + PH_GIN);
        }
        if (IN(pb + PH_PREP)) {
            for (int rep = 0; rep < REP_LRU; ++rep) for (int u = blockIdx.x; u < Bsz * NCH; u += gridDim.x) prep_unit(args_now(), l, u, lds, pg8::tid_now(), rep == 0);
            for (int rep = 0; rep < REP_RW1; ++rep) for (int u = blockIdx.x; u < Bsz * NCH; u += gridDim.x) rw1_unit(args_now(), l, u, lds, pg8::tid_now());
            SEAM(pb + PH_PREP);
        }
        if (IN(pb + PH_MIX)) {
            for (int su = blockIdx.x; su < Bsz * 4 * 2; su += gridDim.x) scan_unit<0>(args_now(), su, lds, pg8::tid_now());
#ifdef SCAN_VAR
            for (int rep = 1; rep < REP_SCAN; ++rep) for (int su = blockIdx.x; su < Bsz * 4 * 2; su += gridDim.x) scan_unit<SCAN_VAR>(args_now(), su, lds, pg8::tid_now());
#endif
#if MK_ONE_LAUNCH && defined(SCAN_ALONE)
            xcd_barrier(bar);
#endif
            { CA a = args_now(); gu32* qh = (gu32*)(a->ws + WS_CTL) + CW_Q0 + l * CW_LSTRIDE;
                for (;;) {
                    if (threadIdx.x == 0) MISC[0] = __hip_atomic_fetch_add((unsigned*)qh, 1u, RLX_AGENT);
                    __syncthreads();
                    const int ui = (int)MISC[0];
                    __syncthreads();
                    if (ui >= Bsz * 8 * 16) break;
                    const int bh = ui & 31; attn_run(args_now(), bh >> 3, bh & 7, 15 - (ui >> 5), lds);
                } }
            SEAM(pb + PH_MIX);
        }
        if (IN(pb + PH_POST)) { for (int rep = 0; rep < REP_POST; ++rep) for (int u = blockIdx.x; u < Bsz * NCH; u += gridDim.x) post_unit(args_now(), l, u, lds, pg8::tid_now(), rep == 0); SEAM(pb + PH_POST); }
        if (IN(pb + PH_GOUT)) { CA a = args_now();
            pg8::Gemm g{(const pg8::bf16_t*)(a->ws + WS_Y), (const pg8::bf16_t*)(a->ws + WS_WOUT), T, DM, DM}; pg8::StaticOrder So; So.init(T, DM, (int)gridDim.x, (int)blockIdx.x);
            EpiResF32 E{(l == 0) ? a->in[I_X] : a->out, a->out, (bf16*)(a->ws + WS_H)};
            pg8::gemm_phase<EpiResF32, pg8::StaticOrder, true, true>((PG8_LAS unsigned char*)lds, g, So, E);
            SEAM(pb + PH_GOUT);
        }
        if (IN(pb + PH_ROUTE)) { CA a = args_now(); for (int rep = 0; rep < REP_ROUTE; ++rep) phase_route(a, l, lds, pg8::tid_now(), (gu32*)(a->ws + WS_CTL), rep == 0); SEAM(pb + PH_ROUTE); }
        if (IN(pb + PH_PLACE)) { CA a = args_now(); const int tid = pg8::tid_now(); gu32* ctl = (gu32*)(a->ws + WS_CTL); moe_tables(l, lds, tid, ctl); phase_place(a, l, lds, tid, ctl); SEAM(pb + PH_PLACE); }
        if (IN(pb + PH_MOE1)) { CA a = args_now();
            moe_tables(l, lds, pg8::tid_now(), (gu32*)(a->ws + WS_CTL));
            const int* tst = (const int*)(lds + LDS_TAB); const int* cnt = tst + 32;
            pg8::Gemm g{(const pg8::bf16_t*)(a->ws + WS_ASORT), (const pg8::bf16_t*)(a->ws + WS_WGU), MAXTILES * 256, NE * 512, DM};
            MoeSched Sm{tst, 2, tst[NE] * 2, (int)gridDim.x, (int)blockIdx.x};
            EpiSwiglu E{(bf16*)(a->ws + WS_HID), (const float*)(a->ws + WS_SW), (const float*)(a->ws + WS_SR), tst, cnt};
            for (int rep = 0; rep < REP_MOE1; ++rep) pg8::gemm_phase<EpiSwiglu, MoeSched, true, true>((PG8_LAS unsigned char*)lds, g, Sm, E);
            SEAM(pb + PH_MOE1);
        }
        if (IN(pb + PH_MOE2)) { CA a = args_now();
            moe_tables(l, lds, pg8::tid_now(), (gu32*)(a->ws + WS_CTL));
            const int* tst = (const int*)(lds + LDS_TAB);
            int Kd = DE; asm volatile("" : "+s"(Kd));
            pg8::Gemm g{(const pg8::bf16_t*)(a->ws + WS_HID), (const pg8::bf16_t*)(a->ws + WS_WD), MAXTILES * 256, NE * DM, Kd};
            MoeSched Sm{tst, 4, tst[NE] * 4, (int)gridDim.x, (int)blockIdx.x};
            EpiYE E{(bf16*)(a->ws + WS_YE)};
            for (int rep = 0; rep < REP_MOE2; ++rep) pg8::gemm_phase<EpiYE, MoeSched, true, true>((PG8_LAS unsigned char*)lds, g, Sm, E);
            SEAM(pb + PH_MOE2);
        }
    }
    if (IN(PH_FIN)) phase_fin(args_now(), pg8::tid_now());
#undef IN
#undef SEAM
}

extern "C" void kernel_launch(void* const* d_in, const int* in_sizes, int n_in, void* d_out, int out_size, void* d_ws, size_t ws_size, hipStream_t stream) {
    static int grid = 0;
    if (grid == 0) {
        if (n_in != N_IN || in_sizes[0] != T * DM || out_size != T * DM || ws_size < WS_END) { fprintf(stderr, "kernel_launch: unexpected problem shape (n_in %d, in0 %d, out %d, ws %zu); nothing launched\n", n_in, n_in > 0 ? in_sizes[0] : -1, out_size, ws_size); grid = -1; return; }
        int dev = 0, cus = 0, per_cu = 0;
        if (hipGetDevice(&dev) != hipSuccess || hipDeviceGetAttribute(&cus, hipDeviceAttributeMultiprocessorCount, dev) != hipSuccess) { grid = -1; return; }
        if (hipFuncSetAttribute((const void*)fwd, hipFuncAttributeMaxDynamicSharedMemorySize, LDS_BYTES) != hipSuccess) { fprintf(stderr, "kernel_launch: hipFuncSetAttribute failed\n"); grid = -1; return; }
        if (hipOccupancyMaxActiveBlocksPerMultiprocessor(&per_cu, (const void*)fwd, NTHR, LDS_BYTES) != hipSuccess || per_cu < 1) { fprintf(stderr, "kernel_launch: occupancy query reports %d workgroups per CU\n", per_cu); }
        (void)hipGetLastError();
        grid = cus;
    }
    if (grid < 0) return;
    if (hipMemsetAsync((char*)d_ws + WS_CTL, 0, CTL_ZERO_BYTES, stream) != hipSuccess) return;
    Args a{};
    for (int i = 0; i < N_IN; ++i) a.in[i] = (const float*)d_in[i];
    a.out = (float*)d_out; a.ws = (unsigned char*)d_ws;
#if MK_ONE_LAUNCH
    a.ph_lo = 0; a.ph_hi = N_PHASES;
    hipLaunchKernelGGL(fwd, dim3(grid), dim3(NTHR), LDS_BYTES, stream, a);
#else
    for (int p = 0; p < N_PHASES; ++p) { a.ph_lo = p; a.ph_hi = p + 1; hipLaunchKernelGGL(fwd, dim3(grid), dim3(NTHR), LDS_BYTES, stream, a); }
#endif
}
```

```cpp
#include <hip/hip_runtime.h>
#include <hip/hip_bf16.h>
#include <cstdio>
#include <cstdint>
#include <cmath>
namespace pg8 {
#define PG8_LAS __attribute__((address_space(3)))
typedef unsigned short bf16_t;
typedef short bf16x8 __attribute__((ext_vector_type(8)));
typedef float f32x4 __attribute__((ext_vector_type(4)));
typedef unsigned u32x4 __attribute__((ext_vector_type(4)));
__device__ __forceinline__ int tid_now() { int t = threadIdx.x; asm volatile("" : "+v"(t)); return t; }
constexpr int BM = 256, BK = 64, HALF = 128, HTB = HALF * BK * 2  , STAGE_BYTES = 8 * HTB, NXCD = 8, WGM = 8;

__host__ __device__ __forceinline__ int lds_byte(int r, int c) { const int st = (r >> 4) * 2 + (c >> 5), rr = r & 15, cc = c & 31, ob = rr * 64 + cc * 2; return st * 1024 + (ob ^ (((ob >> 9) & 1) << 5)); }
__host__ __device__ __forceinline__ void stage_rc(int b, int& R, int& C) { const int st = b / 1024, sb = b % 1024, swz = sb ^ (((sb >> 9) & 1) << 5); R = (st >> 1) * 16 + swz / 64; C = (st & 1) * 32 + (swz % 64) / 2; }
__host__ __device__ __forceinline__ int perm32(int rho) { const int n = rho >> 4, i = rho & 15; return 8 * (i >> 2) + 4 * n + (i & 3); }

struct Unit { int pm, pn; };
struct Gemm { const bf16_t* A; const bf16_t* Bt; int M, N, K; };

struct StaticOrder {
    int nM, nN, nwg, G, c;
    __host__ __device__ void init(int M, int N, int G_, int c_) { nM = M / BM; nN = N / BM; nwg = nM * nN; G = G_; c = c_; }
    __host__ __device__ bool next(int i, Unit& u) const {
        const long L = (long)i * G + c; if (L >= nwg) return false;
        int wgid = (int)L; { const int q = nwg / NXCD, r = nwg % NXCD, xcd = wgid % NXCD, off = wgid / NXCD; wgid = (xcd < r ? xcd * (q + 1) : r * (q + 1) + (xcd - r) * q) + off; }
        const int nig = WGM * nN, gid = wgid / nig, fm = gid * WGM, gsz = (nM - fm) < WGM ? (nM - fm) : WGM;
        u.pm = fm + ((wgid % nig) % gsz); u.pn = (wgid % nig) / gsz; return true;
    }
    __device__ __forceinline__ void a_ready(const Unit&) const {}
    __device__ __forceinline__ void done(const Unit&) const {}
};

__device__ __forceinline__ unsigned cvt_pk_bf16(float lo, float hi) { unsigned r; asm volatile("v_cvt_pk_bf16_f32 %0, %1, %2" : "=v"(r) : "v"(lo), "v"(hi)); return r; }
typedef float f32x2 __attribute__((ext_vector_type(2)));
__device__ __forceinline__ f32x2 gelu_pk(f32x2 v) {
    const f32x2 av = __builtin_elementwise_abs(v), d = av * 0.2316418882f + 1.0f;
    f32x2 t; t.x = __builtin_amdgcn_rcpf(d.x); t.y = __builtin_amdgcn_rcpf(d.y);
    f32x2 q = t * 0.5307027145f + (-0.7265760135f); q = q * t + 0.7107068705f; q = q * t + (-0.142248368f); q = q * t + 0.127414796f; q = q * t;
    const f32x2 s = (v * v) * (-0.72134752044f);
    f32x2 e; e.x = __builtin_amdgcn_exp2f(s.x); e.y = __builtin_amdgcn_exp2f(s.y);
    const f32x2 m = v * (q * e), r = v - m;
    f32x2 o; o.x = v.x < 0.f ? m.x : r.x; o.y = v.y < 0.f ? m.y : r.y; return o;
}

template <int ACT  > struct EpiBf16 {
    static constexpr bool PERM = true, AFTER_DRAIN = false; static_assert(ACT == 0 || ACT == 1, "EpiBf16: ACT is 0 (none) or 1 (gelu_pk)");
    bf16_t* O; int ldc; const float* bias; int split_cols; size_t split_stride; float scale0;
    __device__ __forceinline__ void operator()(const f32x4 (&acc)[2][2][4][2], const Unit& u, int wr, int wc, int fr, int fq) const {
        const int row0 = u.pm * BM + wr * 64 + fr; int colt = u.pn * BM; bf16_t* base = O;
        float sc = 1.f; if (split_cols) { const int t = colt / split_cols; base += (size_t)t * split_stride; colt -= t * split_cols; if (t == 0) sc = scale0; }
        const int col0 = colt + wc * 32 + 8 * fq, bcol0 = u.pn * BM + wc * 32 + 8 * fq;
        f32x4 bv[2][2];
#pragma unroll
        for (int bj = 0; bj < 2; ++bj)
#pragma unroll
            for (int n = 0; n < 2; ++n) bv[bj][n] = bias ? *(const f32x4*)(bias + bcol0 + bj * HALF + 4 * n) : (f32x4){0.f, 0.f, 0.f, 0.f};
#pragma unroll
        for (int ai = 0; ai < 2; ++ai)
#pragma unroll
            for (int m = 0; m < 4; ++m) { bf16_t* rowp = base + (size_t)(row0 + ai * HALF + m * 16) * ldc + col0;
#pragma unroll
                for (int bj = 0; bj < 2; ++bj) { f32x4 v0 = acc[ai][bj][m][0] + bv[bj][0], v1 = acc[ai][bj][m][1] + bv[bj][1];
                    if (ACT == 1) { f32x2 a = gelu_pk((f32x2){v0[0], v0[1]}), b = gelu_pk((f32x2){v0[2], v0[3]}), c = gelu_pk((f32x2){v1[0], v1[1]}), d = gelu_pk((f32x2){v1[2], v1[3]});
                        v0 = (f32x4){a.x, a.y, b.x, b.y}; v1 = (f32x4){c.x, c.y, d.x, d.y}; }
                    v0 = v0 * sc; v1 = v1 * sc; u32x4 w; w.x = cvt_pk_bf16(v0[0], v0[1]); w.y = cvt_pk_bf16(v0[2], v0[3]); w.z = cvt_pk_bf16(v1[0], v1[1]); w.w = cvt_pk_bf16(v1[2], v1[3]);
                    *(u32x4*)(rowp + bj * HALF) = w; } }
    }
};
template <class Epi, class Sched, bool ALIGN_EPI = false, bool SP2 = false>
__device__ __forceinline__ void gemm_phase(PG8_LAS unsigned char* lds, const Gemm g, const Sched& S, const Epi& E) {
    const int tid = tid_now(), wid = __builtin_amdgcn_readfirstlane(tid >> 6), lane = tid & 63, wr = wid >> 2, wc = wid & 3, fr = lane & 15, fq = lane >> 4;
    const int K = g.K, nt = K / BK;
    unsigned voffA[2], voffB[2];
#pragma unroll
    for (int i = 0; i < 2; ++i) { int R, C; stage_rc(tid * 16 + i * 8192, R, C); const int Rb = Epi::PERM ? ((R & ~31) + perm32(R & 31)) : R;
        voffA[i] = (unsigned)(R * K + C) * 2u; voffB[i] = (unsigned)(Rb * K + C) * 2u; }
    const size_t kstep = (size_t)(BK * 2);
    const size_t hstep = (size_t)HALF * K * 2;
    const size_t tstep = 2 * hstep;
    const unsigned ldsw = (unsigned)wid * 1024u;
    const int aoff = lds_byte(wr * 64 + fr, fq * 8), boff = lds_byte(wc * 32 + fr, fq * 8);
#define PG8_SA(b, h) (((b) * 2 + (h)) * HTB)
#define PG8_SB(b, h) ((4 + (b) * 2 + (h)) * HTB)
#define PG8_STAGE(bufoff, gbase, voff) do { _Pragma("unroll") for (int _i = 0; _i < 2; ++_i) \
        __builtin_amdgcn_global_load_lds((const unsigned*)((const char*)(gbase) + (voff)[_i]), (PG8_LAS unsigned*)(lds + (bufoff) + ldsw + _i * 8192), 16, 0, 0); } while (0)
#define PG8_LDA(dst, b, h) do { _Pragma("unroll") for (int m = 0; m < 4; ++m) _Pragma("unroll") for (int k = 0; k < 2; ++k) dst[m][k] = *(const PG8_LAS bf16x8*)(lds + PG8_SA(b, h) + aoff + m * 2048 + k * 1024); } while (0)
#define PG8_LDB(dst, b, h) do { _Pragma("unroll") for (int n = 0; n < 2; ++n) _Pragma("unroll") for (int k = 0; k < 2; ++k) dst[n][k] = *(const PG8_LAS bf16x8*)(lds + PG8_SB(b, h) + boff + n * 2048 + k * 1024); } while (0)
#define PG8_MMA(ai, bj, At, Bt) do { __builtin_amdgcn_s_setprio(1); _Pragma("unroll") for (int m = 0; m < 4; ++m) _Pragma("unroll") for (int n = 0; n < 2; ++n) _Pragma("unroll") for (int k = 0; k < 2; ++k) \
        acc[ai][bj][m][n] = __builtin_amdgcn_mfma_f32_16x16x32_bf16(Bt[n][k], At[m][k], acc[ai][bj][m][n], 0, 0, 0); __builtin_amdgcn_s_setprio(0); } while (0)
#define PG8_WAIT_V(n) asm volatile("s_waitcnt vmcnt(" #n ")" ::: "memory")
#define PG8_WAIT_L(n) asm volatile("s_waitcnt lgkmcnt(" #n ")" ::: "memory")
#define PG8_BAR __builtin_amdgcn_s_barrier()
#define PG8_SCHED __builtin_amdgcn_sched_barrier(0)
    Unit cur, nxt; int ui = 0;
    if (!S.next(0, cur)) return;
    f32x4 acc[2][2][4][2];
#pragma unroll
    for (int a = 0; a < 2; ++a)
#pragma unroll
        for (int b = 0; b < 2; ++b)
#pragma unroll
            for (int m = 0; m < 4; ++m)
#pragma unroll
                for (int n = 0; n < 2; ++n) acc[a][b][m][n] = (f32x4){0.f, 0.f, 0.f, 0.f};
    bf16x8 At[4][2], B0[2][2], B1[2][2];
    const char* cA = (const char*)g.A + (size_t)cur.pm * tstep; const char* cB = (const char*)g.Bt + (size_t)cur.pn * tstep;
    S.a_ready(cur);
    if constexpr (SP2) {
        PG8_STAGE(PG8_SB(0, 0), cB, voffB); PG8_STAGE(PG8_SB(0, 1), cB + hstep, voffB); PG8_STAGE(PG8_SA(0, 0), cA, voffA); PG8_STAGE(PG8_SA(0, 1), cA + hstep, voffA);
        if (wr == 1) PG8_BAR;
        PG8_WAIT_V(2); PG8_BAR;
        PG8_STAGE(PG8_SB(1, 0), cB + kstep, voffB); PG8_STAGE(PG8_SA(1, 0), cA + kstep, voffA); PG8_STAGE(PG8_SB(1, 1), cB + hstep + kstep, voffB);
        PG8_WAIT_V(6); PG8_BAR;
    } else {
        PG8_STAGE(PG8_SB(0, 0), cB, voffB); PG8_STAGE(PG8_SA(0, 0), cA, voffA); PG8_STAGE(PG8_SB(0, 1), cB + hstep, voffB); PG8_STAGE(PG8_SA(0, 1), cA + hstep, voffA);
        if (wr == 1) PG8_BAR;
        PG8_WAIT_V(4); PG8_BAR;
        PG8_STAGE(PG8_SB(1, 0), cB + kstep, voffB); PG8_STAGE(PG8_SA(1, 0), cA + kstep, voffA); PG8_STAGE(PG8_SB(1, 1), cB + hstep + kstep, voffB);
        PG8_WAIT_V(6); PG8_BAR;
    }
    for (;;) {
        const bool has_next = S.next(ui + 1, nxt);
        const char* nA = has_next ? (const char*)g.A + (size_t)nxt.pm * tstep : cA; const char* nB = has_next ? (const char*)g.Bt + (size_t)nxt.pn * tstep : cB;
        for (int t = 0; t < nt; t += 2) {
            const bool last = (t == nt - 2);
            const char* a1 = cA + (size_t)(t + 1) * kstep;
            const char* a2 = last ? nA : cA + (size_t)(t + 2) * kstep; const char* b2 = last ? nB : cB + (size_t)(t + 2) * kstep;
            const char* a3 = a2 + kstep; const char* b3 = b2 + kstep;
            if (last && has_next) S.a_ready(nxt);
            if constexpr (SP2) {
            PG8_LDB(B0, 0, 0); PG8_LDB(B1, 0, 1); PG8_SCHED; PG8_LDA(At, 0, 0); PG8_STAGE(PG8_SA(1, 1), a1 + hstep, voffA);
            PG8_WAIT_V(8); PG8_WAIT_L(0); PG8_BAR; PG8_MMA(0, 0, At, B0); PG8_MMA(0, 1, At, B1); PG8_BAR; PG8_SCHED;
            PG8_LDA(At, 0, 1); PG8_STAGE(PG8_SB(0, 0), b2, voffB); PG8_STAGE(PG8_SB(0, 1), b2 + hstep, voffB); PG8_STAGE(PG8_SA(0, 0), a2, voffA);
            PG8_WAIT_V(8); PG8_WAIT_L(0); PG8_BAR; PG8_MMA(1, 0, At, B0); PG8_MMA(1, 1, At, B1); PG8_BAR; PG8_SCHED;
            PG8_LDB(B0, 1, 0); PG8_LDB(B1, 1, 1); PG8_SCHED; PG8_LDA(At, 1, 0); PG8_STAGE(PG8_SA(0, 1), a2 + hstep, voffA);
            PG8_WAIT_V(8); PG8_WAIT_L(0); PG8_BAR; PG8_MMA(0, 0, At, B0); PG8_MMA(0, 1, At, B1); PG8_BAR; PG8_SCHED;
            PG8_LDA(At, 1, 1); PG8_STAGE(PG8_SB(1, 0), b3, voffB); PG8_STAGE(PG8_SB(1, 1), b3 + hstep, voffB); PG8_STAGE(PG8_SA(1, 0), a3, voffA);
            PG8_WAIT_V(8); PG8_WAIT_L(0); PG8_BAR; PG8_MMA(1, 0, At, B0); PG8_MMA(1, 1, At, B1); PG8_BAR; PG8_SCHED;
            } else {
            PG8_LDB(B0, 0, 0); PG8_SCHED; PG8_LDA(At, 0, 0); PG8_STAGE(PG8_SA(1, 1), a1 + hstep, voffA);
            PG8_WAIT_L(8); PG8_BAR; PG8_WAIT_L(0); PG8_MMA(0, 0, At, B0); PG8_BAR; PG8_SCHED;
            PG8_LDB(B1, 0, 1); PG8_STAGE(PG8_SB(0, 0), b2, voffB);
            PG8_BAR; PG8_WAIT_L(0); PG8_MMA(0, 1, At, B1); PG8_BAR;
            PG8_LDA(At, 0, 1); PG8_STAGE(PG8_SA(0, 0), a2, voffA);
            PG8_BAR; PG8_WAIT_L(0); PG8_MMA(1, 0, At, B0); PG8_BAR; PG8_SCHED;
            PG8_STAGE(PG8_SB(0, 1), b2 + hstep, voffB);
            PG8_WAIT_V(6); PG8_BAR; PG8_MMA(1, 1, At, B1); PG8_BAR;
            PG8_LDB(B0, 1, 0); PG8_SCHED; PG8_LDA(At, 1, 0); PG8_STAGE(PG8_SA(0, 1), a2 + hstep, voffA);
            PG8_WAIT_L(8); PG8_BAR; PG8_WAIT_L(0); PG8_MMA(0, 0, At, B0); PG8_BAR; PG8_SCHED;
            PG8_LDB(B1, 1, 1); PG8_STAGE(PG8_SB(1, 0), b3, voffB);
            PG8_BAR; PG8_WAIT_L(0); PG8_MMA(0, 1, At, B1); PG8_BAR;
            PG8_LDA(At, 1, 1); PG8_STAGE(PG8_SA(1, 0), a3, voffA);
            PG8_BAR; PG8_WAIT_L(0); PG8_MMA(1, 0, At, B0); PG8_BAR; PG8_SCHED;
            PG8_STAGE(PG8_SB(1, 1), b3 + hstep, voffB);
            PG8_WAIT_V(6); PG8_BAR; PG8_MMA(1, 1, At, B1); PG8_BAR;
            }
        }
        if constexpr (ALIGN_EPI) { if (wr == 0) PG8_BAR; }
        if constexpr (!Epi::AFTER_DRAIN) { E(acc, cur, wr, wc, fr, fq); S.done(cur); }
        if (!has_next) break;
#pragma unroll
        for (int a = 0; a < 2; ++a)
#pragma unroll
            for (int b = 0; b < 2; ++b)
#pragma unroll
                for (int m = 0; m < 4; ++m)
#pragma unroll
                    for (int n = 0; n < 2; ++n) acc[a][b][m][n] = (f32x4){0.f, 0.f, 0.f, 0.f};
        cur = nxt; cA = nA; cB = nB; ++ui;
        if constexpr (ALIGN_EPI) { if (wr == 1) PG8_BAR; }
    }
    PG8_WAIT_V(0);
    if constexpr (!ALIGN_EPI) { if (wr == 0) PG8_BAR; }
    PG8_BAR;
    if constexpr (Epi::AFTER_DRAIN) { E.fused(acc, cur, wr, wc, fr, fq, lds, wid, lane); S.done(cur); }
#undef PG8_SA
#undef PG8_SB
#undef PG8_STAGE
#undef PG8_LDA
#undef PG8_LDB
#undef PG8_MMA
#undef PG8_WAIT_V
#undef PG8_WAIT_L
#undef PG8_BAR
#undef PG8_SCHED
}
}
namespace attn_body {
using bf16=__hip_bfloat16;
using bf16x8=__attribute__((ext_vector_type(8)))short;
using s16x4=__attribute__((ext_vector_type(4)))short;
using f32x16=__attribute__((ext_vector_type(16)))float;
using u32x4=__attribute__((ext_vector_type(4)))unsigned;
constexpr int BATCH=4,NHEAD=8,SEQ=4096,D=64,PQ=3072,PO=1024;
typedef float f32x4_t __attribute__((ext_vector_type(4)));
__device__ __forceinline__ int lane_now(){int l;asm volatile("v_mbcnt_lo_u32_b32 %0, -1, 0\n\tv_mbcnt_hi_u32_b32 %0, -1, %0":"=v"(l));return l;}
constexpr int NW=8,QBLK=32,QB=QBLK*NW,KVBLK=64,NQB=SEQ/QB;
constexpr int ATTN_UNIT_ROWS=QB;
__device__ __forceinline__ int crow(int r,int hi){return (r&3)+8*(r>>2)+4*hi;}
#define SBAR() __builtin_amdgcn_sched_barrier(0)
__device__ __forceinline__ void cmask(f32x16&p0,f32x16&p1,int jb,int qrel,int hi){
  const float NEG=-INFINITY; int kb=64*jb+4*hi;
  #pragma unroll
  for(int r=0;r<16;++r){int kv=kb+(r&3)+8*(r>>2); if(kv>qrel)p0[r]=NEG; if(kv+32>qrel)p1[r]=NEG;}
}

constexpr int NSLOT=3, SLOTB=8192;
constexpr int LDS_K=0, LDS_V=NSLOT*SLOTB, LDS_WS=2*NSLOT*SLOTB, LDS_OST=LDS_WS+NW*64*4, LDS_BYTES=LDS_OST+NW*4096;
constexpr float C2=0.125f*1.4426950408889634f;
__device__ __forceinline__ void glds16(const void*gsrc,unsigned lds_dst){unsigned keep;
  asm volatile("s_mov_b32 %0, m0\n\ts_mov_b32 m0, %2\n\ts_nop 0\n\tglobal_load_lds_dwordx4 %1, off\n\ts_mov_b32 m0, %0":"=&s"(keep):"v"(gsrc),"s"(lds_dst):"memory");}
__device__ __forceinline__ float max3f(float a,float b,float c){float r;asm("v_max3_f32 %0, %1, %2, %3":"=v"(r):"v"(a),"v"(b),"v"(c));return r;}
__device__ __forceinline__ float max2f(float a,float b){float r;asm("v_max_f32_e32 %0, %1, %2":"=v"(r):"v"(a),"v"(b));return r;}
__device__ __forceinline__ float fadd_s(float a,float b){float r;asm("v_add_f32_e32 %0, %1, %2":"=v"(r):"v"(a),"v"(b));return r;}
__device__ __forceinline__ float fsub_s(float a,float b){float r;asm("v_sub_f32_e32 %0, %1, %2":"=v"(r):"v"(a),"v"(b));return r;}
typedef float f32x2_t __attribute__((ext_vector_type(2))); typedef __bf16 bf16x2_t __attribute__((ext_vector_type(2)));
__device__ __forceinline__ unsigned cvtpk_s(float lo,float hi){f32x2_t v={lo,hi};bf16x2_t b=__builtin_convertvector(v,bf16x2_t);return __builtin_bit_cast(unsigned,b);}
#define WAIT_BAR(N) asm volatile("s_waitcnt vmcnt(" #N ") lgkmcnt(0)\n\ts_barrier":::"memory")

__device__ __forceinline__ void qkt(f32x16&p0,f32x16&p1,const char*Kslot,const bf16x8*qr,int r32,int hi){ const f32x16 negm=f32x16{};
  const char*kb=Kslot+hi*1024+r32*16;
  #pragma unroll
  for(int d0=0;d0<4;++d0){
    const bf16x8 b0=*reinterpret_cast<const bf16x8*>(kb+d0*2048);
    const bf16x8 b1=*reinterpret_cast<const bf16x8*>(kb+d0*2048+512);
    if(d0==0){p0=__builtin_amdgcn_mfma_f32_32x32x16_bf16(b0,qr[0],negm,0,0,0);p1=__builtin_amdgcn_mfma_f32_32x32x16_bf16(b1,qr[0],negm,0,0,0);}
    else{p0=__builtin_amdgcn_mfma_f32_32x32x16_bf16(b0,qr[d0],p0,0,0,0);p1=__builtin_amdgcn_mfma_f32_32x32x16_bf16(b1,qr[d0],p1,0,0,0);}}
}
typedef __attribute__((address_space(3))) const char* lds_cptr;
typedef short v4i16_t __attribute__((ext_vector_type(4)));
__device__ __forceinline__ void kload8(bf16x8*kf,lds_cptr kp){
  kf[0]=*(const __attribute__((address_space(3))) bf16x8*)(kp);      kf[1]=*(const __attribute__((address_space(3))) bf16x8*)(kp+512);
  kf[2]=*(const __attribute__((address_space(3))) bf16x8*)(kp+2048); kf[3]=*(const __attribute__((address_space(3))) bf16x8*)(kp+2560);
  kf[4]=*(const __attribute__((address_space(3))) bf16x8*)(kp+4096); kf[5]=*(const __attribute__((address_space(3))) bf16x8*)(kp+4608);
  kf[6]=*(const __attribute__((address_space(3))) bf16x8*)(kp+6144); kf[7]=*(const __attribute__((address_space(3))) bf16x8*)(kp+6656);
}
__device__ __forceinline__ void kload2(bf16x8*kf,lds_cptr kp,int j){ kf[2*j]=*(const __attribute__((address_space(3))) bf16x8*)(kp+j*2048); kf[2*j+1]=*(const __attribute__((address_space(3))) bf16x8*)(kp+j*2048+512); }
__device__ __forceinline__ s16x4 vtr(lds_cptr p){ return __builtin_bit_cast(s16x4,__builtin_amdgcn_ds_read_tr16_b64_v4i16((__attribute__((address_space(3))) v4i16_t*)p)); }
__device__ __forceinline__ float rowmax(const f32x16&p0,const f32x16&p1){
  float a=max3f(p0[0],p0[1],p1[0]),b=max3f(p0[2],p0[3],p1[1]);a=max3f(a,p1[2],p1[3]);
  #pragma unroll
  for(int r=4;r<16;r+=4){a=max3f(a,p0[r],p0[r+1]);b=max3f(b,p0[r+2],p0[r+3]);a=max3f(a,p1[r],p1[r+1]);b=max3f(b,p1[r+2],p1[r+3]);}
  const float m=max2f(a,b);
  auto rr=__builtin_amdgcn_permlane32_swap(__float_as_uint(m),__float_as_uint(m),false,false);
  return max2f(__uint_as_float(rr[0]),__uint_as_float(rr[1]));
}
__device__ __forceinline__ void pv(f32x16*o,int vb,bf16x8 pa0,bf16x8 pa1,bf16x8 pa2,bf16x8 pa3){
  #pragma unroll
  for(int d0=0;d0<2;++d0){s16x4 lo[4],hi[4];
    #pragma unroll
    for(int ks=0;ks<4;++ks){
      asm volatile("ds_read_b64_tr_b16 %0,%1 offset:%c2":"=&v"(lo[ks]):"v"(vb),"i"(d0*4096+ks*1024):"memory");
      asm volatile("ds_read_b64_tr_b16 %0,%1 offset:%c2":"=&v"(hi[ks]):"v"(vb),"i"(d0*4096+ks*1024+512):"memory");}
    asm volatile("s_waitcnt lgkmcnt(0)":::"memory");SBAR();
    #define PK(k) (bf16x8){lo[k][0],lo[k][1],lo[k][2],lo[k][3],hi[k][0],hi[k][1],hi[k][2],hi[k][3]}
    o[d0]=__builtin_amdgcn_mfma_f32_32x32x16_bf16(pa0,PK(0),o[d0],0,0,0);
    o[d0]=__builtin_amdgcn_mfma_f32_32x32x16_bf16(pa1,PK(1),o[d0],0,0,0);
    o[d0]=__builtin_amdgcn_mfma_f32_32x32x16_bf16(pa2,PK(2),o[d0],0,0,0);
    o[d0]=__builtin_amdgcn_mfma_f32_32x32x16_bf16(pa3,PK(3),o[d0],0,0,0);
    #undef PK
  }
}

#ifndef ATTN_STORE16
#define ATTN_STORE16(p,v) (*(u32x4*)(p)=(v))
#endif
template<int THRL> __device__ __forceinline__ void attn_unit(int b,int h,int qb,const bf16*Q,const bf16*__restrict__ K,const bf16*__restrict__ V,bf16*O,char*shm,const char*cs,int t0){
  const int tid=pg8::tid_now(),lane=tid&63,r32=lane&31,hi=lane>>5; const int wid=__builtin_amdgcn_readfirstlane(tid>>6);
  const long rowbase=(long)b*SEQ; const int q0=qb*QB;
  const bf16*Qw=Q+(rowbase+q0+wid*QBLK)*PQ+h*D;
  const bf16*Kh=K+(rowbase+(long)t0*KVBLK)*PQ+h*D,*Vh=V+(rowbase+(long)t0*KVBLK)*PQ+h*D;
  const unsigned lds0=(unsigned)(uintptr_t)shm;
  float*wsf=(float*)(shm+LDS_WS)+wid*64;
  const bf16*ksrc=Kh+(long)lane*PQ+wid*8;
  const bf16*vsrc=Vh+(long)(16*(wid&3)+(lane>>2))*PQ+(wid>>2)*32+(lane&3)*8;
  const unsigned kdst=lds0+LDS_K+wid*1024, vdst=lds0+LDS_V+wid*1024;
  #define DMA_K(t,slot) glds16(ksrc+(long)(t)*KVBLK*PQ,(unsigned)__builtin_amdgcn_readfirstlane(kdst+(slot)))
  #define DMA_V(t,slot) glds16(vsrc+(long)(t)*KVBLK*PQ,(unsigned)__builtin_amdgcn_readfirstlane(vdst+(slot)))
  const int vb0=(int)(lds0+LDS_V)+((lane>>4)&1)*32+(lane&3)*8+(4*hi+((lane&15)>>2))*64;
  const char*Kbase=shm+LDS_K; bf16x8 kf[8];
  const lds_cptr shm3=(lds_cptr)shm; const lds_cptr kp0=shm3+LDS_K+hi*1024+r32*16; const lds_cptr vp0=shm3+LDS_V+((lane>>4)&1)*32+(lane&3)*8+(4*hi+((lane&15)>>2))*64;
  const int NT=(q0+QB)/KVBLK-t0;
  DMA_K(0,0);DMA_V(0,0);DMA_K(1,SLOTB);
  bf16x8 qr[4];
  #pragma unroll
  for(int d0=0;d0<4;++d0)qr[d0]=*reinterpret_cast<const bf16x8*>(&Qw[(long)r32*PQ+d0*16+hi*8]);
  float mhat=0.f,l_reg=0.f;f32x16 o[2];o[0]=f32x16{};o[1]=f32x16{};const f32x16 zero16=f32x16{};
  const int qrel=wid*QBLK+r32;
  #define CMASK(P0,P1,t) do{int jb_=(t)-(NT-4); if(jb_>=0)cmask(P0,P1,jb_,qrel,hi);}while(0)
  const lds_cptr csb=(lds_cptr)cs+hi*16+t0*256;
  #define BIAS(P0,P1,t) do{ const __attribute__((address_space(3))) f32x4_t* cb_=(const __attribute__((address_space(3))) f32x4_t*)(csb+(t)*256); const float nm_=-mhat; \
    _Pragma("unroll") for(int g_=0;g_<4;++g_){ const f32x4_t v0_=cb_[2*g_]+nm_; \
      P0[4*g_]+=v0_[0];P0[4*g_+1]+=v0_[1];P0[4*g_+2]+=v0_[2];P0[4*g_+3]+=v0_[3]; if(g_&1)SBAR(); } \
    _Pragma("unroll") for(int g_=0;g_<4;++g_){ const f32x4_t v1_=cb_[8+2*g_]+nm_; \
      P1[4*g_]+=v1_[0];P1[4*g_+1]+=v1_[1];P1[4*g_+2]+=v1_[2];P1[4*g_+3]+=v1_[3]; if(g_&1)SBAR(); } }while(0)
  bool resc=false;
  #define START(P0,P1) do{ const float rm=rowmax(P0,P1); resc=false; \
    { const float dl=rm; mhat=fadd_s(mhat,dl); \
      _Pragma("unroll") for(int r=0;r<16;++r){P0[r]=fsub_s(P0[r],dl);P1[r]=fsub_s(P1[r],dl);} \
    } \
    _Pragma("unroll") for(int r=0;r<16;++r)P0[r]=__builtin_amdgcn_exp2f(P0[r]); }while(0)
  #define RESC() do{ if(resc){ asm volatile("s_waitcnt lgkmcnt(0)":::"memory"); \
      _Pragma("unroll") for(int d_=0;d_<2;++d_) _Pragma("unroll") for(int r=0;r<16;++r)o[d_][r]*=wsf[crow(r,hi)]; } }while(0)
  f32x16 pA0,pA1,pB0,pB1;
  int sl_prev=0,sl_cur=0,sl_next=SLOTB;
  #define ROT() do{sl_prev=sl_cur;sl_cur=sl_next;sl_next=(sl_next==(NSLOT-1)*SLOTB)?0:sl_next+SLOTB;}while(0)
  DMA_K(2,2*SLOTB);
  WAIT_BAR(3);
  qkt(pA0,pA1,Kbase,qr,r32,hi);asm volatile("s_nop 15\n\ts_nop 7":"+v"(pA0),"+v"(pA1));BIAS(pA0,pA1,0);CMASK(pA0,pA1,0);
  START(pA0,pA1);
  _Pragma("unroll") for(int r=0;r<16;++r)pA1[r]=__builtin_amdgcn_exp2f(pA1[r]);
  WAIT_BAR(0);
  DMA_K(3,0);DMA_V(1,SLOTB);
  ROT();
  kload8(kf,kp0+sl_cur);
  WAIT_BAR(2);
  s16x4 vlo[8],vhi[8]; u32x4 pw0,pw1,pw2,pw3;
  #define PKW(P,B) cvtpk_s(P[B],P[B+1])
  #define PAF(k) __builtin_bit_cast(bf16x8,pw##k)
  #define VFR(i) (bf16x8){vlo[i][0],vlo[i][1],vlo[i][2],vlo[i][3],vhi[i][0],vhi[i][1],vhi[i][2],vhi[i][3]}
  #define PIN(x) asm volatile("":"+v"(x))
  #define MX3(a,b,c) __builtin_fmaxf(__builtin_fmaxf((a),(b)),(c))
  #define GAPA(MF,A0,A1,A2,A3,W0,W1,PW) do{ MF; sacc+=A0; sacc+=A1; sacc+=A2; sacc+=A3; PIN(sacc); W0; W1; PIN(PW); SBAR(); }while(0)
  #define EX(v) __builtin_amdgcn_exp2f(v)
  #define GAPB(MF,X,B) do{ MF; X[B]=EX(X[B]); X[B+1]=EX(X[B+1]); X[B+2]=EX(X[B+2]); X[B+3]=EX(X[B+3]); PIN(X); SBAR(); }while(0)
  #define VRD(i) do{ vlo[i]=vtr(vp_+(((i)>>2)*4096+((i)&3)*1024)); vhi[i]=vtr(vp_+(((i)>>2)*4096+((i)&3)*1024+512)); }while(0)
  #define KRD(G,j) do{ if(G){ kload2(kf,kp0+sl_next,j); SBAR(); } }while(0)
  #define STEP(C0,C1,P0,P1,t,GK,GV,GL) do{ SBAR(); \
    const lds_cptr vp_=vp0+sl_prev; \
    VRD(0); SBAR(); float sacc=(P0[0]+P0[1]); \
    GAPA(C0=__builtin_amdgcn_mfma_f32_32x32x16_bf16(kf[0],qr[0],zero16,0,0,0), P0[2],P0[3],P0[4],P0[5],     pw0[0]=PKW(P0,0), pw0[1]=PKW(P0,2), pw0); \
    VRD(4); SBAR(); GAPA(C1=__builtin_amdgcn_mfma_f32_32x32x16_bf16(kf[1],qr[0],zero16,0,0,0), P0[6],P0[7],P0[8],P0[9],     pw0[2]=PKW(P0,4), pw0[3]=PKW(P0,6), pw0); \
    VRD(1); SBAR(); GAPA(C0=__builtin_amdgcn_mfma_f32_32x32x16_bf16(kf[2],qr[1],C0,0,0,0),   P0[10],P0[11],P0[12],P0[13], pw1[0]=PKW(P0,8), pw1[1]=PKW(P0,10), pw1); \
    VRD(5); SBAR(); GAPA(C1=__builtin_amdgcn_mfma_f32_32x32x16_bf16(kf[3],qr[1],C1,0,0,0),   P0[14],P0[15],P1[0],P1[1],   pw1[2]=PKW(P0,12),pw1[3]=PKW(P0,14), pw1); \
    VRD(2); SBAR(); GAPA(C0=__builtin_amdgcn_mfma_f32_32x32x16_bf16(kf[4],qr[2],C0,0,0,0),   P1[2],P1[3],P1[4],P1[5],     pw2[0]=PKW(P1,0), pw2[1]=PKW(P1,2), pw2); \
    VRD(6); SBAR(); GAPA(C1=__builtin_amdgcn_mfma_f32_32x32x16_bf16(kf[5],qr[2],C1,0,0,0),   P1[6],P1[7],P1[8],P1[9],     pw2[2]=PKW(P1,4), pw2[3]=PKW(P1,6), pw2); \
    VRD(3); SBAR(); GAPA(C0=__builtin_amdgcn_mfma_f32_32x32x16_bf16(kf[6],qr[3],C0,0,0,0),   P1[10],P1[11],P1[12],P1[13], pw3[0]=PKW(P1,8), pw3[1]=PKW(P1,10), pw3); \
    VRD(7); SBAR(); GAPA(C1=__builtin_amdgcn_mfma_f32_32x32x16_bf16(kf[7],qr[3],C1,0,0,0),   P1[14],P1[15],0.f,0.f,       pw3[2]=PKW(P1,12),pw3[3]=PKW(P1,14), pw3); \
    l_reg+=sacc; \
    if(GK){DMA_K((t)+3,sl_cur);} if(GV){DMA_V((t)+1,sl_next);} \
    BIAS(C0,C1,t); CMASK(C0,C1,t); \
    { float a=MX3(C0[0],C0[1],C1[0]),b=MX3(C0[2],C0[3],C1[1]); a=MX3(a,C1[2],C1[3]); \
      _Pragma("unroll") for(int r=4;r<16;r+=4){a=MX3(a,C0[r],C0[r+1]);b=MX3(b,C0[r+2],C0[r+3]);a=MX3(a,C1[r],C1[r+1]);b=MX3(b,C1[r+2],C1[r+3]);} \
      float rm=__builtin_fmaxf(a,b); { auto rr=__builtin_amdgcn_permlane32_swap(__float_as_uint(rm),__float_as_uint(rm),false,false); rm=__builtin_fmaxf(__uint_as_float(rr[0]),__uint_as_float(rr[1])); } \
      resc=false; \
      if(__builtin_expect(__any(rm>(float)THRL),0)){ const float dl=__builtin_fmaxf(rm,0.f); mhat+=dl; \
        _Pragma("unroll") for(int r=0;r<16;++r){C0[r]-=dl;C1[r]-=dl;} \
        const float f=__builtin_amdgcn_exp2f(-dl); l_reg*=f; if(hi==0)wsf[r32]=f; resc=true; } } \
    SBAR(); \
    GAPB(o[0]=__builtin_amdgcn_mfma_f32_32x32x16_bf16(PAF(0),VFR(0),o[0],0,0,0), C0,0); \
    GAPB(o[1]=__builtin_amdgcn_mfma_f32_32x32x16_bf16(PAF(0),VFR(4),o[1],0,0,0), C0,4); \
    KRD(GL,0); GAPB(o[0]=__builtin_amdgcn_mfma_f32_32x32x16_bf16(PAF(1),VFR(1),o[0],0,0,0), C0,8); \
    KRD(GL,1); GAPB(o[1]=__builtin_amdgcn_mfma_f32_32x32x16_bf16(PAF(1),VFR(5),o[1],0,0,0), C0,12); \
    KRD(GL,2); GAPB(o[0]=__builtin_amdgcn_mfma_f32_32x32x16_bf16(PAF(2),VFR(2),o[0],0,0,0), C1,0); \
    KRD(GL,3); GAPB(o[1]=__builtin_amdgcn_mfma_f32_32x32x16_bf16(PAF(2),VFR(6),o[1],0,0,0), C1,4); \
    GAPB(o[0]=__builtin_amdgcn_mfma_f32_32x32x16_bf16(PAF(3),VFR(3),o[0],0,0,0), C1,8); \
    GAPB(o[1]=__builtin_amdgcn_mfma_f32_32x32x16_bf16(PAF(3),VFR(7),o[1],0,0,0), C1,12); \
    }while(0)
  int t=1;
  #undef CMASK
  #define CMASK(P0,P1,t) do{}while(0)
  for(;t+5<NT;t+=2){
    STEP(pB0,pB1,pA0,pA1,t,true,true,true);     WAIT_BAR(2); RESC(); ROT();
    STEP(pA0,pA1,pB0,pB1,t+1,true,true,true);   WAIT_BAR(2); RESC(); ROT();
  }
  #undef CMASK
  #define CMASK(P0,P1,t) do{int jb_=(t)-(NT-4); if(jb_>=0)cmask(P0,P1,jb_,qrel,hi);}while(0)
  #define ENDW(tt) do{ if((tt)+3<NT){WAIT_BAR(2);} else if((tt)+2<NT){WAIT_BAR(1);} else {WAIT_BAR(0);} }while(0)
  for(;t+1<NT;t+=2){
    STEP(pB0,pB1,pA0,pA1,t,(t+3<NT),(t+1<NT),(t+1<NT));       ENDW(t);   RESC(); ROT();
    STEP(pA0,pA1,pB0,pB1,t+1,(t+4<NT),(t+2<NT),(t+2<NT));     ENDW(t+1); RESC(); ROT();
  }
  STEP(pB0,pB1,pA0,pA1,NT-1,false,false,false); RESC();
  { float sacc=pB0[0]+pB0[1]; _Pragma("unroll") for(int r=2;r<16;++r)sacc+=pB0[r]; _Pragma("unroll") for(int r=0;r<16;++r)sacc+=pB1[r]; l_reg+=sacc;
    pw0=(u32x4){PKW(pB0,0),PKW(pB0,2),PKW(pB0,4),PKW(pB0,6)};pw1=(u32x4){PKW(pB0,8),PKW(pB0,10),PKW(pB0,12),PKW(pB0,14)};pw2=(u32x4){PKW(pB1,0),PKW(pB1,2),PKW(pB1,4),PKW(pB1,6)};pw3=(u32x4){PKW(pB1,8),PKW(pB1,10),PKW(pB1,12),PKW(pB1,14)};
    SBAR(); pv(o,vb0+sl_cur,PAF(0),PAF(1),PAF(2),PAF(3)); }
  #undef PKW
  #undef PAF
  #undef VFR
  #undef PIN
  #undef MX3
  #undef GAPA
  #undef GAPB
  #undef EX
  #undef VRD
  #undef KRD
  #undef STEP
  #undef ENDW
  {auto rr=__builtin_amdgcn_permlane32_swap(__float_as_uint(l_reg),__float_as_uint(l_reg),false,false);l_reg=__uint_as_float(rr[0])+__uint_as_float(rr[1]);}
  if(hi==0)wsf[32+r32]=l_reg;asm volatile("s_waitcnt lgkmcnt(0)":::"memory");
  float rli[16];
  #pragma unroll
  for(int r=0;r<16;++r)rli[r]=__builtin_amdgcn_rcpf(wsf[32+crow(r,hi)]);
  bf16*Ow=O+(rowbase+q0+wid*QBLK)*PO+h*D;
  { bf16*stg=(bf16*)(shm+LDS_OST)+wid*2048;
    #pragma unroll
    for(int r=0;r<16;++r){const int orow=crow(r,hi);
      #pragma unroll
      for(int d0=0;d0<2;++d0)stg[orow*64+d0*32+r32]=__float2bfloat16(o[d0][r]*rli[r]);}
    asm volatile("s_waitcnt lgkmcnt(0)":::"memory");
    const int le_=lane_now();
    #pragma unroll
    for(int i=0;i<4;++i){const int row=i*8+(le_>>3),ch=le_&7; const u32x4 v=*(const u32x4*)(stg+row*64+ch*8); ATTN_STORE16(Ow+(long)row*PO+ch*8,v);} }
  asm volatile("s_waitcnt lgkmcnt(0)\n\ts_barrier":::"memory");
  #undef BIAS
  #undef DMA_K
  #undef DMA_V
  #undef CMASK
  #undef START
  #undef RESC
  #undef ROT
}
constexpr int ATTN_LDS_BYTES=LDS_BYTES;
#undef SBAR
#undef WAIT_BAR
}

#ifndef MK_ONE_LAUNCH
#define MK_ONE_LAUNCH 1
#endif
constexpr int NWAVES = 8, NTHR = NWAVES * 64;
constexpr int Bsz = 4, S = 4096, T = Bsz * S, DM = 1024, NL = 2;
constexpr int NCH = S / 64;
constexpr int C_XA = 0, C_GA = 256, C_Q = 512, C_K = 1024, C_V = 1536, C_FL = 2048, C_P = 2056;
constexpr int C_R = C_P, C_RK = C_P + 256, C_RV = C_P + 512, C_WD = C_P + 768, C_AD = C_P + 800, C_GD = C_P + 832, DIN = C_P + 896, NP = 3072, RCOLS = 896;
constexpr int NE = 16, DE = 256, MAXTILES = 144;
constexpr float L2E = 1.4426950408889634f;
constexpr int NPH = 10;
enum { PH_PRE = 0, PH_GIN, PH_PREP, PH_MIX, PH_POST, PH_GOUT, PH_ROUTE, PH_PLACE, PH_MOE1, PH_MOE2 };
constexpr int PH_FIN = NL * NPH, N_PHASES = PH_FIN + 1;
enum { I_X = 0, I_N1G, I_WIN, I_CONVW, I_CONVB, I_WA, I_BA, I_WX, I_BX, I_LAM, I_LNG, I_FB, I_QNG, I_KNG, I_FNG, I_MU, I_W0, I_W2, I_A0, I_A2, I_G2, I_KK, I_KA, I_RK, I_RLG, I_RLB,
       I_WOUT, I_N2G, I_RGW, I_RGB, I_REW, I_REB, I_EG, I_EU, I_ED, N_IN };

constexpr size_t MiB = 1u << 20;
constexpr size_t WS_CTL = 0, CTL_ZERO_BYTES = 1 * MiB;
constexpr size_t WS_WRH = 1 * MiB, WS_WRL = WS_WRH + 64 * 1024;
constexpr size_t WS_LRUW = WS_WRH + 128 * 1024;
constexpr size_t WS_RWW = WS_WRH + 192 * 1024;
constexpr size_t WS_WIN = 2 * MiB, WS_WOUT = 8 * MiB, WS_WGU = 10 * MiB, WS_WD = 26 * MiB;
constexpr size_t WS_H = 34 * MiB;
constexpr size_t WS_PROJ = 66 * MiB;
constexpr size_t WS_Y = 162 * MiB;
constexpr size_t WS_HLOC = 194 * MiB, WS_CUMA = 202 * MiB;
constexpr size_t WS_ORAW = 210 * MiB;
constexpr size_t WS_CARRY = WS_ORAW + 9 * MiB;
constexpr size_t WS_G = 226 * MiB, WS_VS = 234 * MiB;
constexpr size_t WS_CLOC = 242 * MiB, WS_BON = WS_CLOC + 512 * 1024, WS_AAGG = WS_BON + 256 * 1024, WS_HAGG = WS_AAGG + 256 * 1024, WS_CTOT = WS_HAGG + 256 * 1024;
constexpr size_t WS_TOKE = 244 * MiB, WS_TOKW = WS_TOKE + 128 * 1024, WS_TSLOT = WS_TOKW + 128 * 1024;
constexpr size_t WS_ASORT = 66 * MiB, WS_HID = 138 * MiB, WS_STOK = 156 * MiB, WS_SW = 157 * MiB;
constexpr size_t WS_TR = WS_TSLOT + 128 * 1024, WS_SR = WS_SW + 512 * 1024;
constexpr size_t WS_YE = WS_ASORT;
constexpr size_t WS_END = 256 * MiB;
static_assert(WS_ASORT + (size_t)MAXTILES * 256 * 1024 * 2 <= WS_HID && WS_HID + (size_t)MAXTILES * 256 * 256 * 2 <= WS_STOK && WS_SW + MAXTILES * 256 * 4 <= WS_Y, "MoE overlay");
static_assert(WS_PROJ + (size_t)T * NP * 2 <= WS_Y && WS_CTOT + 4 * 64 * 8 * 4 <= WS_TOKE && WS_TR + 64 * 1024 <= WS_END && WS_SR + MAXTILES * 256 * 4 <= WS_Y, "d_ws map");

constexpr int CW_TMO = 0;
constexpr int CW_BAR = 4096;
constexpr int CW_CNT0 = 8192, CW_CUR0 = 8192 + 64, CW_Q0 = 8192 + 128, CW_LSTRIDE = 256;

constexpr int LDS_BYTES = 160 * 1024;
constexpr int MISC_OFF = LDS_BYTES - 256;
constexpr int LDS_TAB = 131072;

#define GAS __attribute__((address_space(1)))
#define LAS __attribute__((address_space(3)))
typedef unsigned short bf16;
typedef unsigned v4u __attribute__((ext_vector_type(4)));
typedef unsigned v2u __attribute__((ext_vector_type(2)));
typedef float f32x4 __attribute__((ext_vector_type(4)));
typedef short bf16x8 __attribute__((ext_vector_type(8)));
typedef GAS unsigned gu32;
#define RLX_AGENT __ATOMIC_RELAXED, __HIP_MEMORY_SCOPE_AGENT
typedef float f32x2_ __attribute__((ext_vector_type(2))); typedef __bf16 bf16x2_ __attribute__((ext_vector_type(2)));
__device__ __forceinline__ unsigned pk2(float lo, float hi) { f32x2_ v = {lo, hi}; bf16x2_ b = __builtin_convertvector(v, bf16x2_); return __builtin_bit_cast(unsigned, b); }
__device__ __forceinline__ unsigned f2bf(float f) { return pk2(f, 0.f) & 0xffffu; }
__device__ __forceinline__ float bf2f(bf16 v) { return __builtin_bit_cast(float, (unsigned)v << 16); }
__device__ __forceinline__ float bflo(unsigned w) { return __builtin_bit_cast(float, w << 16); }
__device__ __forceinline__ float bfhi(unsigned w) { return __builtin_bit_cast(float, w & 0xffff0000u); }
__device__ __forceinline__ float sigmoidf_(float x) { return 1.f / (1.f + __expf(-x)); }
__device__ __forceinline__ float softplusf_(float x) { return fmaxf(x, 0.f) + log1pf(__expf(-fabsf(x))); }
__device__ __forceinline__ float softplus_fast(float x) { return fmaxf(x, 0.f) + __logf(1.f + __expf(-fabsf(x))); }
__device__ __forceinline__ float wave_sum(float v) {
#pragma unroll
    for (int o = 1; o < 64; o <<= 1) v += __shfl_xor(v, o);
    return v;
}
#define XB_TMO      128
#define XB_XCNT(j)  (256  + 64 * (j))
#define XB_XSUB(j)  (1280 + 64 * (j))
#define XB_XGEN(j)  (2304 + 64 * (j))
#define XB_TOP      3328
#define XB_TOPGEN   3392
#define XCD_BAR_WORDS 3456
#define XB_SPIN_CAP (1u << 21)

__device__ __forceinline__ unsigned xb_ld(unsigned* p)              { return __hip_atomic_load(p, __ATOMIC_RELAXED, __HIP_MEMORY_SCOPE_AGENT); }
__device__ __forceinline__ unsigned xb_add(unsigned* p, unsigned v) { return __hip_atomic_fetch_add(p, v, __ATOMIC_RELAXED, __HIP_MEMORY_SCOPE_AGENT); }
__device__ __forceinline__ unsigned xb_xcc_id() { return (unsigned)__builtin_amdgcn_s_getreg((3 << 11) | 20) & 0xFu; }
#define XB_SPIN(cond, bar) do { unsigned _sp = 0; while (cond) { __builtin_amdgcn_s_sleep(1); \
    if ((++_sp & 255u) == 0u) { if (xb_ld(&(bar)[XB_TMO])) break; if (_sp > XB_SPIN_CAP) { atomicAdd(&(bar)[XB_TMO], 1u); break; } } } } while (0)

struct XcdBarrier {
    unsigned* bar; unsigned x;
    volatile LAS unsigned* st;
};

__device__ __forceinline__ XcdBarrier xcd_barrier_post(unsigned* bar, volatile LAS unsigned* st) {
    XcdBarrier b; b.bar = bar; b.x = xb_xcc_id(); b.st = st;
    if (threadIdx.x == 0) (void)xb_add(&bar[XB_XCNT(b.x)], 1u);
    return b;
}
__device__ __forceinline__ void xcd_barrier_complete(unsigned* bar, unsigned x, unsigned& nloc, unsigned& nx) {
    const unsigned G = gridDim.x * gridDim.y * gridDim.z;
    unsigned sum, cnt, mine, sp = 0u;
    for (;;) {
        sum = 0u; cnt = 0u; mine = 0u;
#pragma unroll
        for (unsigned j = 0; j < 16; ++j) { const unsigned c = xb_ld(&bar[XB_XCNT(j)]); sum += c; cnt += (c > 0u) ? 1u : 0u; mine = (j == x) ? c : mine; }
        if (sum == G) break;
        __builtin_amdgcn_s_sleep(1);
        if ((++sp & 255u) == 0u) { if (xb_ld(&bar[XB_TMO])) break; if (sp > XB_SPIN_CAP) { atomicAdd(&bar[XB_TMO], 1u); break; } }
    }
    nloc = mine > 0u ? mine : 1u; nx = cnt > 0u ? cnt : 1u;
}

__device__ __forceinline__ void xcd_barrier(const XcdBarrier& b) {
    asm volatile("s_waitcnt vmcnt(0)" ::: "memory");
    __syncthreads();
    if (threadIdx.x == 0) {
        unsigned* bar = b.bar;
        __builtin_amdgcn_s_waitcnt(0);
        unsigned nloc = b.st[0], nx = b.st[1];
        if (nloc == 0u) { xcd_barrier_complete(bar, b.x, nloc, nx); b.st[0] = nloc; b.st[1] = nx; }
        const unsigned old = xb_add(&bar[XB_XSUB(b.x)], 1u);
        const unsigned gen = old / nloc;
        if (old + 1u == (gen + 1u) * nloc) {
            __builtin_amdgcn_fence(__ATOMIC_RELEASE, "agent");
            asm volatile("s_waitcnt vmcnt(0)" ::: "memory");
            const unsigned og = xb_add(&bar[XB_TOP], 1u);
            const unsigned tg = og / nx;
            if (og + 1u == (tg + 1u) * nx) xb_add(&bar[XB_TOPGEN], 1u);
            else XB_SPIN(xb_ld(&bar[XB_TOPGEN]) == tg, bar);
            __builtin_amdgcn_fence(__ATOMIC_ACQUIRE, "agent");
            xb_add(&bar[XB_XGEN(b.x)], 1u);
            asm volatile("s_waitcnt vmcnt(0)" ::: "memory");
        } else {
            XB_SPIN(xb_ld(&bar[XB_XGEN(b.x)]) == gen, bar);
            __builtin_amdgcn_fence(__ATOMIC_ACQUIRE, "agent");
            asm volatile("s_waitcnt vmcnt(0)" ::: "memory");
        }
    }
    __syncthreads();
}

struct Args { const float* in[N_IN]; float* out; unsigned char* ws; int ph_lo, ph_hi; };
typedef const __attribute__((address_space(4))) Args* CA;
__device__ __forceinline__ CA args_now() { CA p = (CA)__builtin_amdgcn_kernarg_segment_ptr(); asm volatile("" : "+s"(p)); return p; }

__device__ __forceinline__ void tr_item(const float* W, int K, int N, const float* gk, bf16* WT, int row_off, int row_stride, float* scr, int item, int nblk, int lane) {
    const int kb = item / nblk, nb = item % nblk, k0 = 64 * kb, n0 = 32 * nb;
    const int nn = n0 + (lane & 31);
#pragma unroll 8
    for (int i = 0; i < 32; ++i) { const int kk = 2 * i + (lane >> 5); float v = (nn < N) ? W[(size_t)(k0 + kk) * N + nn] : 0.f; if (gk) v *= gk[k0 + kk]; scr[kk * 33 + (lane & 31)] = v; }
    asm volatile("s_waitcnt lgkmcnt(0)" ::: "memory");
    const int c = lane & 7;
#pragma unroll
    for (int j = 0; j < 4; ++j) { const int n = (lane >> 3) + 8 * j; const float* s = scr + (8 * c) * 33 + n;
        v4u o; o.x = pk2(s[0 * 33], s[1 * 33]); o.y = pk2(s[2 * 33], s[3 * 33]); o.z = pk2(s[4 * 33], s[5 * 33]); o.w = pk2(s[6 * 33], s[7 * 33]);
        *(v4u*)(WT + (size_t)(row_off + row_stride * (n0 + n)) * K + k0 + 8 * c) = o; }
    asm volatile("s_waitcnt lgkmcnt(0)" ::: "memory");
}
__device__ __forceinline__ void rms_row_to_bf16(const float* xrow, bf16* orow, int lane) {
    const f32x4* xr = (const f32x4*)xrow + lane;
    f32x4 v[4]; float s = 0.f;
#pragma unroll
    for (int j = 0; j < 4; ++j) { v[j] = xr[64 * j]; s += (v[j].x * v[j].x + v[j].y * v[j].y) + (v[j].z * v[j].z + v[j].w * v[j].w); }
    const float rstd = rsqrtf(wave_sum(s) * (1.f / DM) + 1e-6f);
    v2u* o8 = (v2u*)orow + lane;
#pragma unroll
    for (int j = 0; j < 4; ++j) { v2u o; o.x = pk2(v[j].x * rstd, v[j].y * rstd); o.y = pk2(v[j].z * rstd, v[j].w * rstd); o8[64 * j] = o; }
}
__device__ __forceinline__ void combine_row(float* xrow, const bf16* y0, const bf16* y1, bf16* orow, int lane) {
    f32x4* xr = (f32x4*)xrow + lane; const v2u* p0 = (const v2u*)y0 + lane; const v2u* p1 = (const v2u*)y1 + lane;
    f32x4 v[4]; float s = 0.f;
#pragma unroll
    for (int j = 0; j < 4; ++j) { v[j] = xr[64 * j]; const v2u q0 = p0[64 * j], q1 = p1[64 * j];
        v[j].x += bflo(q0.x) + bflo(q1.x); v[j].y += bfhi(q0.x) + bfhi(q1.x); v[j].z += bflo(q0.y) + bflo(q1.y); v[j].w += bfhi(q0.y) + bfhi(q1.y);
        xr[64 * j] = v[j]; s += (v[j].x * v[j].x + v[j].y * v[j].y) + (v[j].z * v[j].z + v[j].w * v[j].w); }
    if (orow) { const float rstd = rsqrtf(wave_sum(s) * (1.f / DM) + 1e-6f); v2u* o8 = (v2u*)orow + lane;
#pragma unroll
        for (int j = 0; j < 4; ++j) { v2u o; o.x = pk2(v[j].x * rstd, v[j].y * rstd); o.y = pk2(v[j].z * rstd, v[j].w * rstd); o8[64 * j] = o; } }
}
__device__ __forceinline__ void phase_pre(CA a, int l, unsigned char* lds, int tid) {
    const int lane = tid & 63, wave = tid >> 6;
    float* scr = (float*)lds + wave * (64 * 33);
    const int gw = blockIdx.x * NWAVES + wave, NGW = gridDim.x * NWAVES;
    bf16* WinT = (bf16*)(a->ws + WS_WIN); bf16* WoutT = (bf16*)(a->ws + WS_WOUT); bf16* WguT = (bf16*)(a->ws + WS_WGU); bf16* WdT = (bf16*)(a->ws + WS_WD);
    constexpr int I_IN = 16 * 96, I_OUT = 16 * 32, I_E = 16 * 128;
    constexpr int NITEMS = I_IN + I_OUT + 3 * I_E;
    for (int it = gw; it < NITEMS; it += NGW) {
        int r = it;
        if (r < I_IN) { tr_item(a->in[I_WIN] + (size_t)l * DM * DIN, DM, DIN, a->in[I_N1G] + l * DM, WinT, 0, 1, scr, r, 96, lane); continue; } r -= I_IN;
        if (r < I_OUT) { tr_item(a->in[I_WOUT] + (size_t)l * DM * DM, DM, DM, nullptr, WoutT, 0, 1, scr, r, 32, lane); continue; } r -= I_OUT;
        if (r < I_E) { const int e = r >> 7, rr = r & 127; tr_item(a->in[I_EG] + (size_t)(l * NE + e) * DM * DE, DM, DE, a->in[I_N2G] + l * DM, WguT + (size_t)e * 512 * DM, 0, 2, scr, rr, 8, lane); continue; } r -= I_E;
        if (r < I_E) { const int e = r >> 7, rr = r & 127; tr_item(a->in[I_EU] + (size_t)(l * NE + e) * DM * DE, DM, DE, a->in[I_N2G] + l * DM, WguT + (size_t)e * 512 * DM, 1, 2, scr, rr, 8, lane); continue; } r -= I_E;
        { const int e = r >> 7, rr = r & 127; tr_item(a->in[I_ED] + (size_t)(l * NE + e) * DE * DM, DE, DM, nullptr, WdT + (size_t)e * DM * DE, 0, 1, scr, rr, 32, lane); }
    }
    { bf16* WRH = (bf16*)(a->ws + WS_WRH); bf16* WRL = (bf16*)(a->ws + WS_WRL); const float* g2 = a->in[I_N2G] + l * DM; const float* gwp = a->in[I_RGW] + (size_t)l * DM * 4; const float* ewp = a->in[I_REW] + (size_t)l * DM * NE;
        for (int i = blockIdx.x * NTHR + tid; i < 32 * DM; i += gridDim.x * NTHR) { const int n = i >> 10, k = i & 1023;
            const float v = (n < 4) ? g2[k] * gwp[k * 4 + n] : ((n < 20) ? g2[k] * ewp[k * NE + n - 4] : 0.f); const unsigned hb = f2bf(v); WRH[i] = (bf16)hb; WRL[i] = (bf16)f2bf(v - bf2f((bf16)hb)); } }
    { bf16* LW = (bf16*)(a->ws + WS_LRUW);
        for (int i = blockIdx.x * NTHR + tid; i < 2 * 4 * 64 * 64; i += gridDim.x * NTHR) { const int m = i >> 14, hh = (i >> 12) & 3, jj = (i >> 6) & 63, ii = i & 63;
            LW[i] = (bf16)f2bf(a->in[m ? I_WX : I_WA][((size_t)(l * 4 + hh) * 64 + ii) * 64 + jj]); }
        bf16* RW = (bf16*)(a->ws + WS_RWW);
        for (int i = blockIdx.x * NTHR + tid; i < 2 * 8192; i += gridDim.x * NTHR) { const int m = i >> 13, hh = (i >> 11) & 3, n = (i >> 5) & 63, k = i & 31;
            RW[i] = (bf16)f2bf(a->in[m ? I_A2 : I_W2][(size_t)(l * 32 + k) * 256 + hh * 64 + n]); }
        for (int i = blockIdx.x * NTHR + tid; i < 16384; i += gridDim.x * NTHR) { const int hh = i >> 12, n = (i >> 6) & 63, k = i & 63;
            RW[16384 + i] = (bf16)f2bf(a->in[I_G2][(size_t)(l * 64 + k) * 256 + hh * 64 + n]); } }
    bf16* H = (bf16*)(a->ws + WS_H);
    if (l == 0) { for (int m = gw; m < T; m += NGW) rms_row_to_bf16(a->in[I_X] + (size_t)m * DM, H + (size_t)m * DM, lane); }
    else { const int* TS = (const int*)(a->ws + WS_TSLOT); const bf16* YE = (const bf16*)(a->ws + WS_YE);
        for (int m = gw; m < T; m += NGW) combine_row(a->out + (size_t)m * DM, YE + (size_t)TS[2 * m] * DM, YE + (size_t)TS[2 * m + 1] * DM, H + (size_t)m * DM, lane); }
}
__device__ __forceinline__ void phase_fin(CA a, int tid) {
    const int lane = tid & 63, wave = tid >> 6; const int gw = blockIdx.x * NWAVES + wave, NGW = gridDim.x * NWAVES;
    const int* TS = (const int*)(a->ws + WS_TSLOT); const bf16* YE = (const bf16*)(a->ws + WS_YE);
    for (int m = gw; m < T; m += NGW) combine_row(a->out + (size_t)m * DM, YE + (size_t)TS[2 * m] * DM, YE + (size_t)TS[2 * m + 1] * DM, nullptr, lane);
}

__device__ __forceinline__ void prep_unit(CA a, int l, int u, unsigned char* lds, int tid, bool fox = true) {
    const int b = u / NCH, c = u % NCH, t0 = c * 64; const size_t row0 = (size_t)b * S + t0;
    bf16* P = (bf16*)(a->ws + WS_PROJ);
    bf16* xcb = (bf16*)lds; float* Abuf = (float*)(lds + 33792); bf16* Bbuf = (bf16*)(lds + 99328); float* ex = (float*)(lds + 132096); float* lfb = (float*)(lds + 134144);
    const int j = tid & 255, half = tid >> 8;
    {
        const float* cw = a->in[I_CONVW] + l * 4 * 256; const float cb = a->in[I_CONVB][l * 256 + j];
        const float w0 = cw[j], w1 = cw[256 + j], w2 = cw[512 + j], w3 = cw[768 + j];
        const int tb = t0 + half * 32;
        const bf16* px = P + ((size_t)b * S) * NP + C_XA + j;
        float x3 = (tb >= 3) ? bf2f(px[(size_t)(tb - 3) * NP]) : 0.f, x2 = (tb >= 2) ? bf2f(px[(size_t)(tb - 2) * NP]) : 0.f, x1 = (tb >= 1) ? bf2f(px[(size_t)(tb - 1) * NP]) : 0.f;
#pragma unroll
        for (int tt = 0; tt < 32; ++tt) { const float x0 = bf2f(px[(size_t)(tb + tt) * NP]); const float v = cb + w0 * x3 + w1 * x2 + w2 * x1 + w3 * x0;
            xcb[(half * 32 + tt) * 264 + j] = (bf16)f2bf(v); x3 = x2; x2 = x1; x1 = x0; }
    }
    __syncthreads();
    {
        const int lane = tid & 63, wave = tid >> 6, r16 = lane & 15, q4 = lane >> 4, hh = wave >> 1;
        const bf16* LW = (const bf16*)(a->ws + WS_LRUW);
        bf16x8 ya[2][2], yx[2][2]; f32x4 bav[2], bxv[2], spv[2];
#pragma unroll
        for (int n2 = 0; n2 < 2; ++n2) { const int jl = (wave & 1) * 32 + n2 * 16 + r16, jg = wave * 32 + n2 * 16 + 4 * q4;
            ya[n2][0] = *(const bf16x8*)(LW + ((size_t)hh * 64 + jl) * 64 + q4 * 8); ya[n2][1] = *(const bf16x8*)(LW + ((size_t)hh * 64 + jl) * 64 + 32 + q4 * 8);
            yx[n2][0] = *(const bf16x8*)(LW + 16384 + ((size_t)hh * 64 + jl) * 64 + q4 * 8); yx[n2][1] = *(const bf16x8*)(LW + 16384 + ((size_t)hh * 64 + jl) * 64 + 32 + q4 * 8);
            bav[n2] = *(const f32x4*)(a->in[I_BA] + l * 256 + jg); bxv[n2] = *(const f32x4*)(a->in[I_BX] + l * 256 + jg);
            const f32x4 lam = *(const f32x4*)(a->in[I_LAM] + l * 256 + jg); spv[n2] = (f32x4){softplusf_(-lam.x), softplusf_(-lam.y), softplusf_(-lam.z), softplusf_(-lam.w)}; }
#pragma unroll
        for (int mi = 0; mi < 4; ++mi) { const int tt = mi * 16 + r16;
            const bf16x8 x0 = *(const bf16x8*)(xcb + tt * 264 + hh * 64 + q4 * 8), x1 = *(const bf16x8*)(xcb + tt * 264 + hh * 64 + 32 + q4 * 8);
#pragma unroll
            for (int n2 = 0; n2 < 2; ++n2) { const int jg = wave * 32 + n2 * 16 + 4 * q4;
                f32x4 aR = bav[n2], aI = bxv[n2];
                aR = __builtin_amdgcn_mfma_f32_16x16x32_bf16(ya[n2][0], x0, aR, 0, 0, 0); aR = __builtin_amdgcn_mfma_f32_16x16x32_bf16(ya[n2][1], x1, aR, 0, 0, 0);
                aI = __builtin_amdgcn_mfma_f32_16x16x32_bf16(yx[n2][0], x0, aI, 0, 0, 0); aI = __builtin_amdgcn_mfma_f32_16x16x32_bf16(yx[n2][1], x1, aI, 0, 0, 0);
                const v2u xw = *(const v2u*)(xcb + tt * 264 + jg); const float xc4[4] = {bflo(xw.x), bfhi(xw.x), bflo(xw.y), bfhi(xw.y)};
                f32x4 av4; float bb4[4];
#pragma unroll
                for (int e = 0; e < 4; ++e) { const float r = sigmoidf_(aR[e]), ig = sigmoidf_(aI[e]); const float la = -8.f * r * spv[n2][e]; av4[e] = __expf(la); bb4[e] = sqrtf(fmaxf(-expm1f(2.f * la), 0.f)) * (ig * xc4[e]); }
                *(f32x4*)(Abuf + tt * 256 + jg) = av4; v2u bo; bo.x = pk2(bb4[0], bb4[1]); bo.y = pk2(bb4[2], bb4[3]); *(v2u*)(Bbuf + tt * 256 + jg) = bo; } }
    }
    __syncthreads();
    float aR[32], aI[32];
    {
        float hrun = 0.f, arun = 1.f;
#pragma unroll
        for (int tt = 0; tt < 32; ++tt) { const float av = Abuf[(half * 32 + tt) * 256 + j], bb = bf2f(Bbuf[(half * 32 + tt) * 256 + j]); hrun = av * hrun + bb; arun *= av; aR[tt] = hrun; aI[tt] = arun; }
        if (half == 0) { ex[j] = hrun; ex[256 + j] = arun; }
    }
    __syncthreads();
    if (half == 1) { const float h0 = ex[j], a0 = ex[256 + j];
#pragma unroll
        for (int tt = 0; tt < 32; ++tt) { aR[tt] += aI[tt] * h0; aI[tt] *= a0; }
        ((float*)(a->ws + WS_AAGG))[(size_t)(b * NCH + c) * 256 + j] = aI[31]; ((float*)(a->ws + WS_HAGG))[(size_t)(b * NCH + c) * 256 + j] = aR[31]; }
    { bf16* HL = (bf16*)(a->ws + WS_HLOC); bf16* CA = (bf16*)(a->ws + WS_CUMA);
#pragma unroll
        for (int tt = 0; tt < 32; ++tt) { const size_t o = (row0 + half * 32 + tt) * 256 + j; HL[o] = (bf16)f2bf(aR[tt]); CA[o] = (bf16)f2bf(aI[tt]); } }
    if (fox) {
        const float* qg = a->in[I_QNG] + l * 64; const float* kg = a->in[I_KNG] + l * 64;
        for (int pass = 0; pass < 16; ++pass) { const int item = pass * 64 + (tid >> 3), sub = tid & 7; const int which = item >> 9, rem = item & 511, t = rem >> 3, h = rem & 7;
            bf16* p = P + (row0 + t) * NP + (which ? C_K : C_Q) + h * 64 + sub * 8;
            const v4u raw = *(const v4u*)p; float v[8] = {bflo(raw.x), bfhi(raw.x), bflo(raw.y), bfhi(raw.y), bflo(raw.z), bfhi(raw.z), bflo(raw.w), bfhi(raw.w)};
            float ss = 0.f;
#pragma unroll
            for (int e = 0; e < 8; ++e) ss += v[e] * v[e];
            ss += __shfl_xor(ss, 1); ss += __shfl_xor(ss, 2); ss += __shfl_xor(ss, 4);
            const float rstd = rsqrtf(ss * (1.f / 64.f) + 1e-6f) * (which ? 1.f : 0.125f * L2E);
            const float* g = (which ? kg : qg) + sub * 8;
            v4u o; o.x = pk2(v[0] * rstd * g[0], v[1] * rstd * g[1]); o.y = pk2(v[2] * rstd * g[2], v[3] * rstd * g[3]); o.z = pk2(v[4] * rstd * g[4], v[5] * rstd * g[5]); o.w = pk2(v[6] * rstd * g[6], v[7] * rstd * g[7]);
            *(v4u*)p = o; }
    }
    { const int t = tid >> 3, h = tid & 7; const float fl = bf2f(P[(row0 + t) * NP + C_FL + h]) + a->in[I_FB][l * 8 + h]; lfb[t * 8 + h] = fminf(fl, 0.f) - log1pf(__expf(-fabsf(fl))); }
    __syncthreads();
    if (tid < 8) { float run = 0.f; float* CL = (float*)(a->ws + WS_CLOC);
        for (int t = 0; t < 64; ++t) { run += lfb[t * 8 + tid]; CL[(row0 + t) * 8 + tid] = run; }
        ((float*)(a->ws + WS_CTOT))[(size_t)(b * NCH + c) * 8 + tid] = run; }
    __syncthreads();
}

constexpr int ATT_CS_OFF = 86016, ATT_CB_OFF = ATT_CS_OFF + 16384;
static_assert(attn_body::ATTN_LDS_BYTES <= ATT_CS_OFF && ATT_CB_OFF + 512 <= LDS_TAB, "attention LDS map");
__device__ __forceinline__ void attn_run(CA a, int b, int h, int qb, unsigned char* lds) {
    const int lane = attn_body::lane_now(); const int tid = __builtin_amdgcn_readfirstlane(threadIdx.x >> 6) * 64 + lane;
    float* cs = (float*)(lds + ATT_CS_OFF); float* cbase = (float*)(lds + ATT_CB_OFF);
    const float* CT = (const float*)(a->ws + WS_CTOT); const float* CL = (const float*)(a->ws + WS_CLOC);
    if (tid < 64) { const float v = CT[(size_t)(b * NCH + tid) * 8 + h]; float s = v;
#pragma unroll
        for (int o = 1; o < 64; o <<= 1) { const float n = __shfl_up(s, o); if (tid >= o) s += n; }
        cbase[tid] = s - v; }
    __syncthreads();
    const int q0 = qb * 256; const float cref = cbase[q0 >> 6] + CL[((size_t)b * S + q0) * 8 + h];
    for (int jx = tid; jx < q0 + 256; jx += NTHR) cs[jx] = (cref - (cbase[jx >> 6] + CL[((size_t)b * S + jx) * 8 + h])) * L2E;
    __syncthreads();
    int* t0w = (int*)(cbase + 64);
    if (tid < 64) { const int NT = (q0 + 256) / 64; const bool far = (tid < NT) && (cs[tid * 64 + 63] < -80.f); const int cnt = __popcll(__ballot(far)); if (tid == 0) t0w[0] = ((cnt < NT - 4) ? cnt : NT - 4) & ~1; }
    __syncthreads();
    const int t0 = t0w[0];
    const attn_body::bf16* P = (const attn_body::bf16*)(a->ws + WS_PROJ);
    attn_body::attn_unit<8>(b, h, qb, P + C_Q, P + C_K, P + C_V, (attn_body::bf16*)(a->ws + WS_Y) + 256, (char*)lds, (const char*)cs, t0);
}

constexpr int LDB = 72, MB = 64 * LDB * 2;
__device__ __forceinline__ f32x4 tile16(const unsigned char* X, int xr, const unsigned char* Y, int yr, f32x4 acc, int lane) {
    const int r = lane & 15, q = lane >> 4;
    const bf16x8 x0 = *(const bf16x8*)(X + ((xr + r) * LDB + q * 8) * 2), x1 = *(const bf16x8*)(X + ((xr + r) * LDB + 32 + q * 8) * 2);
    const bf16x8 y0 = *(const bf16x8*)(Y + ((yr + r) * LDB + q * 8) * 2), y1 = *(const bf16x8*)(Y + ((yr + r) * LDB + 32 + q * 8) * 2);
    acc = __builtin_amdgcn_mfma_f32_16x16x32_bf16(y0, x0, acc, 0, 0, 0);
    return __builtin_amdgcn_mfma_f32_16x16x32_bf16(y1, x1, acc, 0, 0, 0);
}
constexpr int R1_LRB = 0, R1_A32 = 16384, R1_WT = 32768, R1_AKRT = 52224, R1_ABRT = R1_AKRT + MB, R1_G = 70656, R1_M = 87040;
constexpr int R1_KH = R1_M, R1_BH = R1_M + MB, R1_KT = R1_M + 2 * MB, R1_RT = R1_M + 3 * MB, R1_KTT = R1_M + 4 * MB, R1_VT = R1_M + 5 * MB, R1_BGT = R1_M + 6 * MB, R1_KGT = R1_M + 7 * MB;
constexpr int R1_AT32 = R1_A32, R1_AKKT = R1_WT, R1_W32 = R1_WT + MB, R1_GC = R1_W32 + 4096, R1_PRM = R1_GC + 256, R1_SEG = R1_PRM + 1536, R1_T32 = R1_G;
constexpr int R1_NP = R1_KH, R1_VA = R1_BH, R1_TMT = R1_KT, R1_NE0 = R1_AKKT;
static_assert(R1_M + 8 * MB <= MISC_OFF && R1_SEG + 2048 <= R1_AKRT, "rw1 LDS map");
constexpr size_t WS_RWM = WS_H, WS_RWN = WS_H + 8 * MiB, WS_RWQ = WS_H + 16 * MiB, WS_RWO = WS_H + 24 * MiB;
constexpr size_t WS_SC = WS_ORAW;

#ifndef RW1_RS
#define RW1_RS 0
#endif
#ifndef RW1_RN
#define RW1_RN 1
#endif
#define RW1_REPEAT(k) for (int rp_ = 0; rp_ < ((RW1_RS == (k)) ? RW1_RN : 1); ++rp_)
__device__ __forceinline__ void rw1_unit(CA a, int l, int ub, unsigned char* lds, int tid) {
    const int b = ub >> 6, c = ub & 63, lane = tid & 63, wave = tid >> 6;
    const size_t row0 = (size_t)b * S + c * 64;
    bf16* lrb = (bf16*)(lds + R1_LRB); float* A32 = (float*)(lds + R1_A32); float* Gm = (float*)(lds + R1_G); float* PRM = (float*)(lds + R1_PRM);
    const bf16* P = (const bf16*)(a->ws + WS_PROJ);
    const float* mu = a->in[I_MU] + l * RCOLS;
    const int mi = wave & 3, nb = (wave >> 2) * 2, r16 = lane & 15, q4 = lane >> 4;
    const int t = tid >> 3, n0 = (tid & 7) * 8; const size_t row = row0 + t;
    for (int idx = tid; idx < 64 * 128; idx += NTHR) { const int tt = idx >> 7, jx = idx & 127; const size_t o = (row0 + tt) * NP + C_WD + jx;
        const float cur = bf2f(P[o]); const float prev = (c * 64 + tt > 0) ? bf2f(P[o - NP]) : 0.f; float val = cur + (prev - cur) * mu[768 + jx];
        if (jx < 32) val = 1.f - 2.f / (1.f + __expf(2.f * val)); else if (jx >= 64) val = sigmoidf_(val);
        lrb[idx] = (bf16)f2bf(val); }
#pragma unroll 1
    for (int h = 0; h < 4; ++h) {
    const int u = (b * 4 + h) * 64 + c;
    const bool hasprev = (c * 64 + t) > 0;
    const bf16* pr = P + row * NP + C_R + h * 64 + n0;
    const v4u rc = *(const v4u*)pr, kc = *(const v4u*)(pr + 256), vc = *(const v4u*)(pr + 512);
    v4u rp = {0u, 0u, 0u, 0u}, kp_ = rp, vp = rp;
    if (hasprev) { rp = *(const v4u*)(pr - NP); kp_ = *(const v4u*)(pr - NP + 256); vp = *(const v4u*)(pr - NP + 512); }
    if (h == 0) __syncthreads();
    RW1_REPEAT(1) {
        const int tt = mi * 16 + r16;
        const bf16x8 xw = *(const bf16x8*)(lrb + tt * 128 + q4 * 8), xa = *(const bf16x8*)(lrb + tt * 128 + 32 + q4 * 8), xg0 = *(const bf16x8*)(lrb + tt * 128 + 64 + q4 * 8), xg1 = *(const bf16x8*)(lrb + tt * 128 + 96 + q4 * 8);
#pragma unroll
        for (int k2 = 0; k2 < 2; ++k2) { const int ni = nb + k2, n = ni * 16 + 4 * q4;
            const bf16* RWg = (const bf16*)(a->ws + WS_RWW);
            const bf16x8 yw = *(const bf16x8*)(RWg + ((size_t)h * 64 + ni * 16 + r16) * 32 + q4 * 8), ya = *(const bf16x8*)(RWg + 8192 + ((size_t)h * 64 + ni * 16 + r16) * 32 + q4 * 8);
            const bf16x8 yg0 = *(const bf16x8*)(RWg + 16384 + ((size_t)h * 64 + ni * 16 + r16) * 64 + q4 * 8), yg1 = *(const bf16x8*)(RWg + 16384 + ((size_t)h * 64 + ni * 16 + r16) * 64 + 32 + q4 * 8);
            f32x4 accw = *(const f32x4*)(a->in[I_W0] + l * 256 + h * 64 + n), acca = *(const f32x4*)(a->in[I_A0] + l * 256 + h * 64 + n), accg = {0.f, 0.f, 0.f, 0.f};
            accw = __builtin_amdgcn_mfma_f32_16x16x32_bf16(yw, xw, accw, 0, 0, 0); acca = __builtin_amdgcn_mfma_f32_16x16x32_bf16(ya, xa, acca, 0, 0, 0);
            accg = __builtin_amdgcn_mfma_f32_16x16x32_bf16(yg0, xg0, accg, 0, 0, 0); accg = __builtin_amdgcn_mfma_f32_16x16x32_bf16(yg1, xg1, accg, 0, 0, 0);
            f32x4 dec, av4;
#pragma unroll
            for (int jx = 0; jx < 4; ++jx) { dec[jx] = __expf(-__expf(-softplus_fast(-accw[jx]) - 0.5f)); av4[jx] = sigmoidf_(acca[jx]); }
            *(f32x4*)(Gm + tt * 64 + n) = dec; *(f32x4*)(A32 + tt * 64 + n) = av4;
            v2u go; go.x = pk2(accg[0], accg[1]); go.y = pk2(accg[2], accg[3]); *(v2u*)((bf16*)(a->ws + WS_G) + (row0 + tt) * 256 + h * 64 + n) = go; }
    }
    __syncthreads();
    if (tid < 384) { const int q = tid >> 6, n = tid & 63, hn = h * 64 + n;
        PRM[tid] = (q == 0) ? mu[hn] : (q == 1) ? mu[256 + hn] : (q == 2) ? mu[512 + hn] : (q == 3) ? a->in[I_KK][l * 256 + hn] : (q == 4) ? a->in[I_KA][l * 256 + hn] : a->in[I_RK][l * 256 + hn]; }
    {
        float* seg = (float*)(lds + R1_SEG); const int n = tid & 63, sg = tid >> 6; float p = 1.f;
#pragma unroll
        for (int i = 0; i < 8; ++i) { p *= Gm[(sg * 8 + i) * 64 + n]; Gm[(sg * 8 + i) * 64 + n] = p; }
        seg[sg * 64 + n] = p;
        __syncthreads();
        float pre = 1.f;
        for (int s2 = 0; s2 < sg; ++s2) pre *= seg[s2 * 64 + n];
#pragma unroll
        for (int i = 0; i < 8; ++i) Gm[(sg * 8 + i) * 64 + n] *= pre;
    }
    __syncthreads();
    RW1_REPEAT(2) {
        const unsigned rcw[4] = {rc.x, rc.y, rc.z, rc.w}, kcw[4] = {kc.x, kc.y, kc.z, kc.w}, vcw[4] = {vc.x, vc.y, vc.z, vc.w};
        const unsigned rpw[4] = {rp.x, rp.y, rp.z, rp.w}, kpw[4] = {kp_.x, kp_.y, kp_.z, kp_.w}, vpw[4] = {vp.x, vp.y, vp.z, vp.w};
        float pm[6][8];
#pragma unroll
        for (int q = 0; q < 6; ++q) { const f32x4 pa = *(const f32x4*)(PRM + q * 64 + n0), pb = *(const f32x4*)(PRM + q * 64 + n0 + 4); pm[q][0] = pa.x; pm[q][1] = pa.y; pm[q][2] = pa.z; pm[q][3] = pa.w; pm[q][4] = pb.x; pm[q][5] = pb.y; pm[q][6] = pb.z; pm[q][7] = pb.w; }
        float av[8]; { const f32x4 aa = *(const f32x4*)(A32 + t * 64 + n0), ab = *(const f32x4*)(A32 + t * 64 + n0 + 4); av[0] = aa.x; av[1] = aa.y; av[2] = aa.z; av[3] = aa.w; av[4] = ab.x; av[5] = ab.y; av[6] = ab.z; av[7] = ab.w; }
        float kkv[8], kpv[8], rv[8], vv[8]; float ss = 0.f, bon = 0.f;
#pragma unroll
        for (int e = 0; e < 8; ++e) { const int w_ = e >> 1; const bool hi_ = e & 1;
            const float rcur = hi_ ? bfhi(rcw[w_]) : bflo(rcw[w_]), kcur = hi_ ? bfhi(kcw[w_]) : bflo(kcw[w_]), vcur = hi_ ? bfhi(vcw[w_]) : bflo(vcw[w_]);
            const float rprev = hi_ ? bfhi(rpw[w_]) : bflo(rpw[w_]), kprev = hi_ ? bfhi(kpw[w_]) : bflo(kpw[w_]), vprev = hi_ ? bfhi(vpw[w_]) : bflo(vpw[w_]);
            const float r = rcur + (rprev - rcur) * pm[0][e], k = kcur + (kprev - kcur) * pm[1][e], v = vcur + (vprev - vcur) * pm[2][e];
            kkv[e] = k * pm[3][e]; ss += kkv[e] * kkv[e];
            kpv[e] = k * (1.f + (av[e] - 1.f) * pm[4][e]); bon += r * kpv[e] * pm[5][e];
            rv[e] = r; vv[e] = v; }
        ss += __shfl_xor(ss, 1); ss += __shfl_xor(ss, 2); ss += __shfl_xor(ss, 4);
        bon += __shfl_xor(bon, 1); bon += __shfl_xor(bon, 2); bon += __shfl_xor(bon, 4);
        const float inv = 1.f / fmaxf(sqrtf(ss), 1e-12f);
        float kh[8], bh_[8], kt[8], rt[8], kg[8], bg[8];
#pragma unroll
        for (int e = 0; e < 8; ++e) { const int n = n0 + e; const float Gt = Gm[t * 64 + n], Gp = (t > 0) ? Gm[(t - 1) * 64 + n] : 1.f, GC = Gm[63 * 64 + n]; const float ig = 1.f / Gt;
            const float kkn = kkv[e] * inv; kh[e] = kpv[e] * ig; bh_[e] = kkn * av[e] * ig; kt[e] = kkn * Gp; rt[e] = rv[e] * Gt; kg[e] = kh[e] * GC; bg[e] = bh_[e] * GC; }
        v4u o;
        o.x = pk2(kh[0], kh[1]); o.y = pk2(kh[2], kh[3]); o.z = pk2(kh[4], kh[5]); o.w = pk2(kh[6], kh[7]); *(v4u*)(lds + R1_KH + (t * LDB + n0) * 2) = o;
        o.x = pk2(bh_[0], bh_[1]); o.y = pk2(bh_[2], bh_[3]); o.z = pk2(bh_[4], bh_[5]); o.w = pk2(bh_[6], bh_[7]); *(v4u*)(lds + R1_BH + (t * LDB + n0) * 2) = o;
        o.x = pk2(kt[0], kt[1]); o.y = pk2(kt[2], kt[3]); o.z = pk2(kt[4], kt[5]); o.w = pk2(kt[6], kt[7]); *(v4u*)(lds + R1_KT + (t * LDB + n0) * 2) = o;
        o.x = pk2(rt[0], rt[1]); o.y = pk2(rt[2], rt[3]); o.z = pk2(rt[4], rt[5]); o.w = pk2(rt[6], rt[7]); *(v4u*)(lds + R1_RT + (t * LDB + n0) * 2) = o;
#pragma unroll
        for (int e = 0; e < 8; ++e) { const int n = n0 + e;
            *(bf16*)(lds + R1_KTT + (n * LDB + t) * 2) = (bf16)f2bf(kt[e]); *(bf16*)(lds + R1_VT + (n * LDB + t) * 2) = (bf16)f2bf(vv[e]);
            *(bf16*)(lds + R1_BGT + (n * LDB + t) * 2) = (bf16)f2bf(bg[e]); *(bf16*)(lds + R1_KGT + (n * LDB + t) * 2) = (bf16)f2bf(kg[e]); }
        { v4u vo; vo.x = pk2(vv[0], vv[1]); vo.y = pk2(vv[2], vv[3]); vo.z = pk2(vv[4], vv[5]); vo.w = pk2(vv[6], vv[7]);
            *(v4u*)((bf16*)(a->ws + WS_VS) + row * 256 + h * 64 + n0) = vo;
            if ((tid & 7) == 0) ((float*)(a->ws + WS_BON))[row * 4 + h] = bon; }
    }
    __syncthreads();
    float* AT32 = (float*)(lds + R1_AT32); float* T32 = (float*)(lds + R1_T32); float* W32 = (float*)(lds + R1_W32); float* GCv = (float*)(lds + R1_GC);
    if (tid < 64) GCv[tid] = Gm[63 * 64 + tid];
    RW1_REPEAT(3)
#pragma unroll
    for (int k2 = 0; k2 < 2; ++k2) { const int ni = nb + k2; const f32x4 z = {0.f, 0.f, 0.f, 0.f};
        const f32x4 gkk = tile16(lds + R1_KT, mi * 16, lds + R1_KH, ni * 16, z, lane), gbk = tile16(lds + R1_KT, mi * 16, lds + R1_BH, ni * 16, z, lane);
        const f32x4 gkr = tile16(lds + R1_RT, mi * 16, lds + R1_KH, ni * 16, z, lane), gbr = tile16(lds + R1_RT, mi * 16, lds + R1_BH, ni * 16, z, lane);
        const int tt = mi * 16 + r16, i0 = ni * 16 + 4 * q4;
        float s0[4], s1[4], s2[4], s3[4];
#pragma unroll
        for (int j = 0; j < 4; ++j) { const bool st = (i0 + j) < tt, in = (i0 + j) <= tt; s0[j] = st ? gkk[j] : 0.f; s1[j] = st ? gbk[j] : 0.f; s2[j] = in ? gkr[j] : 0.f; s3[j] = in ? gbr[j] : 0.f; }
        v2u o; o.x = pk2(s0[0], s0[1]); o.y = pk2(s0[2], s0[3]); *(v2u*)(lds + R1_AKKT + (tt * LDB + i0) * 2) = o;
        o.x = pk2(s2[0], s2[1]); o.y = pk2(s2[2], s2[3]); *(v2u*)(lds + R1_AKRT + (tt * LDB + i0) * 2) = o;
        o.x = pk2(s3[0], s3[1]); o.y = pk2(s3[2], s3[3]); *(v2u*)(lds + R1_ABRT + (tt * LDB + i0) * 2) = o;
        *(f32x4*)(AT32 + tt * 64 + i0) = (f32x4){s1[0], s1[1], s1[2], s1[3]}; }
    __syncthreads();
    RW1_REPEAT(4) {
    for (int idx = tid; idx < 4096; idx += NTHR) T32[idx] = 0.f;
    __syncthreads();
    if (tid < 64) { const int bk = tid >> 4, cc = tid & 15; const float* Lb = AT32 + (bk * 16) * 64 + bk * 16; float xc[16];
#pragma unroll
        for (int rr = 0; rr < 16; ++rr) { float sacc = 0.f;
#pragma unroll
            for (int j = 0; j < rr; ++j) sacc += Lb[rr * 64 + j] * xc[j];
            xc[rr] = (rr > cc) ? -sacc : ((rr == cc) ? 1.f : 0.f); T32[(bk * 16 + rr) * 64 + bk * 16 + cc] = xc[rr]; } }
    __syncthreads();
    {
        const int p = tid >> 8, rr = (tid >> 4) & 15, cc = tid & 15; const float* Bq = AT32 + ((2 * p + 1) * 16) * 64 + (2 * p) * 16; const float* X0 = T32 + ((2 * p) * 16) * 64 + (2 * p) * 16; const float* X1 = T32 + ((2 * p + 1) * 16) * 64 + (2 * p + 1) * 16;
        float sacc = 0.f;
#pragma unroll
        for (int k = 0; k < 16; ++k) sacc += Bq[rr * 64 + k] * X0[k * 64 + cc];
        W32[p * 256 + rr * 16 + cc] = sacc;
        __syncthreads();
        sacc = 0.f;
#pragma unroll
        for (int k = 0; k < 16; ++k) sacc += X1[rr * 64 + k] * W32[p * 256 + k * 16 + cc];
        T32[((2 * p + 1) * 16 + rr) * 64 + (2 * p) * 16 + cc] = -sacc;
    }
    __syncthreads();
    {
        const int rr = tid >> 4, c0 = (tid & 15) * 2; const float* Bq = AT32 + 32 * 64; const float* X1 = T32 + 32 * 64 + 32;
        float sa = 0.f, sb = 0.f;
#pragma unroll 8
        for (int k = 0; k < 32; ++k) { const float bv_ = Bq[rr * 64 + k]; sa += bv_ * T32[k * 64 + c0]; sb += bv_ * T32[k * 64 + c0 + 1]; }
        W32[rr * 32 + c0] = sa; W32[rr * 32 + c0 + 1] = sb;
        __syncthreads();
        sa = 0.f; sb = 0.f;
#pragma unroll 8
        for (int k = 0; k < 32; ++k) { const float xv = X1[rr * 64 + k]; sa += xv * W32[k * 32 + c0]; sb += xv * W32[k * 32 + c0 + 1]; }
        T32[(32 + rr) * 64 + c0] = -sa; T32[(32 + rr) * 64 + c0 + 1] = -sb;
    }
    __syncthreads();
    { const int tt = tid >> 3, i0 = (tid & 7) * 8; const f32x4 ta = *(const f32x4*)(T32 + tt * 64 + i0), tb = *(const f32x4*)(T32 + tt * 64 + i0 + 4);
        v4u o; o.x = pk2(ta.x, ta.y); o.y = pk2(ta.z, ta.w); o.z = pk2(tb.x, tb.y); o.w = pk2(tb.z, tb.w); *(v4u*)(lds + R1_TMT + (tt * LDB + i0) * 2) = o; }
    __syncthreads();
    }
    RW1_REPEAT(5) {
#pragma unroll
    for (int k2 = 0; k2 < 2; ++k2) { const int ni = nb + k2; const f32x4 z = {0.f, 0.f, 0.f, 0.f};
        const f32x4 gp = tile16(lds + R1_KTT, mi * 16, lds + R1_TMT, ni * 16, z, lane), gva = tile16(lds + R1_VT, mi * 16, lds + R1_AKKT, ni * 16, z, lane);
        const int xr = mi * 16 + r16, y0 = ni * 16 + 4 * q4;
        v2u o; o.x = pk2(-gp[0], -gp[1]); o.y = pk2(-gp[2], -gp[3]); *(v2u*)(lds + R1_NP + (xr * LDB + y0) * 2) = o;
        o.x = pk2(gva[0], gva[1]); o.y = pk2(gva[2], gva[3]); *(v2u*)(lds + R1_VA + (xr * LDB + y0) * 2) = o; }
    __syncthreads();
    {
        const size_t ob = (size_t)u * 4096;
        bf16* MTg = (bf16*)(a->ws + WS_RWM) + ob; bf16* QTg = (bf16*)(a->ws + WS_RWQ) + ob;
#pragma unroll
        for (int k2 = 0; k2 < 2; ++k2) { const int ni = nb + k2; const f32x4 z = {0.f, 0.f, 0.f, 0.f};
            const f32x4 ge = tile16(lds + R1_VA, mi * 16, lds + R1_TMT, ni * 16, z, lane);
            const f32x4 gm = tile16(lds + R1_BGT, mi * 16, lds + R1_NP, ni * 16, z, lane);
            const int xr = mi * 16 + r16, y0 = ni * 16 + 4 * q4;
            const v2u rt2 = *(const v2u*)(lds + R1_RT + (xr * LDB + y0) * 2);
            f32x4 q0 = {bflo(rt2.x), bfhi(rt2.x), bflo(rt2.y), bfhi(rt2.y)};
            q0 = tile16(lds + R1_ABRT, mi * 16, lds + R1_NP, ni * 16, q0, lane);
            v2u o; o.x = pk2(-ge[0], -ge[1]); o.y = pk2(-ge[2], -ge[3]); *(v2u*)(lds + R1_NE0 + (xr * LDB + y0) * 2) = o;
            const float gcx = GCv[xr];
            o.x = pk2(gm[0] + ((y0 == xr) ? gcx : 0.f), gm[1] + ((y0 + 1 == xr) ? gcx : 0.f)); o.y = pk2(gm[2] + ((y0 + 2 == xr) ? gcx : 0.f), gm[3] + ((y0 + 3 == xr) ? gcx : 0.f));
            *(v2u*)(MTg + xr * 64 + y0) = o;
            o.x = pk2(q0[0], q0[1]); o.y = pk2(q0[2], q0[3]); *(v2u*)(QTg + xr * 64 + y0) = o; }
    }
    __syncthreads();
    {
        const size_t ob = (size_t)u * 4096;
        bf16* N0g = (bf16*)(a->ws + WS_RWN) + ob; bf16* O0g = (bf16*)(a->ws + WS_RWO) + ob;
#pragma unroll
        for (int k2 = 0; k2 < 2; ++k2) { const int ni = nb + k2; f32x4 go = {0.f, 0.f, 0.f, 0.f}, gn = {0.f, 0.f, 0.f, 0.f};
            go = tile16(lds + R1_AKRT, mi * 16, lds + R1_VT, ni * 16, go, lane); go = tile16(lds + R1_ABRT, mi * 16, lds + R1_NE0, ni * 16, go, lane);
            gn = tile16(lds + R1_VT, mi * 16, lds + R1_KGT, ni * 16, gn, lane); gn = tile16(lds + R1_NE0, mi * 16, lds + R1_BGT, ni * 16, gn, lane);
            const int xr = mi * 16 + r16, y0 = ni * 16 + 4 * q4;
            v2u o; o.x = pk2(go[0], go[1]); o.y = pk2(go[2], go[3]); *(v2u*)(O0g + xr * 64 + y0) = o;
            o.x = pk2(gn[0], gn[1]); o.y = pk2(gn[2], gn[3]); *(v2u*)(N0g + xr * 64 + y0) = o; }
    }
    __syncthreads();
    }
    }
}

template <int VAR> __device__ __forceinline__ void scan_unit(CA a, int su, unsigned char* lds, int tid) {
    const int bh = su >> 1, half = su & 1, lane = tid & 63, wave = tid >> 6, mi = wave & 1, ni = wave >> 1, r16 = lane & 15, q4 = lane >> 4;
    const bf16* MTg = (const bf16*)(a->ws + WS_RWM) + (size_t)bh * 64 * 4096 + (ni * 16 + r16) * 64 + q4 * 8;
    const bf16* N0g = (const bf16*)(a->ws + WS_RWN) + (size_t)bh * 64 * 4096 + (half * 32 + mi * 16 + r16) * 64 + ni * 16 + 4 * q4;
    bf16* SCg = (bf16*)(a->ws + WS_SC) + (size_t)bh * 64 * 4096 + (half * 32 + mi * 16 + r16) * 64 + ni * 16 + 4 * q4;
    unsigned char* Sb = lds;
    bf16* dump = (bf16*)(a->ws + WS_SC + 8 * MiB) + (size_t)(su * NTHR + tid) * 4;
    const int soff = ((mi * 16 + r16) * LDB + ni * 16 + 4 * q4) * 2, xoff = ((mi * 16 + r16) * LDB + q4 * 8) * 2;
    constexpr int D = 16, SBB = 32 * LDB * 2;
    bf16x8 m0[D], m1[D]; v2u nn[D];
#pragma unroll
    for (int d = 0; d < D; ++d) { m0[d] = *(const bf16x8*)(MTg + (size_t)d * 4096); m1[d] = *(const bf16x8*)(MTg + (size_t)d * 4096 + 32); nn[d] = *(const v2u*)(N0g + (size_t)d * 4096); }
    { const v2u z = {0u, 0u}; *(v2u*)(Sb + soff) = z; if (VAR == 0) *(v2u*)SCg = z; }
#pragma unroll
    for (int cb = 0; cb < 64; cb += D) {
#pragma unroll
        for (int d = 0; d < D; ++d) { const int c = cb + d;
            asm volatile("s_waitcnt lgkmcnt(0)\n\ts_barrier" ::: "memory");
            const unsigned char* Sc = Sb + (c & 1) * SBB;
            const bf16x8 x0 = *(const bf16x8*)(Sc + xoff), x1 = *(const bf16x8*)(Sc + xoff + 64);
            f32x4 acc = {bflo(nn[d].x), bfhi(nn[d].x), bflo(nn[d].y), bfhi(nn[d].y)};
            acc = __builtin_amdgcn_mfma_f32_16x16x32_bf16(m0[d], x0, acc, 0, 0, 0); acc = __builtin_amdgcn_mfma_f32_16x16x32_bf16(m1[d], x1, acc, 0, 0, 0);
            v2u o; o.x = pk2(acc[0], acc[1]); o.y = pk2(acc[2], acc[3]);
            *(v2u*)(Sb + ((c + 1) & 1) * SBB + soff) = o;
            if (VAR == 0) *(v2u*)((c + 1 < 64) ? SCg + (size_t)(c + 1) * 4096 : dump) = o;
            if (VAR < 2 || VAR == 3) { const int cn = (VAR == 3) ? d : ((c + D < 64) ? c + D : 63); m0[d] = *(const bf16x8*)(MTg + (size_t)cn * 4096); m1[d] = *(const bf16x8*)(MTg + (size_t)cn * 4096 + 32); nn[d] = *(const v2u*)(N0g + (size_t)cn * 4096); } }
    }
    __syncthreads();
}

__device__ __forceinline__ void lru_carry_unit(CA a, int b, int tid) {
    if (tid < 256) { const float* AA = (const float*)(a->ws + WS_AAGG) + (size_t)b * NCH * 256 + tid; const float* HA = (const float*)(a->ws + WS_HAGG) + (size_t)b * NCH * 256 + tid; float* CR = (float*)(a->ws + WS_CARRY) + (size_t)b * NCH * 256 + tid;
        float cr = 0.f;
#pragma unroll 1
        for (int c0 = 0; c0 < NCH; c0 += 16) { float av[16], hv[16];
#pragma unroll
            for (int i = 0; i < 16; ++i) { av[i] = AA[(c0 + i) * 256]; hv[i] = HA[(c0 + i) * 256]; }
#pragma unroll
            for (int i = 0; i < 16; ++i) { CR[(c0 + i) * 256] = cr; cr = av[i] * cr + hv[i]; } } }
}
__device__ __forceinline__ float gelu_tanh(float x) { const float u = 0.7978845608028654f * (x + 0.044715f * x * x * x); return 0.5f * x * (1.f + tanhf(u)); }
__device__ __forceinline__ void post_unit(CA a, int l, int u, unsigned char* lds, int tid, bool fox = true) {
    const int b = u / NCH, c = u % NCH, lane = tid & 63, wave = tid >> 6; const size_t row0 = (size_t)b * S + c * 64;
    const bf16* P = (const bf16*)(a->ws + WS_PROJ); bf16* Y = (bf16*)(a->ws + WS_Y);
    const f32x4 cr4 = *(const f32x4*)((const float*)(a->ws + WS_CARRY) + (size_t)(b * NCH + c) * 256 + 4 * lane);
    const f32x4 lg4 = *(const f32x4*)(a->in[I_LNG] + l * 256 + 4 * lane);
    const f32x4 fgA = *(const f32x4*)(a->in[I_FNG] + l * 512 + 8 * lane), fgB = *(const f32x4*)(a->in[I_FNG] + l * 512 + 8 * lane + 4);
    for (int tt = wave; tt < 64; tt += NWAVES) { const size_t row = row0 + tt;
        {
            const v2u hl = *(const v2u*)((const bf16*)(a->ws + WS_HLOC) + row * 256 + 4 * lane), ca = *(const v2u*)((const bf16*)(a->ws + WS_CUMA) + row * 256 + 4 * lane), ga = *(const v2u*)(P + row * NP + C_GA + 4 * lane);
            const float y0 = gelu_tanh(bflo(ga.x)) * (bflo(hl.x) + bflo(ca.x) * cr4.x), y1 = gelu_tanh(bfhi(ga.x)) * (bfhi(hl.x) + bfhi(ca.x) * cr4.y),
                        y2 = gelu_tanh(bflo(ga.y)) * (bflo(hl.y) + bflo(ca.y) * cr4.z), y3 = gelu_tanh(bfhi(ga.y)) * (bfhi(hl.y) + bfhi(ca.y) * cr4.w);
            const float rstd = rsqrtf(wave_sum((y0 * y0 + y1 * y1) + (y2 * y2 + y3 * y3)) * (1.f / 256.f) + 1e-6f);
            v2u o; o.x = pk2(y0 * rstd * lg4.x, y1 * rstd * lg4.y); o.y = pk2(y2 * rstd * lg4.z, y3 * rstd * lg4.w); *(v2u*)(Y + row * DM + 4 * lane) = o; }
        if (fox) {
            bf16* p = Y + row * DM + 256 + 8 * lane; const v4u raw = *(const v4u*)p;
            const float v0 = bflo(raw.x), v1 = bfhi(raw.x), v2 = bflo(raw.y), v3 = bfhi(raw.y), v4 = bflo(raw.z), v5 = bfhi(raw.z), v6 = bflo(raw.w), v7 = bfhi(raw.w);
            const float rstd = rsqrtf(wave_sum(((v0 * v0 + v1 * v1) + (v2 * v2 + v3 * v3)) + ((v4 * v4 + v5 * v5) + (v6 * v6 + v7 * v7))) * (1.f / 512.f) + 1e-6f);
            v4u o; o.x = pk2(v0 * rstd * fgA.x, v1 * rstd * fgA.y); o.y = pk2(v2 * rstd * fgA.z, v3 * rstd * fgA.w); o.z = pk2(v4 * rstd * fgB.x, v5 * rstd * fgB.y); o.w = pk2(v6 * rstd * fgB.z, v7 * rstd * fgB.w);
            *(v4u*)p = o; }
    }
    {
        const int h = wave >> 1, r16 = lane & 15, q4 = lane >> 4; const size_t ub = ((size_t)((b * 4 + h) * 64 + c)) * 4096;
        const bf16* QTg = (const bf16*)(a->ws + WS_RWQ) + ub; const bf16* SCg = (const bf16*)(a->ws + WS_SC) + ub; const bf16* O0g = (const bf16*)(a->ws + WS_RWO) + ub;
        const float* rlg = a->in[I_RLG] + l * 256 + h * 64; const float* rlb = a->in[I_RLB] + l * 256 + h * 64;
#pragma unroll
        for (int m2 = 0; m2 < 2; ++m2) { const int t = (2 * (wave & 1) + m2) * 16 + r16; const size_t row = row0 + t;
            const bf16x8 x0 = *(const bf16x8*)(QTg + t * 64 + q4 * 8), x1 = *(const bf16x8*)(QTg + t * 64 + 32 + q4 * 8);
            f32x4 o[4]; float s = 0.f;
#pragma unroll
            for (int ni = 0; ni < 4; ++ni) { const bf16x8 y0 = *(const bf16x8*)(SCg + (ni * 16 + r16) * 64 + q4 * 8), y1 = *(const bf16x8*)(SCg + (ni * 16 + r16) * 64 + 32 + q4 * 8);
                const v2u ov = *(const v2u*)(O0g + t * 64 + ni * 16 + 4 * q4); o[ni] = (f32x4){bflo(ov.x), bfhi(ov.x), bflo(ov.y), bfhi(ov.y)};
                o[ni] = __builtin_amdgcn_mfma_f32_16x16x32_bf16(y0, x0, o[ni], 0, 0, 0); o[ni] = __builtin_amdgcn_mfma_f32_16x16x32_bf16(y1, x1, o[ni], 0, 0, 0);
                s += (o[ni][0] + o[ni][1]) + (o[ni][2] + o[ni][3]); }
            s += __shfl_xor(s, 16); s += __shfl_xor(s, 32);
            const float mean = s * (1.f / 64.f); float q = 0.f;
#pragma unroll
            for (int ni = 0; ni < 4; ++ni) { o[ni] = o[ni] - mean; q += (o[ni][0] * o[ni][0] + o[ni][1] * o[ni][1]) + (o[ni][2] * o[ni][2] + o[ni][3] * o[ni][3]); }
            q += __shfl_xor(q, 16); q += __shfl_xor(q, 32);
            const float rstd = rsqrtf(q * (1.f / 64.f) + 64e-5f);
            const float bon = ((const float*)(a->ws + WS_BON))[row * 4 + h];
#pragma unroll
            for (int ni = 0; ni < 4; ++ni) { const int n = ni * 16 + 4 * q4, hn = h * 64 + n;
                const f32x4 lg = *(const f32x4*)(rlg + n), lb = *(const f32x4*)(rlb + n);
                const v2u g2_ = *(const v2u*)((const bf16*)(a->ws + WS_G) + row * 256 + hn), vs = *(const v2u*)((const bf16*)(a->ws + WS_VS) + row * 256 + hn);
                const float z0 = (o[ni][0] * rstd * lg.x + lb.x + bon * bflo(vs.x)) * bflo(g2_.x), z1 = (o[ni][1] * rstd * lg.y + lb.y + bon * bfhi(vs.x)) * bfhi(g2_.x),
                            z2 = (o[ni][2] * rstd * lg.z + lb.z + bon * bflo(vs.y)) * bflo(g2_.y), z3 = (o[ni][3] * rstd * lg.w + lb.w + bon * bfhi(vs.y)) * bfhi(g2_.y);
                v2u ow; ow.x = pk2(z0, z1); ow.y = pk2(z2, z3); *(v2u*)(Y + row * DM + 768 + hn) = ow; } }
    }
    __syncthreads();
}

struct EpiResF32 {
    static constexpr bool PERM = true, AFTER_DRAIN = false;
    const float* X; float* O; bf16* Hb;
    __device__ __forceinline__ void operator()(const pg8::f32x4 (&acc)[2][2][4][2], const pg8::Unit& u, int wr, int wc, int fr, int fq) const {
        const int row0 = u.pm * 256 + wr * 64 + fr, col0 = u.pn * 256 + wc * 32 + 8 * fq;
#pragma unroll
        for (int ai = 0; ai < 2; ++ai)
#pragma unroll
            for (int m = 0; m < 4; ++m) { const size_t ro = (size_t)(row0 + ai * 128 + m * 16) * DM + col0;
#pragma unroll
                for (int bj = 0; bj < 2; ++bj) { const pg8::f32x4 x0 = *(const pg8::f32x4*)(X + ro + bj * 128), x1 = *(const pg8::f32x4*)(X + ro + bj * 128 + 4);
                    const pg8::f32x4 y0 = x0 + acc[ai][bj][m][0], y1 = x1 + acc[ai][bj][m][1];
                    *(pg8::f32x4*)(O + ro + bj * 128) = y0; *(pg8::f32x4*)(O + ro + bj * 128 + 4) = y1;
                    v4u hb; hb.x = pk2(y0[0], y0[1]); hb.y = pk2(y0[2], y0[3]); hb.z = pk2(y1[0], y1[1]); hb.w = pk2(y1[2], y1[3]); *(v4u*)(Hb + ro + bj * 128) = hb; } }
    }
};
struct MoeSched {
    const int* tst; int NJ, nunits, G, c;
    __device__ __forceinline__ bool next(int i, pg8::Unit& u) const {
        const int L = i * G + c; if (L >= nunits) return false;
        const int tile = L / NJ, j = L % NJ; int e = 0;
#pragma unroll
        for (int k = 1; k < NE; ++k) e += (tile >= tst[k]) ? 1 : 0;
        u.pm = tile; u.pn = e * NJ + j; return true;
    }
    __device__ __forceinline__ void a_ready(const pg8::Unit&) const {}
    __device__ __forceinline__ void done(const pg8::Unit&) const {}
};
struct EpiSwiglu {
    static constexpr bool PERM = true, AFTER_DRAIN = false;
    bf16* HID; const float* SW; const float* SR; const int* tst; const int* cnt;
    __device__ __forceinline__ void operator()(const pg8::f32x4 (&acc)[2][2][4][2], const pg8::Unit& u, int wr, int wc, int fr, int fq) const {
        const int e = u.pn >> 1, j = u.pn & 1, seg0 = tst[e] * 256, ce = cnt[e];
        const int row0 = u.pm * 256 + wr * 64 + fr, hc0 = j * 128 + wc * 16 + 4 * fq;
#pragma unroll
        for (int ai = 0; ai < 2; ++ai)
#pragma unroll
            for (int m = 0; m < 4; ++m) { const int row = row0 + ai * 128 + m * 16; const bool valid = (row - seg0) < ce; const float w = valid ? SW[row] : 0.f, rs = valid ? SR[row] : 0.f;
#pragma unroll
                for (int bj = 0; bj < 2; ++bj) { const pg8::f32x4 v0 = acc[ai][bj][m][0] * rs, v1 = acc[ai][bj][m][1] * rs;
                    float h0 = v0[0] * sigmoidf_(v0[0]) * v0[1] * w, h1 = v0[2] * sigmoidf_(v0[2]) * v0[3] * w, h2 = v1[0] * sigmoidf_(v1[0]) * v1[1] * w, h3 = v1[2] * sigmoidf_(v1[2]) * v1[3] * w;
                    if (!valid) { h0 = 0.f; h1 = 0.f; h2 = 0.f; h3 = 0.f; }
                    v2u o; o.x = pk2(h0, h1); o.y = pk2(h2, h3); *(v2u*)(HID + (size_t)row * DE + hc0 + bj * 64) = o; } }
    }
};
struct EpiYE {
    static constexpr bool PERM = true, AFTER_DRAIN = false;
    bf16* YE;
    __device__ __forceinline__ void operator()(const pg8::f32x4 (&acc)[2][2][4][2], const pg8::Unit& u, int wr, int wc, int fr, int fq) const {
        const int j = u.pn & 3; const int row0 = u.pm * 256 + wr * 64 + fr, col0 = j * 256 + wc * 32 + 8 * fq;
#pragma unroll
        for (int ai = 0; ai < 2; ++ai)
#pragma unroll
            for (int m = 0; m < 4; ++m) { bf16* rowp = YE + (size_t)(row0 + ai * 128 + m * 16) * DM + col0;
#pragma unroll
                for (int bj = 0; bj < 2; ++bj) { const pg8::f32x4 v0 = acc[ai][bj][m][0], v1 = acc[ai][bj][m][1];
                    v4u w; w.x = pk2(v0[0], v0[1]); w.y = pk2(v0[2], v0[3]); w.z = pk2(v1[0], v1[1]); w.w = pk2(v1[2], v1[3]); *(v4u*)(rowp + bj * 128) = w; } }
    }
};

__device__ __forceinline__ void route_unit(CA a, int l, int u, unsigned char* lds, int tid, int* hist) {
    const int lane = tid & 63, wave = tid >> 6, r16 = lane & 15, q4 = lane >> 4;
    const float* xb = a->out + ((size_t)u * 64 + r16) * DM + wave * 128 + q4 * 8;
    const bf16* wh = (const bf16*)(a->ws + WS_WRH) + (size_t)r16 * DM + wave * 128 + q4 * 8; const bf16* wl = (const bf16*)(a->ws + WS_WRL) + (size_t)r16 * DM + wave * 128 + q4 * 8;
    float* part = (float*)lds;
    bf16x8 bh_[2][4], bl_[2][4];
#pragma unroll
    for (int ni = 0; ni < 2; ++ni)
#pragma unroll
        for (int kk = 0; kk < 4; ++kk) { bh_[ni][kk] = *(const bf16x8*)(wh + (size_t)ni * 16 * DM + kk * 32); bl_[ni][kk] = *(const bf16x8*)(wl + (size_t)ni * 16 * DM + kk * 32); }
#pragma unroll
    for (int mi = 0; mi < 4; ++mi) {
        f32x4 xa[4][2];
#pragma unroll
        for (int kk = 0; kk < 4; ++kk) { xa[kk][0] = *(const f32x4*)(xb + (size_t)mi * 16 * DM + kk * 32); xa[kk][1] = *(const f32x4*)(xb + (size_t)mi * 16 * DM + kk * 32 + 4); }
        f32x4 acc0 = {0.f, 0.f, 0.f, 0.f}, acc1 = acc0; float ssq = 0.f;
#pragma unroll
        for (int kk = 0; kk < 4; ++kk) { const f32x4 v0 = xa[kk][0], v1 = xa[kk][1];
            ssq += ((v0.x * v0.x + v0.y * v0.y) + (v0.z * v0.z + v0.w * v0.w)) + ((v1.x * v1.x + v1.y * v1.y) + (v1.z * v1.z + v1.w * v1.w));
            const unsigned h0 = pk2(v0.x, v0.y), h1 = pk2(v0.z, v0.w), h2 = pk2(v1.x, v1.y), h3 = pk2(v1.z, v1.w);
            const v4u hv = {h0, h1, h2, h3};
            const v4u lv = {pk2(v0.x - bflo(h0), v0.y - bfhi(h0)), pk2(v0.z - bflo(h1), v0.w - bfhi(h1)), pk2(v1.x - bflo(h2), v1.y - bfhi(h2)), pk2(v1.z - bflo(h3), v1.w - bfhi(h3))};
            const bf16x8 ah = __builtin_bit_cast(bf16x8, hv), al = __builtin_bit_cast(bf16x8, lv);
            acc0 = __builtin_amdgcn_mfma_f32_16x16x32_bf16(bh_[0][kk], ah, acc0, 0, 0, 0); acc0 = __builtin_amdgcn_mfma_f32_16x16x32_bf16(bl_[0][kk], ah, acc0, 0, 0, 0); acc0 = __builtin_amdgcn_mfma_f32_16x16x32_bf16(bh_[0][kk], al, acc0, 0, 0, 0);
            acc1 = __builtin_amdgcn_mfma_f32_16x16x32_bf16(bh_[1][kk], ah, acc1, 0, 0, 0); acc1 = __builtin_amdgcn_mfma_f32_16x16x32_bf16(bl_[1][kk], ah, acc1, 0, 0, 0); acc1 = __builtin_amdgcn_mfma_f32_16x16x32_bf16(bh_[1][kk], al, acc1, 0, 0, 0); }
        ssq += __shfl_xor(ssq, 16); ssq += __shfl_xor(ssq, 32);
        float* pr = part + (wave * 64 + mi * 16 + r16) * 33;
        pr[4 * q4] = acc0[0]; pr[4 * q4 + 1] = acc0[1]; pr[4 * q4 + 2] = acc0[2]; pr[4 * q4 + 3] = acc0[3];
        pr[16 + 4 * q4] = acc1[0]; pr[16 + 4 * q4 + 1] = acc1[1]; pr[16 + 4 * q4 + 2] = acc1[2]; pr[16 + 4 * q4 + 3] = acc1[3];
        if (q4 == 0) pr[32] = ssq;
    }
    __syncthreads();
    if (tid < 64) {
        float lt[20]; float ssq = 0.f;
#pragma unroll
        for (int n = 0; n < 20; ++n) lt[n] = 0.f;
#pragma unroll
        for (int w = 0; w < 8; ++w) { const float* pr = part + (w * 64 + tid) * 33; ssq += pr[32];
#pragma unroll
            for (int n = 0; n < 20; ++n) lt[n] += pr[n]; }
        const float rstd = rsqrtf(ssq * (1.f / DM) + 1e-6f); const float* gb = a->in[I_RGB] + l * 4; const float* eb = a->in[I_REB] + l * NE;
        const float g0 = lt[0] * rstd + gb[0], g1 = lt[1] * rstd + gb[1], g2_ = lt[2] * rstd + gb[2], g3 = lt[3] * rstd + gb[3];
        int gi = 0; float gm = g0; if (g1 > gm) { gm = g1; gi = 1; } if (g2_ > gm) { gm = g2_; gi = 2; } if (g3 > gm) { gm = g3; gi = 3; }
        const float gp = 1.f / (__expf(g0 - gm) + __expf(g1 - gm) + __expf(g2_ - gm) + __expf(g3 - gm));
        float el[4];
#pragma unroll
        for (int k = 0; k < 4; ++k) el[k] = (gi == 0 ? lt[4 + k] : gi == 1 ? lt[8 + k] : gi == 2 ? lt[12 + k] : lt[16 + k]) * rstd + eb[gi * 4 + k];
        int i0 = 0; float m0 = el[0]; if (el[1] > m0) { m0 = el[1]; i0 = 1; } if (el[2] > m0) { m0 = el[2]; i0 = 2; } if (el[3] > m0) { m0 = el[3]; i0 = 3; }
        int i1 = -1; float m1 = -INFINITY;
#pragma unroll
        for (int k = 0; k < 4; ++k) { if (k != i0 && el[k] > m1) { m1 = el[k]; i1 = k; } }
        const float p0 = 1.f / (1.f + __expf(m1 - m0)), p1 = 1.f - p0; const int m = u * 64 + tid, e0 = gi * 4 + i0, e1 = gi * 4 + i1;
        int* TE = (int*)(a->ws + WS_TOKE); float* TW = (float*)(a->ws + WS_TOKW);
        TE[m * 2] = e0; TE[m * 2 + 1] = e1; TW[m * 2] = gp * p0; TW[m * 2 + 1] = gp * p1; ((float*)(a->ws + WS_TR))[m] = rstd; atomicAdd(&hist[e0], 1); atomicAdd(&hist[e1], 1);
    }
    __syncthreads();
}
__device__ __forceinline__ void phase_route(CA a, int l, unsigned char* lds, int tid, gu32* ctl, bool first = true) {
    int* hist = (int*)(lds + 8 * 64 * 33 * 4);
    if (tid < NE) hist[tid] = 0;
    __syncthreads();
    for (int u = blockIdx.x; u < T / 64; u += gridDim.x) route_unit(a, l, u, lds, tid, hist);
    if (first && tid < NE) __hip_atomic_fetch_add((unsigned*)(ctl + CW_CNT0 + l * CW_LSTRIDE + tid), (unsigned)hist[tid], RLX_AGENT);
    __syncthreads();
}

__device__ __forceinline__ void moe_tables(int l, unsigned char* lds, int tid, gu32* ctl) {
    int* tst = (int*)(lds + LDS_TAB); int* cnt = tst + 32;
    if (tid == 0) { int acc = 0; for (int e = 0; e < NE; ++e) { const int ce = (int)__hip_atomic_load(ctl + CW_CNT0 + l * CW_LSTRIDE + e, RLX_AGENT); cnt[e] = ce; tst[e] = acc; acc += (ce + 255) >> 8; } tst[NE] = acc; }
    __syncthreads();
}
__device__ __forceinline__ void phase_place(CA a, int l, unsigned char* lds, int tid, gu32* ctl) {
    const int lane = tid & 63, wave = tid >> 6;
    int* tst = (int*)(lds + LDS_TAB); int* lcnt = (int*)lds; int* lbase = lcnt + 16; int* sslot = lcnt + 32;
    const int* TE = (const int*)(a->ws + WS_TOKE); const float* TW = (const float*)(a->ws + WS_TOKW); float* SW = (float*)(a->ws + WS_SW); int* TSL = (int*)(a->ws + WS_TSLOT);
    const bf16* H = (const bf16*)(a->ws + WS_H); bf16* AS = (bf16*)(a->ws + WS_ASORT);
    for (int u = blockIdx.x; u < T / 64; u += gridDim.x) {
        if (tid < NE) lcnt[tid] = 0;
        __syncthreads();
        int e = 0, lrank = 0, t = 0; float w = 0.f;
        if (tid < 128) { t = u * 64 + (tid >> 1); e = TE[t * 2 + (tid & 1)]; w = TW[t * 2 + (tid & 1)]; lrank = atomicAdd(&lcnt[e], 1); }
        __syncthreads();
        if (tid < NE) lbase[tid] = (int)__hip_atomic_fetch_add((unsigned*)(ctl + CW_CUR0 + l * CW_LSTRIDE + tid), (unsigned)lcnt[tid], RLX_AGENT);
        __syncthreads();
        if (tid < 128) { const int slot = tst[e] * 256 + lbase[e] + lrank; TSL[t * 2 + (tid & 1)] = slot; SW[slot] = w; ((float*)(a->ws + WS_SR))[slot] = ((const float*)(a->ws + WS_TR))[t]; sslot[tid] = slot; }
        __syncthreads();
#pragma unroll 4
        for (int i = 0; i < 16; ++i) { const int p = wave * 16 + i; const int tk = u * 64 + (p >> 1); const int slot = sslot[p];
            const v4u* src = (const v4u*)(H + (size_t)tk * DM) + lane; v4u* dst = (v4u*)(AS + (size_t)slot * DM) + lane; dst[0] = src[0]; dst[64] = src[64]; }
        __syncthreads();
    }
}

__global__ void __launch_bounds__(NTHR, 2) fwd(Args a_unused) {
    extern __shared__ __attribute__((aligned(16))) unsigned char lds[];
    volatile LAS unsigned* MISC = (volatile LAS unsigned*)((LAS unsigned char*)lds + MISC_OFF);
    if (threadIdx.x < 64) MISC[threadIdx.x] = 0u;
    __syncthreads();
#if MK_ONE_LAUNCH
    XcdBarrier bar = xcd_barrier_post((unsigned*)(args_now()->ws + WS_CTL) + CW_BAR, MISC + 8);
#define SEAM(k) do { if (IN((k) + 1)) xcd_barrier(bar); } while (0)
#else
#define SEAM(k) do { } while (0)
#endif
    const int lo = args_now()->ph_lo, hi = args_now()->ph_hi;
#ifndef REP_GIN
#define REP_GIN 1
#endif
#ifndef REP_LRU
#define REP_LRU 1
#endif
#ifndef REP_RW1
#define REP_RW1 1
#endif
#ifndef REP_SCAN
#define REP_SCAN 1
#endif
#ifndef REP_ATTN
#define REP_ATTN 1
#endif
#ifndef REP_POST
#define REP_POST 1
#endif
#ifndef REP_ROUTE
#define REP_ROUTE 1
#endif
#ifndef REP_MOE1
#define REP_MOE1 1
#endif
#ifndef REP_MOE2
#define REP_MOE2 1
#endif
#ifndef PHASE_MASK
#define PHASE_MASK 0x3ff
#endif
#define IN(k) (((PHASE_MASK >> ((k) % NPH)) & 1) && lo <= (k) && (k) < hi)
    for (int l = 0; l < NL; ++l) {
        const int pb = l * NPH;
        if (IN(pb + PH_PRE)) { phase_pre(args_now(), l, lds, pg8::tid_now()); SEAM(pb + PH_PRE); }
        if (IN(pb + PH_GIN)) { CA a = args_now();
            pg8::Gemm g{(const pg8::bf16_t*)(a->ws + WS_H), (const pg8::bf16_t*)(a->ws + WS_WIN), T, NP, DM}; pg8::StaticOrder So; So.init(T, NP, (int)gridDim.x, (int)blockIdx.x);
            pg8::EpiBf16<0> E{(pg8::bf16_t*)(a->ws + WS_PROJ), NP, nullptr, 0, 0, 1.f};
            for (int rep = 0; rep < REP_GIN; ++rep) pg8::gemm_phase<pg8::EpiBf16<0>, pg8::StaticOrder, true, true>((PG8_LAS unsigned char*)lds, g, So, E);
            SEAM(pb + PH_GIN);
        }
        if (IN(pb + PH_PREP)) {
            for (int rep = 0; rep < REP_LRU; ++rep) for (int u = blockIdx.x; u < Bsz * NCH; u += gridDim.x) prep_unit(args_now(), l, u, lds, pg8::tid_now(), rep == 0);
            for (int rep = 0; rep < REP_RW1; ++rep) for (int u = blockIdx.x; u < Bsz * NCH; u += gridDim.x) rw1_unit(args_now(), l, u, lds, pg8::tid_now());
            SEAM(pb + PH_PREP);
        }
        if (IN(pb + PH_MIX)) {
            for (int su = blockIdx.x; su < Bsz * 4 * 2; su += gridDim.x) scan_unit<0>(args_now(), su, lds, pg8::tid_now());
            if (blockIdx.x >= 32 && blockIdx.x < 32 + Bsz) lru_carry_unit(args_now(), (int)blockIdx.x - 32, pg8::tid_now());
#ifdef SCAN_VAR
            for (int rep = 1; rep < REP_SCAN; ++rep) for (int su = blockIdx.x; su < Bsz * 4 * 2; su += gridDim.x) scan_unit<SCAN_VAR>(args_now(), su, lds, pg8::tid_now());
#endif
#if MK_ONE_LAUNCH && defined(SCAN_ALONE)
            xcd_barrier(bar);
#endif
            { CA a = args_now(); gu32* qh = (gu32*)(a->ws + WS_CTL) + CW_Q0 + l * CW_LSTRIDE;
                for (;;) {
                    if (threadIdx.x == 0) MISC[0] = __hip_atomic_fetch_add((unsigned*)qh, 1u, RLX_AGENT);
                    __syncthreads();
                    const int ui = (int)MISC[0];
                    __syncthreads();
                    if (ui >= Bsz * 8 * 16) break;
                    const int bh = ui & 31; attn_run(args_now(), bh >> 3, bh & 7, 15 - (ui >> 5), lds);
                } }
            SEAM(pb + PH_MIX);
        }
        if (IN(pb + PH_POST)) { for (int rep = 0; rep < REP_POST; ++rep) for (int u = blockIdx.x; u < Bsz * NCH; u += gridDim.x) post_unit(args_now(), l, u, lds, pg8::tid_now(), rep == 0); SEAM(pb + PH_POST); }
        if (IN(pb + PH_GOUT)) { CA a = args_now();
            pg8::Gemm g{(const pg8::bf16_t*)(a->ws + WS_Y), (const pg8::bf16_t*)(a->ws + WS_WOUT), T, DM, DM}; pg8::StaticOrder So; So.init(T, DM, (int)gridDim.x, (int)blockIdx.x);
            EpiResF32 E{(l == 0) ? a->in[I_X] : a->out, a->out, (bf16*)(a->ws + WS_H)};
            pg8::gemm_phase<EpiResF32, pg8::StaticOrder, true, true>((PG8_LAS unsigned char*)lds, g, So, E);
            SEAM(pb + PH_GOUT);
        }
        if (IN(pb + PH_ROUTE)) { CA a = args_now(); for (int rep = 0; rep < REP_ROUTE; ++rep) phase_route(a, l, lds, pg8::tid_now(), (gu32*)(a->ws + WS_CTL), rep == 0); SEAM(pb + PH_ROUTE); }
        if (IN(pb + PH_PLACE)) { CA a = args_now(); const int tid = pg8::tid_now(); gu32* ctl = (gu32*)(a->ws + WS_CTL); moe_tables(l, lds, tid, ctl); phase_place(a, l, lds, tid, ctl); SEAM(pb + PH_PLACE); }
        if (IN(pb + PH_MOE1)) { CA a = args_now();
            moe_tables(l, lds, pg8::tid_now(), (gu32*)(a->ws + WS_CTL));
            const int* tst = (const int*)(lds + LDS_TAB); const int* cnt = tst + 32;
            pg8::Gemm g{(const pg8::bf16_t*)(a->ws + WS_ASORT), (const pg8::bf16_t*)(a->ws + WS_WGU), MAXTILES * 256, NE * 512, DM};
            MoeSched Sm{tst, 2, tst[NE] * 2, (int)gridDim.x, (int)blockIdx.x};
            EpiSwiglu E{(bf16*)(a->ws + WS_HID), (const float*)(a->ws + WS_SW), (const float*)(a->ws + WS_SR), tst, cnt};
            for (int rep = 0; rep < REP_MOE1; ++rep) pg8::gemm_phase<EpiSwiglu, MoeSched, true, true>((PG8_LAS unsigned char*)lds, g, Sm, E);
            SEAM(pb + PH_MOE1);
        }
        if (IN(pb + PH_MOE2)) { CA a = args_now();
            moe_tables(l, lds, pg8::tid_now(), (gu32*)(a->ws + WS_CTL));
            const int* tst = (const int*)(lds + LDS_TAB);
            int Kd = DE; asm volatile("" : "+s"(Kd));
            pg8::Gemm g{(const pg8::bf16_t*)(a->ws + WS_HID), (const pg8::bf16_t*)(a->ws + WS_WD), MAXTILES * 256, NE * DM, Kd};
            MoeSched Sm{tst, 4, tst[NE] * 4, (int)gridDim.x, (int)blockIdx.x};
            EpiYE E{(bf16*)(a->ws + WS_YE)};
            for (int rep = 0; rep < REP_MOE2; ++rep) pg8::gemm_phase<EpiYE, MoeSched, true, true>((PG8_LAS unsigned char*)lds, g, Sm, E);
            SEAM(pb + PH_MOE2);
        }
    }
    if (IN(PH_FIN)) phase_fin(args_now(), pg8::tid_now());
#undef IN
#undef SEAM
}

extern "C" void kernel_launch(void* const* d_in, const int* in_sizes, int n_in, void* d_out, int out_size, void* d_ws, size_t ws_size, hipStream_t stream) {
    static int grid = 0;
    if (grid == 0) {
        if (n_in != N_IN || in_sizes[0] != T * DM || out_size != T * DM || ws_size < WS_END) { fprintf(stderr, "kernel_launch: unexpected problem shape (n_in %d, in0 %d, out %d, ws %zu); nothing launched\n", n_in, n_in > 0 ? in_sizes[0] : -1, out_size, ws_size); grid = -1; return; }
        int dev = 0, cus = 0, per_cu = 0;
        if (hipGetDevice(&dev) != hipSuccess || hipDeviceGetAttribute(&cus, hipDeviceAttributeMultiprocessorCount, dev) != hipSuccess) { grid = -1; return; }
        if (hipFuncSetAttribute((const void*)fwd, hipFuncAttributeMaxDynamicSharedMemorySize, LDS_BYTES) != hipSuccess) { fprintf(stderr, "kernel_launch: hipFuncSetAttribute failed\n"); grid = -1; return; }
        if (hipOccupancyMaxActiveBlocksPerMultiprocessor(&per_cu, (const void*)fwd, NTHR, LDS_BYTES) != hipSuccess || per_cu < 1) { fprintf(stderr, "kernel_launch: occupancy query reports %d workgroups per CU\n", per_cu); }
        (void)hipGetLastError();
        grid = cus;
    }
    if (grid < 0) return;
    if (hipMemsetAsync((char*)d_ws + WS_CTL, 0, CTL_ZERO_BYTES, stream) != hipSuccess) return;
    Args a{};
    for (int i = 0; i < N_IN; ++i) a.in[i] = (const float*)d_in[i];
    a.out = (float*)d_out; a.ws = (unsigned char*)d_ws;
#if MK_ONE_LAUNCH
    a.ph_lo = 0; a.ph_hi = N_PHASES;
    hipLaunchKernelGGL(fwd, dim3(grid), dim3(NTHR), LDS_BYTES, stream, a);
#else
    for (int p = 0; p < N_PHASES; ++p) { a.ph_lo = p; a.ph_hi = p + 1; hipLaunchKernelGGL(fwd, dim3(grid), dim3(NTHR), LDS_BYTES, stream, a); }
#endif
}
```
